# Optimizing an MI355X kernel written in HIP

```python
import math
import jax, jax.numpy as jnp
from jax import lax
import numpy as np

D_MODEL = 1024
BATCH = 4
SEQ = 4096
DEPTH = 1
DEC_BATCH = 4
DEC_SEQ = 8192
PAST_LEN = 128

ATTN_GROUPS = ((128, 1), (512, 4), (2048, 16))
N_GROUPS = 3
ATTN_HEADS_PER_GROUP = 8
ATTN_HEAD_DIM = 64
ATTN_WIDTH = N_GROUPS * ATTN_HEADS_PER_GROUP * ATTN_HEAD_DIM
ATTN_OUT_WIDTH = ATTN_HEADS_PER_GROUP * ATTN_HEAD_DIM
HALF_TAPS = ATTN_GROUPS[0][0] // (2 * ATTN_GROUPS[0][1])
ATTN_BLOCK = HALF_TAPS
ALIBI_SLOPES = tuple(2.0 ** (-8.0 * (j + 1) / ATTN_HEADS_PER_GROUP) for j in range(ATTN_HEADS_PER_GROUP))

HGRN_EXPAND = 128
HGRN_HEADS = D_MODEL // HGRN_EXPAND
HGRN_KEY_DIM = HGRN_EXPAND
HGRN_VAL_DIM = D_MODEL // HGRN_HEADS
HGRN_KEY_WIDTH = HGRN_HEADS * HGRN_KEY_DIM
HGRN_WIDTH = HGRN_HEADS * HGRN_VAL_DIM
HGRN_CHUNK = 64

D_FF = 2816
RMS_EPS = 1e-6
NEG_INF = -1e30

IN_SIZES = (ATTN_WIDTH, ATTN_WIDTH, ATTN_WIDTH,
            HGRN_KEY_WIDTH, HGRN_KEY_WIDTH, HGRN_KEY_WIDTH,
            HGRN_WIDTH, HGRN_WIDTH, D_MODEL, D_MODEL)
IN_WIDTH = sum(IN_SIZES)
IN_SPLITS = tuple(int(v) for v in np.cumsum(IN_SIZES)[:-1])

kernel_name = "dilated_attn_hgrn2_gated_encoder"


def rms_norm(x, g):
    xf = x.astype(jnp.float32)
    y = xf * lax.rsqrt(jnp.mean(xf * xf, axis=-1, keepdims=True) + RMS_EPS)
    return (y * g.astype(jnp.float32)).astype(x.dtype)


def swiglu(x, w_gu, w_down):
    a, b = jnp.split(x @ w_gu, 2, axis=-1)
    return (jax.nn.silu(a) * b) @ w_down


def dilated_window_attn(q, k, v, dilation, slopes):
    B, S, H, E = q.shape
    f32 = jnp.float32
    L = S // dilation
    nb = -(-L // ATTN_BLOCK)
    Lp = nb * ATTN_BLOCK

    def to_sub(t):
        return t.reshape(B, L, dilation, H, E).transpose(0, 2, 1, 3, 4).astype(f32)

    qs = jnp.pad(to_sub(q), ((0, 0), (0, 0), (0, Lp - L), (0, 0), (0, 0)))
    pad_kv = ((0, 0), (0, 0), (ATTN_BLOCK, Lp - L + ATTN_BLOCK), (0, 0), (0, 0))
    ks = jnp.pad(to_sub(k), pad_kv)
    vs = jnp.pad(to_sub(v), pad_kv)

    def band(t):
        return jnp.concatenate(
            [t[:, :, j * ATTN_BLOCK: j * ATTN_BLOCK + Lp].reshape(B, dilation, nb, ATTN_BLOCK, H, E)
             for j in range(3)], axis=3)

    qb = qs.reshape(B, dilation, nb, ATTN_BLOCK, H, E)
    kb, vb = band(ks), band(vs)
    s = jnp.einsum('bdnqhe,bdnkhe->bdnhqk', qb, kb) * (1.0 / math.sqrt(E))

    qi = jnp.arange(ATTN_BLOCK)
    kj = jnp.arange(3 * ATTN_BLOCK) - ATTN_BLOCK
    rel = kj[None, :] - qi[:, None]
    key_pos = jnp.arange(nb)[:, None] * ATTN_BLOCK + kj[None, :]
    valid = (jnp.abs(rel) <= HALF_TAPS)[None] & ((key_pos >= 0) & (key_pos < L))[:, None, :]
    bias = -(slopes * dilation)[:, None, None] * jnp.abs(rel).astype(f32)[None]
    s = jnp.where(valid[:, None], s + bias[None], NEG_INF)

    m = jnp.max(s, axis=-1, keepdims=True)
    p = jnp.exp(s - m)
    den = jnp.sum(p, axis=-1, keepdims=True)
    o = jnp.einsum('bdnhqk,bdnkhe->bdnqhe', p / den, vb)
    lse = (m + jnp.log(den))[..., 0]

    o = o.reshape(B, dilation, Lp, H, E)[:, :, :L].transpose(0, 2, 1, 3, 4).reshape(B, S, H, E)
    lse = lse.transpose(0, 1, 2, 4, 3).reshape(B, dilation, Lp, H)[:, :, :L]
    lse = lse.transpose(0, 2, 1, 3).reshape(B, S, H)
    return o, lse


def dilated_mixture_attention(a_q, a_k, a_v):
    B, S, _ = a_q.shape
    shp = (B, S, N_GROUPS, ATTN_HEADS_PER_GROUP, ATTN_HEAD_DIM)
    q, k, v = a_q.reshape(shp), a_k.reshape(shp), a_v.reshape(shp)
    slopes = jnp.asarray(ALIBI_SLOPES, jnp.float32)
    outs, lses = [], []
    for g, (_, dil) in enumerate(ATTN_GROUPS):
        o, lse = dilated_window_attn(q[:, :, g], k[:, :, g], v[:, :, g], dil, slopes)
        outs.append(o)
        lses.append(lse)
    w = jax.nn.softmax(jnp.stack(lses, axis=0), axis=0)
    o = jnp.sum(w[..., None] * jnp.stack(outs, axis=0), axis=0)
    return o.reshape(B, S, ATTN_OUT_WIDTH).astype(a_q.dtype)


def hgrn2_chunk_scan(q, k, log_f, v):
    B, S, H, K = q.shape
    V = v.shape[-1]
    C = HGRN_CHUNK
    nc = S // C

    def chunks(t):
        return t.reshape(B, nc, C, H, t.shape[-1]).transpose(1, 0, 3, 2, 4)

    qc, kc, gc, vc = chunks(q), chunks(k), chunks(log_f), chunks(v)
    b = jnp.cumsum(gc, axis=3)
    b_last = b[:, :, :, -1:]
    q_t = qc * jnp.exp(b)
    k_t = kc * jnp.exp(-b)
    k_end = kc * jnp.exp(b_last - b)
    causal = jnp.tril(jnp.ones((C, C), dtype=bool))
    A = jnp.where(causal, jnp.einsum('nbhtk,nbhsk->nbhts', q_t, k_t), 0.0)
    o_intra = jnp.einsum('nbhts,nbhsv->nbhtv', A, vc)

    def step(state, inp):
        q_i, k_i, v_i, dec = inp
        o = jnp.einsum('bhtk,bhkv->bhtv', q_i, state)
        state = state * dec[:, :, 0, :, None] + jnp.einsum('bhsk,bhsv->bhkv', k_i, v_i)
        return state, o

    state0 = jnp.zeros((B, H, K, V), jnp.float32)
    _, o_inter = lax.scan(step, state0, (q_t, k_end, vc, jnp.exp(b_last)))
    o = o_intra + o_inter
    return o.transpose(1, 0, 3, 2, 4).reshape(B, S, H, V)


def hgrn2_bidirectional(hq, hf_f, hf_b, hi, hg, lb_f, lb_b, norm_g):
    B, S, _ = hq.shape
    f32 = jnp.float32
    kshape = (B, S, HGRN_HEADS, HGRN_KEY_DIM)
    q = jax.nn.silu(hq.astype(f32)).reshape(kshape)
    v = hi.astype(f32).reshape(B, S, HGRN_HEADS, HGRN_VAL_DIM)

    def gates(raw, lb):
        f = lb + (1.0 - lb) * jax.nn.sigmoid(raw.astype(f32))
        return (1.0 - f).reshape(kshape), jnp.log(f).reshape(kshape)

    k_f, lf_f = gates(hf_f, lb_f)
    k_b, lf_b = gates(hf_b, lb_b)
    rev = lambda t: jnp.flip(t, axis=1)
    o = hgrn2_chunk_scan(q, k_f, lf_f, v) + rev(hgrn2_chunk_scan(rev(q), rev(k_b), rev(lf_b), rev(v)))
    o = o * lax.rsqrt(jnp.mean(o * o, axis=-1, keepdims=True) + RMS_EPS)
    o = o.reshape(B, S, HGRN_WIDTH) * norm_g.astype(f32) * jax.nn.silu(hg.astype(f32))
    return o.astype(hq.dtype)


def encoder_layer(x, l, ffn1_norm, ffn1_w_gu, ffn1_w_down, mix_norm, w_in,
                  hgrn_lb_fwd, hgrn_lb_bwd, hgrn_norm, w_branch_a, w_branch_b, w_out,
                  ffn2_norm, ffn2_w_gu, ffn2_w_down):
    x = x + 0.5 * swiglu(rms_norm(x, ffn1_norm[l]), ffn1_w_gu[l], ffn1_w_down[l])
    h = rms_norm(x, mix_norm[l])
    proj = h @ w_in[l]
    a_q, a_k, a_v, h_q, h_ff, h_fb, h_i, h_g, g_a, g_b = jnp.split(proj, IN_SPLITS, axis=-1)
    ya = dilated_mixture_attention(a_q, a_k, a_v)
    lb_f = jnp.cumsum(jax.nn.softmax(hgrn_lb_fwd.astype(jnp.float32), axis=0), axis=0)[l]
    lb_b = jnp.cumsum(jax.nn.softmax(hgrn_lb_bwd.astype(jnp.float32), axis=0), axis=0)[l]
    yb = hgrn2_bidirectional(h_q, h_ff, h_fb, h_i, h_g, lb_f, lb_b, hgrn_norm[l])
    merged = jax.nn.sigmoid(g_a) * (ya @ w_branch_a[l]) + jax.nn.sigmoid(g_b) * (yb @ w_branch_b[l])
    x = x + merged @ w_out[l]
    x = x + 0.5 * swiglu(rms_norm(x, ffn2_norm[l]), ffn2_w_gu[l], ffn2_w_down[l])
    return x


def setup_inputs(seed: int = 0) -> dict:
    key = jax.random.key(seed)
    ks = jax.random.split(key, 20)
    f32 = jnp.float32
    nrm = lambda k, shape, fan_in: jax.random.normal(k, shape, f32) * (fan_in ** -0.5)
    gain = lambda k, shape: 1.0 + 0.01 * jax.random.normal(k, shape, f32)
    return {
        "x_prompt": jax.random.normal(ks[0], (BATCH, SEQ, D_MODEL), f32),
        "x_sample": jax.random.normal(ks[1], (DEC_BATCH, DEC_SEQ, D_MODEL), f32),
        "ffn1_norm": gain(ks[2], (DEPTH, D_MODEL)),
        "ffn1_w_gu": nrm(ks[3], (DEPTH, D_MODEL, 2 * D_FF), D_MODEL),
        "ffn1_w_down": nrm(ks[4], (DEPTH, D_FF, D_MODEL), D_FF),
        "mix_norm": gain(ks[5], (DEPTH, D_MODEL)),
        "w_in": nrm(ks[6], (DEPTH, D_MODEL, IN_WIDTH), D_MODEL),
        "hgrn_lb_fwd": 0.1 * jax.random.normal(ks[7], (DEPTH + 1, HGRN_KEY_WIDTH), f32),
        "hgrn_lb_bwd": 0.1 * jax.random.normal(ks[8], (DEPTH + 1, HGRN_KEY_WIDTH), f32),
        "hgrn_norm": gain(ks[9], (DEPTH, HGRN_WIDTH)),
        "w_branch_a": nrm(ks[10], (DEPTH, ATTN_OUT_WIDTH, D_MODEL), ATTN_OUT_WIDTH),
        "w_branch_b": nrm(ks[11], (DEPTH, HGRN_WIDTH, D_MODEL), HGRN_WIDTH),
        "w_out": nrm(ks[12], (DEPTH, D_MODEL, D_MODEL), D_MODEL),
        "ffn2_norm": gain(ks[13], (DEPTH, D_MODEL)),
        "ffn2_w_gu": nrm(ks[14], (DEPTH, D_MODEL, 2 * D_FF), D_MODEL),
        "ffn2_w_down": nrm(ks[15], (DEPTH, D_FF, D_MODEL), D_FF),
        "final_norm": gain(ks[16], (D_MODEL,)),
    }


def reference(x_prompt, x_sample, ffn1_norm, ffn1_w_gu, ffn1_w_down, mix_norm, w_in,
              hgrn_lb_fwd, hgrn_lb_bwd, hgrn_norm, w_branch_a, w_branch_b, w_out,
              ffn2_norm, ffn2_w_gu, ffn2_w_down, final_norm):
    def trunk(x):
        for l in range(DEPTH):
            x = encoder_layer(x, l, ffn1_norm, ffn1_w_gu, ffn1_w_down, mix_norm, w_in,
                              hgrn_lb_fwd, hgrn_lb_bwd, hgrn_norm, w_branch_a, w_branch_b, w_out,
                              ffn2_norm, ffn2_w_gu, ffn2_w_down)
        return rms_norm(x, final_norm)

    y_prompt = trunk(x_prompt)
    y_sample = trunk(x_sample)
    return (y_prompt, y_sample)
```

```cpp
#include <hip/hip_runtime.h>
#include <hip/hip_cooperative_groups.h>
#include <cstdio>
#include <cstdint>
#include <cstring>
namespace cg = cooperative_groups;
__device__ __forceinline__ int opq_tid() { int t = threadIdx.x; asm volatile("" : "+v"(t)); return t; }
__device__ __forceinline__ int opq_bid() { int b = blockIdx.x; asm volatile("" : "+s"(b)); return b; }
namespace pg8 {
#define PG8_LAS __attribute__((address_space(3)))
typedef unsigned short bf16_t;
typedef short bf16x8 __attribute__((ext_vector_type(8)));
typedef float f32x4 __attribute__((ext_vector_type(4)));
typedef unsigned u32x4 __attribute__((ext_vector_type(4)));
constexpr int BM = 256, BK = 64, HALF = 128, HTB = HALF * BK * 2  , STAGE_BYTES = 8 * HTB, NXCD = 8, WGM = 8;

__host__ __device__ __forceinline__ int lds_byte(int r, int c) { const int st = (r >> 4) * 2 + (c >> 5), rr = r & 15, cc = c & 31, ob = rr * 64 + cc * 2; return st * 1024 + (ob ^ (((ob >> 9) & 1) << 5)); }
__host__ __device__ __forceinline__ void stage_rc(int b, int& R, int& C) { const int st = b / 1024, sb = b % 1024, swz = sb ^ (((sb >> 9) & 1) << 5); R = (st >> 1) * 16 + swz / 64; C = (st & 1) * 32 + (swz % 64) / 2; }
__host__ __device__ __forceinline__ int perm32(int rho) { const int n = rho >> 4, i = rho & 15; return 8 * (i >> 2) + 4 * n + (i & 3); }

struct Unit { int pm, pn; };
struct Gemm { const bf16_t* A; const bf16_t* Bt; int M, N, K; };

struct StaticOrder {
    int nM, nN, nwg, G, c;
    __host__ __device__ void init(int M, int N, int G_, int c_) { nM = M / BM; nN = N / BM; nwg = nM * nN; G = G_; c = c_; }
    __host__ __device__ bool next(int i, Unit& u) const {
        const long L = (long)i * G + c; if (L >= nwg) return false;
        int wgid = (int)L; { const int q = nwg / NXCD, r = nwg % NXCD, xcd = wgid % NXCD, off = wgid / NXCD; wgid = (xcd < r ? xcd * (q + 1) : r * (q + 1) + (xcd - r) * q) + off; }
        const int nig = WGM * nN, gid = wgid / nig, fm = gid * WGM, gsz = (nM - fm) < WGM ? (nM - fm) : WGM;
        u.pm = fm + ((wgid % nig) % gsz); u.pn = (wgid % nig) / gsz; return true;
    }
    __device__ __forceinline__ void a_ready(const Unit&) const {}
    __device__ __forceinline__ void done(const Unit&) const {}
};
template <class Epi, class Sched>
__device__ __forceinline__ void gemm_phase(PG8_LAS unsigned char* lds, const Gemm g, const Sched& S, const Epi& E) {
    const int tid = opq_tid(), wid = __builtin_amdgcn_readfirstlane(tid >> 6), lane = tid & 63, wr = wid >> 2, wc = wid & 3, fr = lane & 15, fq = lane >> 4;
    const int K = g.K, nt = K / BK;
    unsigned voffA[2], voffB[2];
#pragma unroll
    for (int i = 0; i < 2; ++i) { int R, C; stage_rc(tid * 16 + i * 8192, R, C); const int Rb = Epi::PERM ? ((R & ~31) + perm32(R & 31)) : R;
        voffA[i] = (unsigned)(R * K + C) * 2u; voffB[i] = (unsigned)(Rb * K + C) * 2u; }
    const size_t kstep = (size_t)(BK * 2);
    const size_t hstep = (size_t)HALF * K * 2;
    const size_t tstep = 2 * hstep;
    const unsigned ldsw = (unsigned)wid * 1024u;
    const int aoff = lds_byte(wr * 64 + fr, fq * 8), boff = lds_byte(wc * 32 + fr, fq * 8);
#define PG8_SA(b, h) (((b) * 2 + (h)) * HTB)
#define PG8_SB(b, h) ((4 + (b) * 2 + (h)) * HTB)
#define PG8_STAGE(bufoff, gbase, voff) do { _Pragma("unroll") for (int _i = 0; _i < 2; ++_i) \
        __builtin_amdgcn_global_load_lds((const unsigned*)((const char*)(gbase) + (voff)[_i]), (PG8_LAS unsigned*)(lds + (bufoff) + ldsw + _i * 8192), 16, 0, 0); } while (0)
#define PG8_LDA(dst, b, h) do { _Pragma("unroll") for (int m = 0; m < 4; ++m) _Pragma("unroll") for (int k = 0; k < 2; ++k) dst[m][k] = *(const PG8_LAS bf16x8*)(lds + PG8_SA(b, h) + aoff + m * 2048 + k * 1024); } while (0)
#define PG8_LDB(dst, b, h) do { _Pragma("unroll") for (int n = 0; n < 2; ++n) _Pragma("unroll") for (int k = 0; k < 2; ++k) dst[n][k] = *(const PG8_LAS bf16x8*)(lds + PG8_SB(b, h) + boff + n * 2048 + k * 1024); } while (0)
#define PG8_MMA(ai, bj, At, Bt) do { __builtin_amdgcn_s_setprio(1); _Pragma("unroll") for (int m = 0; m < 4; ++m) _Pragma("unroll") for (int n = 0; n < 2; ++n) _Pragma("unroll") for (int k = 0; k < 2; ++k) \
        acc[ai][bj][m][n] = __builtin_amdgcn_mfma_f32_16x16x32_bf16(Bt[n][k], At[m][k], acc[ai][bj][m][n], 0, 0, 0); __builtin_amdgcn_s_setprio(0); } while (0)
#define PG8_WAIT_V(n) asm volatile("s_waitcnt vmcnt(" #n ")" ::: "memory")
#define PG8_WAIT_L(n) asm volatile("s_waitcnt lgkmcnt(" #n ")" ::: "memory")
#define PG8_BAR __builtin_amdgcn_s_barrier()
#define PG8_SCHED __builtin_amdgcn_sched_barrier(0)
    Unit cur, nxt; int ui = 0;
    if (!S.next(0, cur)) return;
    f32x4 acc[2][2][4][2];
#pragma unroll
    for (int a = 0; a < 2; ++a)
#pragma unroll
        for (int b = 0; b < 2; ++b)
#pragma unroll
            for (int m = 0; m < 4; ++m)
#pragma unroll
                for (int n = 0; n < 2; ++n) acc[a][b][m][n] = (f32x4){0.f, 0.f, 0.f, 0.f};
    bf16x8 At[4][2], B0[2][2], B1[2][2];
    const char* cA = (const char*)g.A + (size_t)cur.pm * tstep; const char* cB = (const char*)g.Bt + (size_t)cur.pn * tstep;
    S.a_ready(cur);
    PG8_STAGE(PG8_SB(0, 0), cB, voffB); PG8_STAGE(PG8_SA(0, 0), cA, voffA); PG8_STAGE(PG8_SB(0, 1), cB + hstep, voffB); PG8_STAGE(PG8_SA(0, 1), cA + hstep, voffA);
    if (wr == 1) PG8_BAR;
    PG8_WAIT_V(4); PG8_BAR;
    PG8_STAGE(PG8_SB(1, 0), cB + kstep, voffB); PG8_STAGE(PG8_SA(1, 0), cA + kstep, voffA); PG8_STAGE(PG8_SB(1, 1), cB + hstep + kstep, voffB);
    PG8_WAIT_V(6); PG8_BAR;
    for (;;) {
        const bool has_next = S.next(ui + 1, nxt);
        const char* nA = has_next ? (const char*)g.A + (size_t)nxt.pm * tstep : cA; const char* nB = has_next ? (const char*)g.Bt + (size_t)nxt.pn * tstep : cB;
        for (int t = 0; t < nt; t += 2) {
            const bool last = (t == nt - 2);
            const char* a1 = cA + (size_t)(t + 1) * kstep;
            const char* a2 = last ? nA : cA + (size_t)(t + 2) * kstep; const char* b2 = last ? nB : cB + (size_t)(t + 2) * kstep;
            const char* a3 = a2 + kstep; const char* b3 = b2 + kstep;
            if (last && has_next) S.a_ready(nxt);
            PG8_LDB(B0, 0, 0); PG8_SCHED; PG8_LDA(At, 0, 0); PG8_STAGE(PG8_SA(1, 1), a1 + hstep, voffA);
            PG8_WAIT_L(8); PG8_BAR; PG8_WAIT_L(0); PG8_MMA(0, 0, At, B0); PG8_BAR; PG8_SCHED;
            PG8_LDB(B1, 0, 1); PG8_STAGE(PG8_SB(0, 0), b2, voffB);
            PG8_BAR; PG8_WAIT_L(0); PG8_MMA(0, 1, At, B1); PG8_BAR;
            PG8_LDA(At, 0, 1); PG8_STAGE(PG8_SA(0, 0), a2, voffA);
            PG8_BAR; PG8_WAIT_L(0); PG8_MMA(1, 0, At, B0); PG8_BAR; PG8_SCHED;
            PG8_STAGE(PG8_SB(0, 1), b2 + hstep, voffB);
            PG8_WAIT_V(6); PG8_BAR; PG8_MMA(1, 1, At, B1); PG8_BAR;
            PG8_LDB(B0, 1, 0); PG8_SCHED; PG8_LDA(At, 1, 0); PG8_STAGE(PG8_SA(0, 1), a2 + hstep, voffA);
            PG8_WAIT_L(8); PG8_BAR; PG8_WAIT_L(0); PG8_MMA(0, 0, At, B0); PG8_BAR; PG8_SCHED;
            PG8_LDB(B1, 1, 1); PG8_STAGE(PG8_SB(1, 0), b3, voffB);
            PG8_BAR; PG8_WAIT_L(0); PG8_MMA(0, 1, At, B1); PG8_BAR;
            PG8_LDA(At, 1, 1); PG8_STAGE(PG8_SA(1, 0), a3, voffA);
            PG8_BAR; PG8_WAIT_L(0); PG8_MMA(1, 0, At, B0); PG8_BAR; PG8_SCHED;
            PG8_STAGE(PG8_SB(1, 1), b3 + hstep, voffB);
            PG8_WAIT_V(6); PG8_BAR; PG8_MMA(1, 1, At, B1); PG8_BAR;
        }
        if constexpr (!Epi::AFTER_DRAIN) { E(acc, cur, wr, wc, fr, fq); S.done(cur); }
        if (!has_next) break;
#pragma unroll
        for (int a = 0; a < 2; ++a)
#pragma unroll
            for (int b = 0; b < 2; ++b)
#pragma unroll
                for (int m = 0; m < 4; ++m)
#pragma unroll
                    for (int n = 0; n < 2; ++n) acc[a][b][m][n] = (f32x4){0.f, 0.f, 0.f, 0.f};
        cur = nxt; cA = nA; cB = nB; ++ui;
    }
    PG8_WAIT_V(0);
    if (wr == 0) PG8_BAR;
    PG8_BAR;
    if constexpr (Epi::AFTER_DRAIN) { E.fused(acc, cur, wr, wc, fr, fq, lds, wid, lane); S.done(cur); }
#undef PG8_SA
#undef PG8_SB
#undef PG8_STAGE
#undef PG8_LDA
#undef PG8_LDB
#undef PG8_MMA
#undef PG8_WAIT_V
#undef PG8_WAIT_L
#undef PG8_BAR
#undef PG8_SCHED
}
}

using pg8::f32x4; using pg8::bf16_t; using pg8::u32x4;
typedef unsigned u32x2 __attribute__((ext_vector_type(2)));
#define DI __device__ __forceinline__

constexpr int T = 49152, TP = 16384, D = 1024, FF = 2816, NIN = 11776, THALF = 24576;
constexpr float EPS = 1e-6f;

DI unsigned pk2(float lo, float hi) { unsigned r; asm volatile("v_cvt_pk_bf16_f32 %0, %1, %2" : "=v"(r) : "v"(lo), "v"(hi)); return r; }
DI float bflo(unsigned u) { return __uint_as_float(u << 16); }
DI float bfhi(unsigned u) { return __uint_as_float(u & 0xffff0000u); }
DI float bf1(bf16_t b) { return __uint_as_float(((unsigned)b) << 16); }
DI float sigm(float x) { return 1.0f / (1.0f + __expf(-x)); }
DI float wave_sum(float v) {
#pragma unroll
  for (int o = 1; o < 64; o <<= 1) v += __shfl_xor(v, o);
  return v;
}
DI float wave_max(float v) {
#pragma unroll
  for (int o = 1; o < 64; o <<= 1) v = fmaxf(v, __shfl_xor(v, o));
  return v;
}

DI float ss16(const float* p) { const f32x4 a = *(const f32x4*)p, b = *(const f32x4*)(p + 4), c = *(const f32x4*)(p + 8), d = *(const f32x4*)(p + 12);
  return ((a[0] + a[1]) + (a[2] + a[3])) + ((b[0] + b[1]) + (b[2] + b[3])) + ((c[0] + c[1]) + (c[2] + c[3])) + ((d[0] + d[1]) + (d[2] + d[3])); }
enum { M_SWIGLU = 0, M_BF16S = 1, M_RESID = 2, M_MUL = 3, M_FMA = 4 };

struct EpiP {
  int mode, sig, split_tiles, ldo;
  const float* ss; bf16_t* ob; size_t split_stride;
  float* of; const float* r0; const float* r1; float alpha; int pad; float* ss_out;
  const bf16_t* sg; const float* tmp;
};
struct Epi {
  static constexpr bool PERM = false, AFTER_DRAIN = false;
  const PG8_LAS EpiP* lp;
  __device__ __forceinline__ void operator()(const f32x4 (&acc)[2][2][4][2], const pg8::Unit& u, int wr, int wc, int fr, int fq) const {
    const int mode = lp->mode, sig = lp->sig, split_tiles = lp->split_tiles, ldo = lp->ldo;
    const float* ss = lp->ss; bf16_t* ob = lp->ob; const size_t split_stride = lp->split_stride;
    float* of = lp->of; const float* r0 = lp->r0; const float* r1 = lp->r1; const float alpha = lp->alpha; float* ss_out = lp->ss_out;
    const bf16_t* sg = lp->sg; const float* tmp = lp->tmp;
    const int rowb = u.pm * 256 + wr * 64 + fr;
    if (mode == M_SWIGLU) {
#pragma unroll
      for (int ai = 0; ai < 2; ++ai)
#pragma unroll
        for (int m = 0; m < 4; ++m) {
          const int row = rowb + ai * 128 + m * 16;
          const float rs = rsqrtf(ss16(ss + (size_t)row * 16) * (1.0f / 1024.0f) + EPS);
          float h[8];
#pragma unroll
          for (int n = 0; n < 2; ++n)
#pragma unroll
            for (int j = 0; j < 4; ++j) { const float a = acc[ai][0][m][n][j] * rs, b = acc[ai][1][m][n][j] * rs; h[n * 4 + j] = a * sigm(a) * b; }
          u32x4 w; w.x = pk2(h[0], h[1]); w.y = pk2(h[2], h[3]); w.z = pk2(h[4], h[5]); w.w = pk2(h[6], h[7]);
          *(u32x4*)(ob + (size_t)row * FF + u.pn * 128 + wc * 32 + fq * 8) = w;
        }
    } else if (mode == M_BF16S) {
      int pn = u.pn; bf16_t* base = ob;
      if (split_tiles) { const int t = pn / split_tiles; base += (size_t)t * split_stride; pn -= t * split_tiles; }
#pragma unroll
      for (int ai = 0; ai < 2; ++ai)
#pragma unroll
        for (int m = 0; m < 4; ++m) {
          const int row = rowb + ai * 128 + m * 16;
          const float rs = rsqrtf(ss16(ss + (size_t)row * 16) * (1.0f / 1024.0f) + EPS);
#pragma unroll
          for (int bj = 0; bj < 2; ++bj) {
            float v[8];
#pragma unroll
            for (int n = 0; n < 2; ++n)
#pragma unroll
              for (int j = 0; j < 4; ++j) { float x = acc[ai][bj][m][n][j] * rs; if (sig) x = sigm(x); v[n * 4 + j] = x; }
            u32x4 w; w.x = pk2(v[0], v[1]); w.y = pk2(v[2], v[3]); w.z = pk2(v[4], v[5]); w.w = pk2(v[6], v[7]);
            *(u32x4*)(base + (size_t)row * ldo + pn * 256 + bj * 128 + wc * 32 + fq * 8) = w;
          }
        }
    } else if (mode == M_RESID) {
#pragma unroll
      for (int ai = 0; ai < 2; ++ai)
#pragma unroll
        for (int m = 0; m < 4; ++m) {
          const int row = rowb + ai * 128 + m * 16;
          const float* rp = row < TP ? r0 + (size_t)row * D : r1 + (size_t)(row - TP) * D;
          float s2 = 0.f;
#pragma unroll
          for (int bj = 0; bj < 2; ++bj)
#pragma unroll
            for (int n = 0; n < 2; ++n) {
              const int c0 = u.pn * 256 + bj * 128 + wc * 32 + n * 16 + fq * 4;
              const f32x4 r = *(const f32x4*)(rp + c0);
              const f32x4 o = r + alpha * acc[ai][bj][m][n];
              *(f32x4*)(of + (size_t)row * D + c0) = o;
              if (ob) { u32x2 w; w.x = pk2(o[0], o[1]); w.y = pk2(o[2], o[3]); *(u32x2*)(ob + (size_t)row * D + c0) = w; }
              s2 += (o[0] * o[0] + o[1] * o[1]) + (o[2] * o[2] + o[3] * o[3]);
            }
          s2 += __shfl_xor(s2, 16); s2 += __shfl_xor(s2, 32);
          if (fq == 0) ss_out[(size_t)row * 16 + u.pn * 4 + wc] = s2;
        }
    } else {
#pragma unroll
      for (int ai = 0; ai < 2; ++ai)
#pragma unroll
        for (int m = 0; m < 4; ++m) {
          const int row = rowb + ai * 128 + m * 16;
#pragma unroll
          for (int bj = 0; bj < 2; ++bj)
#pragma unroll
            for (int n = 0; n < 2; ++n) {
              const int c0 = u.pn * 256 + bj * 128 + wc * 32 + n * 16 + fq * 4;
              const u32x2 g2 = *(const u32x2*)(sg + (size_t)row * D + c0);
              f32x4 gv; gv[0] = bflo(g2.x); gv[1] = bfhi(g2.x); gv[2] = bflo(g2.y); gv[3] = bfhi(g2.y);
              if (mode == M_MUL) {
                *(f32x4*)(of + (size_t)row * D + c0) = gv * acc[ai][bj][m][n];
              } else {
                const f32x4 t4 = *(const f32x4*)(tmp + (size_t)row * D + c0);
                const f32x4 o = t4 + gv * acc[ai][bj][m][n];
                u32x2 w; w.x = pk2(o[0], o[1]); w.y = pk2(o[2], o[3]); *(u32x2*)(ob + (size_t)row * D + c0) = w;
              }
            }
        }
    }
  }
};

constexpr size_t SZ_WGU = (size_t)2 * FF * D * 2, SZ_WD = (size_t)D * FF * 2, SZ_WIN = (size_t)NIN * D * 2;
constexpr size_t OFF_WGU1 = 0, OFF_WD1 = OFF_WGU1 + SZ_WGU, OFF_WGU2 = OFF_WD1 + SZ_WD, OFF_WD2 = OFF_WGU2 + SZ_WGU, OFF_WIN = OFF_WD2 + SZ_WD;
constexpr size_t OFF_WA = OFF_WIN + SZ_WIN, OFF_WB = OFF_WA + (size_t)D * 512 * 2, OFF_WO = OFF_WB + (size_t)D * D * 2, OFF_XB = OFF_WO + (size_t)D * D * 2;
constexpr size_t OFF_SS = OFF_XB + (size_t)T * D * 2, OFF_CTR = OFF_SS + (size_t)4 * T * 16 * 4, OFF_BIG = OFF_CTR + 256;
constexpr size_t B_ACT = 0, B_PROJH = 0, B_OFB = (size_t)T * 4096 * 2, B_HG = 0, B_YB = (size_t)T * D * 2, B_QKV = B_YB + (size_t)T * D * 2;
constexpr size_t B_OG = B_QKV + (size_t)THALF * 4608 * 2, B_LSE = B_OG + (size_t)3 * T * 512 * 2, B_YA = 0, B_SGA = B_QKV, B_SGB = B_SGA + (size_t)T * D * 2, B_TMP = B_SGB + (size_t)T * D * 2;
constexpr size_t WS_NEED = OFF_BIG + B_TMP + (size_t)T * D * 4;

struct PhaseDesc { int type, M, N, K; const bf16_t* A; const bf16_t* Bt; EpiP e; };
struct Params {
  const float* in[17];
  float* out; unsigned char* ws;
  PhaseDesc ph[17];
};

enum { MAP_NAT = 0, MAP_P32 = 1, MAP_GU = 2 };
DI int srccol(int map, int np) {
  if (map == MAP_NAT) return np;
  if (map == MAP_P32) return (np & ~31) + pg8::perm32(np & 31);
  const int pn = np >> 8, w = np & 255, bj = w >> 7, wc = (w & 127) >> 5, n = (w & 31) >> 4, fq = (w & 15) >> 2, j = w & 3;
  return bj * FF + 128 * pn + 32 * wc + 8 * fq + 4 * n + j;
}
DI void transpose_item(const float* W, int K, int Nsrc, const float* gain, bf16_t* WT, int map, float* scr, int item, int nblk, int lane) {
  const int kb = item / nblk, nb = item % nblk, k0 = 64 * kb, n0 = 32 * nb;
  const int sc = srccol(map, n0 + (lane & 31));
#pragma unroll 8
  for (int i = 0; i < 32; ++i) { const int kk = 2 * i + (lane >> 5); scr[kk * 33 + (lane & 31)] = W[(size_t)(k0 + kk) * Nsrc + sc]; }
  asm volatile("s_waitcnt lgkmcnt(0)" ::: "memory");
  const int c = lane & 7;
  float g8[8];
#pragma unroll
  for (int e = 0; e < 8; ++e) g8[e] = gain ? gain[k0 + 8 * c + e] : 1.0f;
#pragma unroll
  for (int j = 0; j < 4; ++j) {
    const int n = (lane >> 3) + 8 * j; const float* s = scr + (8 * c) * 33 + n;
    u32x4 o; o.x = pk2(s[0 * 33] * g8[0], s[1 * 33] * g8[1]); o.y = pk2(s[2 * 33] * g8[2], s[3 * 33] * g8[3]);
    o.z = pk2(s[4 * 33] * g8[4], s[5 * 33] * g8[5]); o.w = pk2(s[6 * 33] * g8[6], s[7 * 33] * g8[7]);
    *(u32x4*)(WT + (size_t)(n0 + n) * K + k0 + 8 * c) = o;
  }
  asm volatile("s_waitcnt lgkmcnt(0)" ::: "memory");
}

DI void prep_phase(const Params& p, unsigned char* shm) {
  const int tid = opq_tid(), wid = tid >> 6, lane = tid & 63;
  const int bid = opq_bid(); const int gw = bid * 8 + wid, NGW = gridDim.x * 8;
  unsigned char* ws = p.ws;
  if (bid == 0 && tid < 64) ((unsigned*)(ws + OFF_CTR))[tid] = 0u;
  { float* ss0 = (float*)(ws + OFF_SS); bf16_t* xb = (bf16_t*)(ws + OFF_XB);
    for (int row = gw; row < T; row += NGW) {
      const float* xr = row < TP ? p.in[0] + (size_t)row * D : p.in[1] + (size_t)(row - TP) * D;
      f32x4 v[4]; float s = 0.f;
#pragma unroll
      for (int j = 0; j < 4; ++j) { v[j] = *(const f32x4*)(xr + 4 * lane + 256 * j); s += (v[j][0] * v[j][0] + v[j][1] * v[j][1]) + (v[j][2] * v[j][2] + v[j][3] * v[j][3]); }
      s = wave_sum(s);
      if (lane < 16) ss0[(size_t)row * 16 + lane] = lane == 0 ? s : 0.f;
#pragma unroll
      for (int j = 0; j < 4; ++j) { u32x2 w; w.x = pk2(v[j][0], v[j][1]); w.y = pk2(v[j][2], v[j][3]); *(u32x2*)(xb + (size_t)row * D + 4 * lane + 256 * j) = w; }
    } }
  float* scr = (float*)(shm + wid * 8704);
  for (int wsel = 0; wsel < 8; ++wsel) {
    const float* W; const float* gain = nullptr; bf16_t* WT; int K, Nsrc, Nd, map;
    switch (wsel) {
      case 0: W = p.in[3]; gain = p.in[2]; WT = (bf16_t*)(ws + OFF_WGU1); K = D; Nsrc = 2 * FF; Nd = 2 * FF; map = MAP_GU; break;
      case 1: W = p.in[4]; WT = (bf16_t*)(ws + OFF_WD1); K = FF; Nsrc = D; Nd = D; map = MAP_NAT; break;
      case 2: W = p.in[6]; gain = p.in[5]; WT = (bf16_t*)(ws + OFF_WIN); K = D; Nsrc = NIN; Nd = NIN; map = MAP_P32; break;
      case 3: W = p.in[10]; WT = (bf16_t*)(ws + OFF_WA); K = 512; Nsrc = D; Nd = D; map = MAP_NAT; break;
      case 4: W = p.in[11]; WT = (bf16_t*)(ws + OFF_WB); K = D; Nsrc = D; Nd = D; map = MAP_NAT; break;
      case 5: W = p.in[12]; WT = (bf16_t*)(ws + OFF_WO); K = D; Nsrc = D; Nd = D; map = MAP_NAT; break;
      case 6: W = p.in[14]; gain = p.in[13]; WT = (bf16_t*)(ws + OFF_WGU2); K = D; Nsrc = 2 * FF; Nd = 2 * FF; map = MAP_GU; break;
      default: W = p.in[15]; WT = (bf16_t*)(ws + OFF_WD2); K = FF; Nsrc = D; Nd = D; map = MAP_NAT; break;
    }
    const int nblk = Nd / 32, nitems = (K / 64) * nblk;
    for (int it = gw; it < nitems; it += NGW) transpose_item(W, K, Nsrc, gain, WT, map, scr, it, nblk, lane);
  }
}

DI void hgrn_naive_phase(const Params& p, unsigned char* shm) {
  const int chain = opq_bid();
  if (chain >= 128) return;
  const int tid = opq_tid(), wid = tid >> 6, lane = tid & 63;
  const int seq = chain >> 4, head = (chain >> 1) & 7, dir = chain & 1;
  const int slen = seq < 4 ? 4096 : 8192, row0 = seq < 4 ? seq * 4096 : TP + (seq - 4) * 8192;
  const bf16_t* pj = (const bf16_t*)(p.ws + OFF_BIG + B_PROJH);
  bf16_t* od = (bf16_t*)(p.ws + OFF_BIG + B_OFB) + (size_t)dir * T * D;
  const float* lbw = dir ? p.in[8] : p.in[7];
  float* gq = (float*)shm; float* gf = gq + 2048; float* gk = gf + 2048; float* gv = gk + 2048;
  const int vl = lane & 15, kq = lane >> 4, v = 16 * wid + vl;
  float S[32];
#pragma unroll
  for (int i = 0; i < 32; ++i) S[i] = 0.f;
  const int fk = tid & 127;
  const float lb = 1.0f / (1.0f + __expf(lbw[D + head * 128 + fk] - lbw[head * 128 + fk]));
  for (int i0 = 0; i0 < slen; i0 += 16) {
    __syncthreads();
#pragma unroll
    for (int r = 0; r < 4; ++r) {
      const int tt = (tid >> 7) + 4 * r; const int t = dir ? slen - 1 - (i0 + tt) : i0 + tt; const size_t rb = (size_t)(row0 + t) * 4096 + head * 128 + fk;
      const float hq = bf1(pj[rb]), hf = bf1(pj[rb + 1024 * (1 + dir)]), hi = bf1(pj[rb + 3072]);
      const float s = sigm(hf);
      gq[tt * 128 + fk] = hq * sigm(hq); gf[tt * 128 + fk] = lb + (1.0f - lb) * s; gk[tt * 128 + fk] = (1.0f - lb) * (1.0f - s); gv[tt * 128 + fk] = hi;
    }
    __syncthreads();
    for (int tt = 0; tt < 16; ++tt) {
      const float val = gv[tt * 128 + v]; float o = 0.f;
#pragma unroll
      for (int k4 = 0; k4 < 8; ++k4) {
        const f32x4 f4 = *(const f32x4*)(gf + tt * 128 + 32 * kq + 4 * k4), k4v = *(const f32x4*)(gk + tt * 128 + 32 * kq + 4 * k4), q4 = *(const f32x4*)(gq + tt * 128 + 32 * kq + 4 * k4);
#pragma unroll
        for (int e = 0; e < 4; ++e) { S[4 * k4 + e] = f4[e] * S[4 * k4 + e] + k4v[e] * val; o += q4[e] * S[4 * k4 + e]; }
      }
      o += __shfl_xor(o, 16); o += __shfl_xor(o, 32);
      const int t = dir ? slen - 1 - (i0 + tt) : i0 + tt;
      if (kq == 0) od[(size_t)(row0 + t) * D + head * 128 + v] = (bf16_t)(pk2(o, 0.f) & 0xffffu);
    }
  }
}

DI void combine_phase(const Params& p) {
  const int tid = opq_tid(), wid = tid >> 6, lane = tid & 63;
  const int bid = opq_bid(); const int gw = bid * 8 + wid, NGW = gridDim.x * 8;
  const bf16_t* oF = (const bf16_t*)(p.ws + OFF_BIG + B_OFB); const bf16_t* oB = oF + (size_t)T * D;
  const bf16_t* hg = (const bf16_t*)(p.ws + OFF_BIG + B_HG); bf16_t* yb = (bf16_t*)(p.ws + OFF_BIG + B_YB);
  const float* ng = p.in[9];
  const int c0 = lane * 16;
  float g[16];
#pragma unroll
  for (int i = 0; i < 16; ++i) g[i] = ng[c0 + i];
  for (int row = gw; row < T; row += NGW) {
    const size_t b = (size_t)row * D + c0;
    float o[16]; float s = 0.f;
#pragma unroll
    for (int h = 0; h < 2; ++h) {
      const u32x4 a = *(const u32x4*)(oF + b + 8 * h), c = *(const u32x4*)(oB + b + 8 * h);
#pragma unroll
      for (int e = 0; e < 4; ++e) { o[8 * h + 2 * e] = bflo(a[e]) + bflo(c[e]); o[8 * h + 2 * e + 1] = bfhi(a[e]) + bfhi(c[e]); }
    }
#pragma unroll
    for (int i = 0; i < 16; ++i) s += o[i] * o[i];
    s += __shfl_xor(s, 1); s += __shfl_xor(s, 2); s += __shfl_xor(s, 4);
    const float rs = rsqrtf(s * (1.0f / 128.0f) + EPS);
#pragma unroll
    for (int h = 0; h < 2; ++h) {
      const u32x4 gg = *(const u32x4*)(hg + b + 8 * h); u32x4 w;
#pragma unroll
      for (int e = 0; e < 4; ++e) {
        const float g0 = bflo(gg[e]), g1 = bfhi(gg[e]);
        w[e] = pk2(o[8 * h + 2 * e] * rs * g[8 * h + 2 * e] * g0 * sigm(g0), o[8 * h + 2 * e + 1] * rs * g[8 * h + 2 * e + 1] * g1 * sigm(g1));
      }
      *(u32x4*)(yb + b + 8 * h) = w;
    }
  }
}

DI void attn_naive_phase(const Params& p, int half) {
  const int tid = opq_tid(), wid = tid >> 6, lane = tid & 63;
  const int bid = opq_bid(); const int gw = bid * 8 + wid, NGW = gridDim.x * 8;
  const int row_base = half * THALF;
  const bf16_t* base = (const bf16_t*)(p.ws + OFF_BIG + B_QKV) - (size_t)row_base * 4608;
  bf16_t* ya = (bf16_t*)(p.ws + OFF_BIG + B_YA);
  for (int unit = gw; unit < THALF * 8; unit += NGW) {
    const int row = row_base + (unit >> 3), j = unit & 7;
    int s0, slen; if (row < TP) { s0 = row & ~4095; slen = 4096; } else { s0 = TP + ((row - TP) & ~8191); slen = 8192; }
    const int t = row - s0;
    const float slope = exp2f(-(float)(j + 1));
    float sc[3][3];
#pragma unroll
    for (int g = 0; g < 3; ++g) {
      const int d = g == 0 ? 1 : (g == 1 ? 4 : 16);
      u32x4 qv[8];
      { const u32x4* qp = (const u32x4*)(base + (size_t)row * 4608 + g * 512 + j * 64);
#pragma unroll
        for (int i = 0; i < 8; ++i) qv[i] = qp[i]; }
#pragma unroll
      for (int r = 0; r < 3; ++r) {
        const int joff = lane + 64 * r - 64; const int pos = t + d * joff;
        const bool valid = (r < 2 || lane == 0) && pos >= 0 && pos < slen;
        float s = -1e30f;
        if (valid) {
          const u32x4* kp = (const u32x4*)(base + (size_t)(s0 + pos) * 4608 + 1536 + g * 512 + j * 64);
          float dot = 0.f;
#pragma unroll
          for (int i = 0; i < 8; ++i) { const u32x4 kv = kp[i];
#pragma unroll
            for (int e = 0; e < 4; ++e) dot += bflo(kv[e]) * bflo(qv[i][e]) + bfhi(kv[e]) * bfhi(qv[i][e]); }
          s = dot * 0.125f - slope * (float)(d * (joff < 0 ? -joff : joff));
        }
        sc[g][r] = s;
      }
    }
    float m = -1e30f;
#pragma unroll
    for (int g = 0; g < 3; ++g)
#pragma unroll
      for (int r = 0; r < 3; ++r) m = fmaxf(m, sc[g][r]);
    m = wave_max(m);
    float l = 0.f;
#pragma unroll
    for (int g = 0; g < 3; ++g)
#pragma unroll
      for (int r = 0; r < 3; ++r) { sc[g][r] = sc[g][r] > -1e29f ? __expf(sc[g][r] - m) : 0.f; l += sc[g][r]; }
    l = wave_sum(l);
    float o = 0.f;
#pragma unroll
    for (int g = 0; g < 3; ++g) {
      const int d = g == 0 ? 1 : (g == 1 ? 4 : 16);
      const bf16_t* vb = base + 3072 + g * 512 + j * 64 + lane;
#pragma unroll
      for (int r = 0; r < 3; ++r) {
        const int ntl = r < 2 ? 64 : 1;
        for (int tl = 0; tl < ntl; ++tl) {
          const float pb = __uint_as_float(__builtin_amdgcn_readlane(__float_as_uint(sc[g][r]), tl));
          if (pb != 0.f) { const int pos = t + d * (tl + 64 * r - 64); o += pb * bf1(vb[(size_t)(s0 + pos) * 4608]); }
        }
      }
    }
    ya[(size_t)row * 512 + j * 64 + lane] = (bf16_t)(pk2(o / l, 0.f) & 0xffffu);
  }
}

DI void final_phase(const Params& p) {
  const int tid = opq_tid(), wid = tid >> 6, lane = tid & 63;
  const int bid = opq_bid(); const int gw = bid * 8 + wid, NGW = gridDim.x * 8;
  const float* ss3 = (const float*)(p.ws + OFF_SS) + (size_t)3 * T * 16; const float* g = p.in[16];
  f32x4 g4[4];
#pragma unroll
  for (int j = 0; j < 4; ++j) g4[j] = *(const f32x4*)(g + 4 * lane + 256 * j);
  for (int row = gw; row < T; row += NGW) {
    const float rs = rsqrtf(ss16(ss3 + (size_t)row * 16) * (1.0f / 1024.0f) + EPS);
    float* xr = p.out + (size_t)row * D;
#pragma unroll
    for (int j = 0; j < 4; ++j) { f32x4 v = *(const f32x4*)(xr + 4 * lane + 256 * j); v = v * rs * g4[j]; *(f32x4*)(xr + 4 * lane + 256 * j) = v; }
  }
}

enum { PT_GEMM = 0, PT_HGRN = 1, PT_COMBINE = 2, PT_ATTN0 = 3, PT_ATTN1 = 4, PT_FINAL = 5 };
__global__ void __launch_bounds__(512, 2) fwd_megakernel(Params p) {
  extern __shared__ __attribute__((aligned(16))) unsigned char shm[];
  cg::grid_group grid = cg::this_grid();
  prep_phase(p, shm);
  grid.sync();
  for (int ph = 0; ph < 17; ++ph) {
    const int type = p.ph[ph].type;
    if (type == PT_GEMM) {
      __syncthreads();
      if (threadIdx.x == 0) *(EpiP*)(shm + 131072) = p.ph[ph].e;
      __syncthreads();
      pg8::Gemm g; g.A = p.ph[ph].A; g.Bt = p.ph[ph].Bt; g.M = p.ph[ph].M; g.N = p.ph[ph].N; g.K = p.ph[ph].K;
      Epi E; E.lp = (const PG8_LAS EpiP*)((PG8_LAS unsigned char*)shm + 131072);
      pg8::StaticOrder S; S.init(g.M, g.N, (int)gridDim.x, opq_bid());
      pg8::gemm_phase<Epi, pg8::StaticOrder>((PG8_LAS unsigned char*)shm, g, S, E);
    } else if (type == PT_HGRN) hgrn_naive_phase(p, shm);
    else if (type == PT_COMBINE) combine_phase(p);
    else if (type == PT_ATTN0) attn_naive_phase(p, 0);
    else if (type == PT_ATTN1) attn_naive_phase(p, 1);
    else final_phase(p);
    if (ph < 16) grid.sync();
  }
}

static void fill_phases(Params& p) {
  unsigned char* ws = p.ws; unsigned char* big = ws + OFF_BIG;
  float* ssb = (float*)(ws + OFF_SS); bf16_t* xb = (bf16_t*)(ws + OFF_XB);
  float* ss0 = ssb; float* ss1 = ssb + (size_t)T * 16; float* ss2 = ssb + (size_t)2 * T * 16; float* ss3 = ssb + (size_t)3 * T * 16;
  const bf16_t* win = (const bf16_t*)(ws + OFF_WIN);
  auto gemm = [&](int i, const bf16_t* A, const bf16_t* Bt, int M, int N, int K) -> EpiP& {
    PhaseDesc& d = p.ph[i]; d.type = PT_GEMM; d.M = M; d.N = N; d.K = K; d.A = A; d.Bt = Bt; d.e.mode = M_BF16S; d.e.ldo = D; d.e.alpha = 1.0f; return d.e; };
  auto other = [&](int i, int type) { p.ph[i].type = type; };
  { EpiP& e = gemm(0, xb, (const bf16_t*)(ws + OFF_WGU1), T, 2 * FF, D); e.mode = M_SWIGLU; e.ss = ss0; e.ob = (bf16_t*)(big + B_ACT); }
  { EpiP& e = gemm(1, (const bf16_t*)(big + B_ACT), (const bf16_t*)(ws + OFF_WD1), T, D, FF); e.mode = M_RESID; e.alpha = 0.5f; e.of = p.out; e.r0 = p.in[0]; e.r1 = p.in[1]; e.ob = xb; e.ss_out = ss1; }
  { EpiP& e = gemm(2, xb, win + (size_t)4608 * D, T, 4096, D); e.ss = ss1; e.ob = (bf16_t*)(big + B_PROJH); e.ldo = 4096; }
  other(3, PT_HGRN);
  { EpiP& e = gemm(4, xb, win + (size_t)8704 * D, T, 1024, D); e.ss = ss1; e.ob = (bf16_t*)(big + B_HG); e.ldo = 1024; }
  other(5, PT_COMBINE);
  for (int half = 0; half < 2; ++half) {
    EpiP& e = gemm(6 + 2 * half, xb + (size_t)half * THALF * D, win, THALF, 4608, D); e.ss = ss1 + (size_t)half * THALF * 16; e.ob = (bf16_t*)(big + B_QKV); e.ldo = 4608;
    other(7 + 2 * half, half ? PT_ATTN1 : PT_ATTN0);
  }
  { EpiP& e = gemm(10, xb, win + (size_t)9728 * D, T, 2048, D); e.ss = ss1; e.sig = 1; e.ob = (bf16_t*)(big + B_SGA); e.ldo = 1024; e.split_tiles = 4; e.split_stride = (size_t)T * D; }
  { EpiP& e = gemm(11, (const bf16_t*)(big + B_YA), (const bf16_t*)(ws + OFF_WA), T, D, 512); e.mode = M_MUL; e.sg = (const bf16_t*)(big + B_SGA); e.of = (float*)(big + B_TMP); }
  { EpiP& e = gemm(12, (const bf16_t*)(big + B_YB), (const bf16_t*)(ws + OFF_WB), T, D, D); e.mode = M_FMA; e.sg = (const bf16_t*)(big + B_SGB); e.tmp = (const float*)(big + B_TMP); e.ob = (bf16_t*)(big + B_SGB); }
  { EpiP& e = gemm(13, (const bf16_t*)(big + B_SGB), (const bf16_t*)(ws + OFF_WO), T, D, D); e.mode = M_RESID; e.alpha = 1.0f; e.of = p.out; e.r0 = p.out; e.r1 = p.out + (size_t)TP * D; e.ob = xb; e.ss_out = ss2; }
  { EpiP& e = gemm(14, xb, (const bf16_t*)(ws + OFF_WGU2), T, 2 * FF, D); e.mode = M_SWIGLU; e.ss = ss2; e.ob = (bf16_t*)(big + B_ACT); }
  { EpiP& e = gemm(15, (const bf16_t*)(big + B_ACT), (const bf16_t*)(ws + OFF_WD2), T, D, FF); e.mode = M_RESID; e.alpha = 0.5f; e.of = p.out; e.r0 = p.out; e.r1 = p.out + (size_t)TP * D; e.ob = nullptr; e.ss_out = ss3; }
  other(16, PT_FINAL);
}

extern "C" void kernel_launch(void* const* d_in, const int* in_sizes, int n_in, void* d_out, int out_size, void* d_ws, size_t ws_size, hipStream_t stream) {
  constexpr int kDynLds = 131072 + 256;
  static int grid_blocks = 0;
  if (!grid_blocks) {
    if (n_in != 17 || out_size != T * D || ws_size < WS_NEED) { fprintf(stderr, "kernel_launch: unexpected shapes (n_in %d out %d ws %zu need %zu)\n", n_in, out_size, ws_size, (size_t)WS_NEED); grid_blocks = -1; return; }
    int dev = 0, cus = 0, per_cu = 0;
    (void)hipGetDevice(&dev);
    (void)hipDeviceGetAttribute(&cus, hipDeviceAttributeMultiprocessorCount, dev);
    (void)hipFuncSetAttribute((const void*)fwd_megakernel, hipFuncAttributeMaxDynamicSharedMemorySize, kDynLds);
    (void)hipOccupancyMaxActiveBlocksPerMultiprocessor(&per_cu, (const void*)fwd_megakernel, 512, kDynLds);
    if (per_cu < 1) per_cu = 1;
    grid_blocks = cus * per_cu;
  }
  if (grid_blocks < 0) return;
  static Params p;
  memset(&p, 0, sizeof(p));
  for (int i = 0; i < 17; ++i) p.in[i] = (const float*)d_in[i];
  p.out = (float*)d_out; p.ws = (unsigned char*)d_ws;
  fill_phases(p);
  void* args[] = {&p};
  hipError_t e = hipLaunchCooperativeKernel((const void*)fwd_megakernel, dim3(grid_blocks), dim3(512), args, kDynLds, stream);
  if (e != hipSuccess) fprintf(stderr, "cooperative launch failed: %s (grid %d)\n", hipGetErrorString(e), grid_blocks);
}
```

```cpp
#include <hip/hip_runtime.h>
#include <hip/hip_cooperative_groups.h>
#include <cstdio>
#include <cstdint>
#include <cstring>
namespace cg = cooperative_groups;
__device__ __forceinline__ int opq_tid() { int t = threadIdx.x; asm volatile("" : "+v"(t)); return t; }
__device__ __forceinline__ int opq_bid() { int b = blockIdx.x; asm volatile("" : "+s"(b)); return b; }
namespace pg8 {
#define PG8_LAS __attribute__((address_space(3)))
typedef unsigned short bf16_t;
typedef short bf16x8 __attribute__((ext_vector_type(8)));
typedef float f32x4 __attribute__((ext_vector_type(4)));
typedef unsigned u32x4 __attribute__((ext_vector_type(4)));
constexpr int BM = 256, BK = 64, HALF = 128, HTB = HALF * BK * 2  , STAGE_BYTES = 8 * HTB, NXCD = 8, WGM = 8;

__host__ __device__ __forceinline__ int lds_byte(int r, int c) { const int st = (r >> 4) * 2 + (c >> 5), rr = r & 15, cc = c & 31, ob = rr * 64 + cc * 2; return st * 1024 + (ob ^ (((ob >> 9) & 1) << 5)); }
__host__ __device__ __forceinline__ void stage_rc(int b, int& R, int& C) { const int st = b / 1024, sb = b % 1024, swz = sb ^ (((sb >> 9) & 1) << 5); R = (st >> 1) * 16 + swz / 64; C = (st & 1) * 32 + (swz % 64) / 2; }
__host__ __device__ __forceinline__ int perm32(int rho) { const int n = rho >> 4, i = rho & 15; return 8 * (i >> 2) + 4 * n + (i & 3); }

struct Unit { int pm, pn; };
struct Gemm { const bf16_t* A; const bf16_t* Bt; int M, N, K; };

struct StaticOrder {
    int nM, nN, nwg, G, c;
    __host__ __device__ void init(int M, int N, int G_, int c_) { nM = M / BM; nN = N / BM; nwg = nM * nN; G = G_; c = c_; }
    __host__ __device__ bool next(int i, Unit& u) const {
        const long L = (long)i * G + c; if (L >= nwg) return false;
        int wgid = (int)L; { const int q = nwg / NXCD, r = nwg % NXCD, xcd = wgid % NXCD, off = wgid / NXCD; wgid = (xcd < r ? xcd * (q + 1) : r * (q + 1) + (xcd - r) * q) + off; }
        const int nig = WGM * nN, gid = wgid / nig, fm = gid * WGM, gsz = (nM - fm) < WGM ? (nM - fm) : WGM;
        u.pm = fm + ((wgid % nig) % gsz); u.pn = (wgid % nig) / gsz; return true;
    }
    __device__ __forceinline__ void a_ready(const Unit&) const {}
    __device__ __forceinline__ void done(const Unit&) const {}
};
template <class Epi, class Sched>
__device__ __forceinline__ void gemm_phase(PG8_LAS unsigned char* lds, const Gemm g, const Sched& S, const Epi& E) {
    const int tid = opq_tid(), wid = __builtin_amdgcn_readfirstlane(tid >> 6), lane = tid & 63, wr = wid >> 2, wc = wid & 3, fr = lane & 15, fq = lane >> 4;
    const int K = g.K, nt = K / BK;
    unsigned voffA[2], voffB[2];
#pragma unroll
    for (int i = 0; i < 2; ++i) { int R, C; stage_rc(tid * 16 + i * 8192, R, C); const int Rb = Epi::PERM ? ((R & ~31) + perm32(R & 31)) : R;
        voffA[i] = (unsigned)(R * K + C) * 2u; voffB[i] = (unsigned)(Rb * K + C) * 2u; }
    const size_t kstep = (size_t)(BK * 2);
    const size_t hstep = (size_t)HALF * K * 2;
    const size_t tstep = 2 * hstep;
    const unsigned ldsw = (unsigned)wid * 1024u;
    const int aoff = lds_byte(wr * 64 + fr, fq * 8), boff = lds_byte(wc * 32 + fr, fq * 8);
#define PG8_SA(b, h) (((b) * 2 + (h)) * HTB)
#define PG8_SB(b, h) ((4 + (b) * 2 + (h)) * HTB)
#define PG8_STAGE(bufoff, gbase, voff) do { _Pragma("unroll") for (int _i = 0; _i < 2; ++_i) \
        __builtin_amdgcn_global_load_lds((const unsigned*)((const char*)(gbase) + (voff)[_i]), (PG8_LAS unsigned*)(lds + (bufoff) + ldsw + _i * 8192), 16, 0, 0); } while (0)
#define PG8_LDA(dst, b, h) do { _Pragma("unroll") for (int m = 0; m < 4; ++m) _Pragma("unroll") for (int k = 0; k < 2; ++k) dst[m][k] = *(const PG8_LAS bf16x8*)(lds + PG8_SA(b, h) + aoff + m * 2048 + k * 1024); } while (0)
#define PG8_LDB(dst, b, h) do { _Pragma("unroll") for (int n = 0; n < 2; ++n) _Pragma("unroll") for (int k = 0; k < 2; ++k) dst[n][k] = *(const PG8_LAS bf16x8*)(lds + PG8_SB(b, h) + boff + n * 2048 + k * 1024); } while (0)
#define PG8_MMA(ai, bj, At, Bt) do { __builtin_amdgcn_s_setprio(1); _Pragma("unroll") for (int m = 0; m < 4; ++m) _Pragma("unroll") for (int n = 0; n < 2; ++n) _Pragma("unroll") for (int k = 0; k < 2; ++k) \
        acc[ai][bj][m][n] = __builtin_amdgcn_mfma_f32_16x16x32_bf16(Bt[n][k], At[m][k], acc[ai][bj][m][n], 0, 0, 0); __builtin_amdgcn_s_setprio(0); } while (0)
#define PG8_WAIT_V(n) asm volatile("s_waitcnt vmcnt(" #n ")" ::: "memory")
#define PG8_WAIT_L(n) asm volatile("s_waitcnt lgkmcnt(" #n ")" ::: "memory")
#define PG8_BAR __builtin_amdgcn_s_barrier()
#define PG8_SCHED __builtin_amdgcn_sched_barrier(0)
    Unit cur, nxt; int ui = 0;
    if (!S.next(0, cur)) return;
    f32x4 acc[2][2][4][2];
#pragma unroll
    for (int a = 0; a < 2; ++a)
#pragma unroll
        for (int b = 0; b < 2; ++b)
#pragma unroll
            for (int m = 0; m < 4; ++m)
#pragma unroll
                for (int n = 0; n < 2; ++n) acc[a][b][m][n] = (f32x4){0.f, 0.f, 0.f, 0.f};
    bf16x8 At[4][2], B0[2][2], B1[2][2];
    const char* cA = (const char*)g.A + (size_t)cur.pm * tstep; const char* cB = (const char*)g.Bt + (size_t)cur.pn * tstep;
    S.a_ready(cur);
    PG8_STAGE(PG8_SB(0, 0), cB, voffB); PG8_STAGE(PG8_SA(0, 0), cA, voffA); PG8_STAGE(PG8_SB(0, 1), cB + hstep, voffB); PG8_STAGE(PG8_SA(0, 1), cA + hstep, voffA);
    if (wr == 1) PG8_BAR;
    PG8_WAIT_V(4); PG8_BAR;
    PG8_STAGE(PG8_SB(1, 0), cB + kstep, voffB); PG8_STAGE(PG8_SA(1, 0), cA + kstep, voffA); PG8_STAGE(PG8_SB(1, 1), cB + hstep + kstep, voffB);
    PG8_WAIT_V(6); PG8_BAR;
    for (;;) {
        const bool has_next = S.next(ui + 1, nxt);
        const char* nA = has_next ? (const char*)g.A + (size_t)nxt.pm * tstep : cA; const char* nB = has_next ? (const char*)g.Bt + (size_t)nxt.pn * tstep : cB;
        for (int t = 0; t < nt; t += 2) {
            const bool last = (t == nt - 2);
            const char* a1 = cA + (size_t)(t + 1) * kstep;
            const char* a2 = last ? nA : cA + (size_t)(t + 2) * kstep; const char* b2 = last ? nB : cB + (size_t)(t + 2) * kstep;
            const char* a3 = a2 + kstep; const char* b3 = b2 + kstep;
            if (last && has_next) S.a_ready(nxt);
            PG8_LDB(B0, 0, 0); PG8_SCHED; PG8_LDA(At, 0, 0); PG8_STAGE(PG8_SA(1, 1), a1 + hstep, voffA);
            PG8_WAIT_L(8); PG8_BAR; PG8_WAIT_L(0); PG8_MMA(0, 0, At, B0); PG8_BAR; PG8_SCHED;
            PG8_LDB(B1, 0, 1); PG8_STAGE(PG8_SB(0, 0), b2, voffB);
            PG8_BAR; PG8_WAIT_L(0); PG8_MMA(0, 1, At, B1); PG8_BAR;
            PG8_LDA(At, 0, 1); PG8_STAGE(PG8_SA(0, 0), a2, voffA);
            PG8_BAR; PG8_WAIT_L(0); PG8_MMA(1, 0, At, B0); PG8_BAR; PG8_SCHED;
            PG8_STAGE(PG8_SB(0, 1), b2 + hstep, voffB);
            PG8_WAIT_V(6); PG8_BAR; PG8_MMA(1, 1, At, B1); PG8_BAR;
            PG8_LDB(B0, 1, 0); PG8_SCHED; PG8_LDA(At, 1, 0); PG8_STAGE(PG8_SA(0, 1), a2 + hstep, voffA);
            PG8_WAIT_L(8); PG8_BAR; PG8_WAIT_L(0); PG8_MMA(0, 0, At, B0); PG8_BAR; PG8_SCHED;
            PG8_LDB(B1, 1, 1); PG8_STAGE(PG8_SB(1, 0), b3, voffB);
            PG8_BAR; PG8_WAIT_L(0); PG8_MMA(0, 1, At, B1); PG8_BAR;
            PG8_LDA(At, 1, 1); PG8_STAGE(PG8_SA(1, 0), a3, voffA);
            PG8_BAR; PG8_WAIT_L(0); PG8_MMA(1, 0, At, B0); PG8_BAR; PG8_SCHED;
            PG8_STAGE(PG8_SB(1, 1), b3 + hstep, voffB);
            PG8_WAIT_V(6); PG8_BAR; PG8_MMA(1, 1, At, B1); PG8_BAR;
        }
        if constexpr (!Epi::AFTER_DRAIN) { E(acc, cur, wr, wc, fr, fq); S.done(cur); }
        if (!has_next) break;
#pragma unroll
        for (int a = 0; a < 2; ++a)
#pragma unroll
            for (int b = 0; b < 2; ++b)
#pragma unroll
                for (int m = 0; m < 4; ++m)
#pragma unroll
                    for (int n = 0; n < 2; ++n) acc[a][b][m][n] = (f32x4){0.f, 0.f, 0.f, 0.f};
        cur = nxt; cA = nA; cB = nB; ++ui;
    }
    PG8_WAIT_V(0);
    if (wr == 0) PG8_BAR;
    PG8_BAR;
    if constexpr (Epi::AFTER_DRAIN) { E.fused(acc, cur, wr, wc, fr, fq, lds, wid, lane); S.done(cur); }
#undef PG8_SA
#undef PG8_SB
#undef PG8_STAGE
#undef PG8_LDA
#undef PG8_LDB
#undef PG8_MMA
#undef PG8_WAIT_V
#undef PG8_WAIT_L
#undef PG8_BAR
#undef PG8_SCHED
}
}

using pg8::f32x4; using pg8::bf16_t; using pg8::u32x4;
typedef unsigned u32x2 __attribute__((ext_vector_type(2)));
#define DI __device__ __forceinline__

constexpr int T = 49152, TP = 16384, D = 1024, FF = 2816, NIN = 11776, THALF = 24576;
constexpr float EPS = 1e-6f;

DI unsigned pk2(float lo, float hi) { unsigned r; asm volatile("v_cvt_pk_bf16_f32 %0, %1, %2" : "=v"(r) : "v"(lo), "v"(hi)); return r; }
DI float bflo(unsigned u) { return __uint_as_float(u << 16); }
DI float bfhi(unsigned u) { return __uint_as_float(u & 0xffff0000u); }
DI float bf1(bf16_t b) { return __uint_as_float(((unsigned)b) << 16); }
DI float sigm(float x) { return 1.0f / (1.0f + __expf(-x)); }
DI float wave_sum(float v) {
#pragma unroll
  for (int o = 1; o < 64; o <<= 1) v += __shfl_xor(v, o);
  return v;
}
DI float wave_max(float v) {
#pragma unroll
  for (int o = 1; o < 64; o <<= 1) v = fmaxf(v, __shfl_xor(v, o));
  return v;
}

DI float ss16(const float* p) { const f32x4 a = *(const f32x4*)p, b = *(const f32x4*)(p + 4), c = *(const f32x4*)(p + 8), d = *(const f32x4*)(p + 12);
  return ((a[0] + a[1]) + (a[2] + a[3])) + ((b[0] + b[1]) + (b[2] + b[3])) + ((c[0] + c[1]) + (c[2] + c[3])) + ((d[0] + d[1]) + (d[2] + d[3])); }
enum { M_SWIGLU = 0, M_BF16S = 1, M_RESID = 2, M_MUL = 3, M_FMA = 4 };

struct EpiP {
  int mode, sig, split_tiles, ldo;
  const float* ss; bf16_t* ob; size_t split_stride;
  float* of; const float* r0; const float* r1; float alpha; int pad; float* ss_out;
  const bf16_t* sg; const float* tmp;
};
struct Epi {
  static constexpr bool PERM = false, AFTER_DRAIN = false;
  const PG8_LAS EpiP* lp;
  __device__ __forceinline__ void operator()(const f32x4 (&acc)[2][2][4][2], const pg8::Unit& u, int wr, int wc, int fr, int fq) const {
    const int mode = lp->mode, sig = lp->sig, split_tiles = lp->split_tiles, ldo = lp->ldo;
    const float* ss = lp->ss; bf16_t* ob = lp->ob; const size_t split_stride = lp->split_stride;
    float* of = lp->of; const float* r0 = lp->r0; const float* r1 = lp->r1; const float alpha = lp->alpha; float* ss_out = lp->ss_out;
    const bf16_t* sg = lp->sg; const float* tmp = lp->tmp;
    const int rowb = u.pm * 256 + wr * 64 + fr;
    if (mode == M_SWIGLU) {
#pragma unroll
      for (int ai = 0; ai < 2; ++ai)
#pragma unroll
        for (int m = 0; m < 4; ++m) {
          const int row = rowb + ai * 128 + m * 16;
          const float rs = rsqrtf(ss16(ss + (size_t)row * 16) * (1.0f / 1024.0f) + EPS);
          float h[8];
#pragma unroll
          for (int n = 0; n < 2; ++n)
#pragma unroll
            for (int j = 0; j < 4; ++j) { const float a = acc[ai][0][m][n][j] * rs, b = acc[ai][1][m][n][j] * rs; h[n * 4 + j] = a * sigm(a) * b; }
          u32x4 w; w.x = pk2(h[0], h[1]); w.y = pk2(h[2], h[3]); w.z = pk2(h[4], h[5]); w.w = pk2(h[6], h[7]);
          *(u32x4*)(ob + (size_t)row * FF + u.pn * 128 + wc * 32 + fq * 8) = w;
        }
    } else if (mode == M_BF16S) {
      int pn = u.pn; bf16_t* base = ob;
      if (split_tiles) { const int t = pn / split_tiles; base += (size_t)t * split_stride; pn -= t * split_tiles; }
#pragma unroll
      for (int ai = 0; ai < 2; ++ai)
#pragma unroll
        for (int m = 0; m < 4; ++m) {
          const int row = rowb + ai * 128 + m * 16;
          const float rs = rsqrtf(ss16(ss + (size_t)row * 16) * (1.0f / 1024.0f) + EPS);
#pragma unroll
          for (int bj = 0; bj < 2; ++bj) {
            float v[8];
#pragma unroll
            for (int n = 0; n < 2; ++n)
#pragma unroll
              for (int j = 0; j < 4; ++j) { float x = acc[ai][bj][m][n][j] * rs; if (sig) x = sigm(x); v[n * 4 + j] = x; }
            u32x4 w; w.x = pk2(v[0], v[1]); w.y = pk2(v[2], v[3]); w.z = pk2(v[4], v[5]); w.w = pk2(v[6], v[7]);
            *(u32x4*)(base + (size_t)row * ldo + pn * 256 + bj * 128 + wc * 32 + fq * 8) = w;
          }
        }
    } else if (mode == M_RESID) {
#pragma unroll
      for (int ai = 0; ai < 2; ++ai)
#pragma unroll
        for (int m = 0; m < 4; ++m) {
          const int row = rowb + ai * 128 + m * 16;
          const float* rp = row < TP ? r0 + (size_t)row * D : r1 + (size_t)(row - TP) * D;
          float s2 = 0.f;
#pragma unroll
          for (int bj = 0; bj < 2; ++bj)
#pragma unroll
            for (int n = 0; n < 2; ++n) {
              const int c0 = u.pn * 256 + bj * 128 + wc * 32 + n * 16 + fq * 4;
              const f32x4 r = *(const f32x4*)(rp + c0);
              const f32x4 o = r + alpha * acc[ai][bj][m][n];
              *(f32x4*)(of + (size_t)row * D + c0) = o;
              if (ob) { u32x2 w; w.x = pk2(o[0], o[1]); w.y = pk2(o[2], o[3]); *(u32x2*)(ob + (size_t)row * D + c0) = w; }
              s2 += (o[0] * o[0] + o[1] * o[1]) + (o[2] * o[2] + o[3] * o[3]);
            }
          s2 += __shfl_xor(s2, 16); s2 += __shfl_xor(s2, 32);
          if (fq == 0) ss_out[(size_t)row * 16 + u.pn * 4 + wc] = s2;
        }
    } else {
#pragma unroll
      for (int ai = 0; ai < 2; ++ai)
#pragma unroll
        for (int m = 0; m < 4; ++m) {
          const int row = rowb + ai * 128 + m * 16;
#pragma unroll
          for (int bj = 0; bj < 2; ++bj)
#pragma unroll
            for (int n = 0; n < 2; ++n) {
              const int c0 = u.pn * 256 + bj * 128 + wc * 32 + n * 16 + fq * 4;
              const u32x2 g2 = *(const u32x2*)(sg + (size_t)row * D + c0);
              f32x4 gv; gv[0] = bflo(g2.x); gv[1] = bfhi(g2.x); gv[2] = bflo(g2.y); gv[3] = bfhi(g2.y);
              if (mode == M_MUL) {
                *(f32x4*)(of + (size_t)row * D + c0) = gv * acc[ai][bj][m][n];
              } else {
                const f32x4 t4 = *(const f32x4*)(tmp + (size_t)row * D + c0);
                const f32x4 o = t4 + gv * acc[ai][bj][m][n];
                u32x2 w; w.x = pk2(o[0], o[1]); w.y = pk2(o[2], o[3]); *(u32x2*)(ob + (size_t)row * D + c0) = w;
              }
            }
        }
    }
  }
};

constexpr size_t SZ_WGU = (size_t)2 * FF * D * 2, SZ_WD = (size_t)D * FF * 2, SZ_WIN = (size_t)NIN * D * 2;
constexpr size_t OFF_WGU1 = 0, OFF_WD1 = OFF_WGU1 + SZ_WGU, OFF_WGU2 = OFF_WD1 + SZ_WD, OFF_WD2 = OFF_WGU2 + SZ_WGU, OFF_WIN = OFF_WD2 + SZ_WD;
constexpr size_t OFF_WA = OFF_WIN + SZ_WIN, OFF_WB = OFF_WA + (size_t)D * 512 * 2, OFF_WO = OFF_WB + (size_t)D * D * 2, OFF_XB = OFF_WO + (size_t)D * D * 2;
constexpr size_t OFF_SS = OFF_XB + (size_t)T * D * 2, OFF_CTR = OFF_SS + (size_t)4 * T * 16 * 4, OFF_BIG = OFF_CTR + 256;
constexpr size_t B_ACT = 0, B_PROJH = 0, B_OFB = (size_t)T * 4096 * 2, B_HG = 0, B_YB = (size_t)T * D * 2, B_QKV = B_YB + (size_t)T * D * 2;
constexpr size_t B_OG = B_QKV + (size_t)THALF * 4608 * 2, B_LSE = B_OG + (size_t)3 * T * 512 * 2, B_YA = 0, B_SGA = B_QKV, B_SGB = B_SGA + (size_t)T * D * 2, B_TMP = B_SGB + (size_t)T * D * 2;
constexpr size_t WS_NEED = OFF_BIG + B_TMP + (size_t)T * D * 4;

struct PhaseDesc { int type, M, N, K; const bf16_t* A; const bf16_t* Bt; EpiP e; };
struct Params {
  const float* in[17];
  float* out; unsigned char* ws;
  PhaseDesc ph[18];
};

enum { MAP_NAT = 0, MAP_P32 = 1, MAP_GU = 2 };
DI int srccol(int map, int np) {
  if (map == MAP_NAT) return np;
  if (map == MAP_P32) return (np & ~31) + pg8::perm32(np & 31);
  const int pn = np >> 8, w = np & 255, bj = w >> 7, wc = (w & 127) >> 5, n = (w & 31) >> 4, fq = (w & 15) >> 2, j = w & 3;
  return bj * FF + 128 * pn + 32 * wc + 8 * fq + 4 * n + j;
}
DI void transpose_item(const float* W, int K, int Nsrc, const float* gain, bf16_t* WT, int map, float* scr, int item, int nblk, int lane) {
  const int kb = item / nblk, nb = item % nblk, k0 = 64 * kb, n0 = 32 * nb;
  const int sc = srccol(map, n0 + (lane & 31));
#pragma unroll 8
  for (int i = 0; i < 32; ++i) { const int kk = 2 * i + (lane >> 5); scr[kk * 33 + (lane & 31)] = W[(size_t)(k0 + kk) * Nsrc + sc]; }
  asm volatile("s_waitcnt lgkmcnt(0)" ::: "memory");
  const int c = lane & 7;
  float g8[8];
#pragma unroll
  for (int e = 0; e < 8; ++e) g8[e] = gain ? gain[k0 + 8 * c + e] : 1.0f;
#pragma unroll
  for (int j = 0; j < 4; ++j) {
    const int n = (lane >> 3) + 8 * j; const float* s = scr + (8 * c) * 33 + n;
    u32x4 o; o.x = pk2(s[0 * 33] * g8[0], s[1 * 33] * g8[1]); o.y = pk2(s[2 * 33] * g8[2], s[3 * 33] * g8[3]);
    o.z = pk2(s[4 * 33] * g8[4], s[5 * 33] * g8[5]); o.w = pk2(s[6 * 33] * g8[6], s[7 * 33] * g8[7]);
    *(u32x4*)(WT + (size_t)(n0 + n) * K + k0 + 8 * c) = o;
  }
  asm volatile("s_waitcnt lgkmcnt(0)" ::: "memory");
}

DI void prep_phase(const Params& p, unsigned char* shm) {
  const int tid = opq_tid(), wid = tid >> 6, lane = tid & 63;
  const int bid = opq_bid(); const int gw = bid * 8 + wid, NGW = gridDim.x * 8;
  unsigned char* ws = p.ws;
  if (bid == 0 && tid < 64) ((unsigned*)(ws + OFF_CTR))[tid] = 0u;
  { float* ss0 = (float*)(ws + OFF_SS); bf16_t* xb = (bf16_t*)(ws + OFF_XB);
    for (int row = gw; row < T; row += NGW) {
      const float* xr = row < TP ? p.in[0] + (size_t)row * D : p.in[1] + (size_t)(row - TP) * D;
      f32x4 v[4]; float s = 0.f;
#pragma unroll
      for (int j = 0; j < 4; ++j) { v[j] = *(const f32x4*)(xr + 4 * lane + 256 * j); s += (v[j][0] * v[j][0] + v[j][1] * v[j][1]) + (v[j][2] * v[j][2] + v[j][3] * v[j][3]); }
      s = wave_sum(s);
      if (lane < 16) ss0[(size_t)row * 16 + lane] = lane == 0 ? s : 0.f;
#pragma unroll
      for (int j = 0; j < 4; ++j) { u32x2 w; w.x = pk2(v[j][0], v[j][1]); w.y = pk2(v[j][2], v[j][3]); *(u32x2*)(xb + (size_t)row * D + 4 * lane + 256 * j) = w; }
    } }
  float* scr = (float*)(shm + wid * 8704);
  for (int wsel = 0; wsel < 8; ++wsel) {
    const float* W; const float* gain = nullptr; bf16_t* WT; int K, Nsrc, Nd, map;
    switch (wsel) {
      case 0: W = p.in[3]; gain = p.in[2]; WT = (bf16_t*)(ws + OFF_WGU1); K = D; Nsrc = 2 * FF; Nd = 2 * FF; map = MAP_GU; break;
      case 1: W = p.in[4]; WT = (bf16_t*)(ws + OFF_WD1); K = FF; Nsrc = D; Nd = D; map = MAP_NAT; break;
      case 2: W = p.in[6]; gain = p.in[5]; WT = (bf16_t*)(ws + OFF_WIN); K = D; Nsrc = NIN; Nd = NIN; map = MAP_P32; break;
      case 3: W = p.in[10]; WT = (bf16_t*)(ws + OFF_WA); K = 512; Nsrc = D; Nd = D; map = MAP_NAT; break;
      case 4: W = p.in[11]; WT = (bf16_t*)(ws + OFF_WB); K = D; Nsrc = D; Nd = D; map = MAP_NAT; break;
      case 5: W = p.in[12]; WT = (bf16_t*)(ws + OFF_WO); K = D; Nsrc = D; Nd = D; map = MAP_NAT; break;
      case 6: W = p.in[14]; gain = p.in[13]; WT = (bf16_t*)(ws + OFF_WGU2); K = D; Nsrc = 2 * FF; Nd = 2 * FF; map = MAP_GU; break;
      default: W = p.in[15]; WT = (bf16_t*)(ws + OFF_WD2); K = FF; Nsrc = D; Nd = D; map = MAP_NAT; break;
    }
    const int nblk = Nd / 32, nitems = (K / 64) * nblk;
    for (int it = gw; it < nitems; it += NGW) transpose_item(W, K, Nsrc, gain, WT, map, scr, it, nblk, lane);
  }
}

DI void hgrn_naive_phase(const Params& p, unsigned char* shm) {
  const int chain = opq_bid();
  if (chain >= 128) return;
  const int tid = opq_tid(), wid = tid >> 6, lane = tid & 63;
  const int seq = chain >> 4, head = (chain >> 1) & 7, dir = chain & 1;
  const int slen = seq < 4 ? 4096 : 8192, row0 = seq < 4 ? seq * 4096 : TP + (seq - 4) * 8192;
  const bf16_t* pj = (const bf16_t*)(p.ws + OFF_BIG + B_PROJH);
  bf16_t* od = (bf16_t*)(p.ws + OFF_BIG + B_OFB) + (size_t)dir * T * D;
  const float* lbw = dir ? p.in[8] : p.in[7];
  float* gq = (float*)shm; float* gf = gq + 2048; float* gk = gf + 2048; float* gv = gk + 2048;
  const int vl = lane & 15, kq = lane >> 4, v = 16 * wid + vl;
  float S[32];
#pragma unroll
  for (int i = 0; i < 32; ++i) S[i] = 0.f;
  const int fk = tid & 127;
  const float lb = 1.0f / (1.0f + __expf(lbw[D + head * 128 + fk] - lbw[head * 128 + fk]));
  for (int i0 = 0; i0 < slen; i0 += 16) {
    __syncthreads();
#pragma unroll
    for (int r = 0; r < 4; ++r) {
      const int tt = (tid >> 7) + 4 * r; const int t = dir ? slen - 1 - (i0 + tt) : i0 + tt; const size_t rb = (size_t)(row0 + t) * 4096 + head * 128 + fk;
      const float hq = bf1(pj[rb]), hf = bf1(pj[rb + 1024 * (1 + dir)]), hi = bf1(pj[rb + 3072]);
      const float s = sigm(hf);
      gq[tt * 128 + fk] = hq * sigm(hq); gf[tt * 128 + fk] = lb + (1.0f - lb) * s; gk[tt * 128 + fk] = (1.0f - lb) * (1.0f - s); gv[tt * 128 + fk] = hi;
    }
    __syncthreads();
    for (int tt = 0; tt < 16; ++tt) {
      const float val = gv[tt * 128 + v]; float o = 0.f;
#pragma unroll
      for (int k4 = 0; k4 < 8; ++k4) {
        const f32x4 f4 = *(const f32x4*)(gf + tt * 128 + 32 * kq + 4 * k4), k4v = *(const f32x4*)(gk + tt * 128 + 32 * kq + 4 * k4), q4 = *(const f32x4*)(gq + tt * 128 + 32 * kq + 4 * k4);
#pragma unroll
        for (int e = 0; e < 4; ++e) { S[4 * k4 + e] = f4[e] * S[4 * k4 + e] + k4v[e] * val; o += q4[e] * S[4 * k4 + e]; }
      }
      o += __shfl_xor(o, 16); o += __shfl_xor(o, 32);
      const int t = dir ? slen - 1 - (i0 + tt) : i0 + tt;
      if (kq == 0) od[(size_t)(row0 + t) * D + head * 128 + v] = (bf16_t)(pk2(o, 0.f) & 0xffffu);
    }
  }
}

DI void combine_phase(const Params& p) {
  const int tid = opq_tid(), wid = tid >> 6, lane = tid & 63;
  const int bid = opq_bid(); const int gw = bid * 8 + wid, NGW = gridDim.x * 8;
  const bf16_t* oF = (const bf16_t*)(p.ws + OFF_BIG + B_OFB); const bf16_t* oB = oF + (size_t)T * D;
  const bf16_t* hg = (const bf16_t*)(p.ws + OFF_BIG + B_HG); bf16_t* yb = (bf16_t*)(p.ws + OFF_BIG + B_YB);
  const float* ng = p.in[9];
  const int c0 = lane * 16;
  float g[16];
#pragma unroll
  for (int i = 0; i < 16; ++i) g[i] = ng[c0 + i];
  for (int row = gw; row < T; row += NGW) {
    const size_t b = (size_t)row * D + c0;
    float o[16]; float s = 0.f;
#pragma unroll
    for (int h = 0; h < 2; ++h) {
      const u32x4 a = *(const u32x4*)(oF + b + 8 * h), c = *(const u32x4*)(oB + b + 8 * h);
#pragma unroll
      for (int e = 0; e < 4; ++e) { o[8 * h + 2 * e] = bflo(a[e]) + bflo(c[e]); o[8 * h + 2 * e + 1] = bfhi(a[e]) + bfhi(c[e]); }
    }
#pragma unroll
    for (int i = 0; i < 16; ++i) s += o[i] * o[i];
    s += __shfl_xor(s, 1); s += __shfl_xor(s, 2); s += __shfl_xor(s, 4);
    const float rs = rsqrtf(s * (1.0f / 128.0f) + EPS);
#pragma unroll
    for (int h = 0; h < 2; ++h) {
      const u32x4 gg = *(const u32x4*)(hg + b + 8 * h); u32x4 w;
#pragma unroll
      for (int e = 0; e < 4; ++e) {
        const float g0 = bflo(gg[e]), g1 = bfhi(gg[e]);
        w[e] = pk2(o[8 * h + 2 * e] * rs * g[8 * h + 2 * e] * g0 * sigm(g0), o[8 * h + 2 * e + 1] * rs * g[8 * h + 2 * e + 1] * g1 * sigm(g1));
      }
      *(u32x4*)(yb + b + 8 * h) = w;
    }
  }
}

DI void attn_naive_phase(const Params& p, int half) {
  const int tid = opq_tid(), wid = tid >> 6, lane = tid & 63;
  const int bid = opq_bid(); const int gw = bid * 8 + wid, NGW = gridDim.x * 8;
  const int row_base = half * THALF;
  const bf16_t* base = (const bf16_t*)(p.ws + OFF_BIG + B_QKV) - (size_t)row_base * 4608;
  bf16_t* ya = (bf16_t*)(p.ws + OFF_BIG + B_YA);
  for (int unit = gw; unit < THALF * 8; unit += NGW) {
    const int row = row_base + (unit >> 3), j = unit & 7;
    int s0, slen; if (row < TP) { s0 = row & ~4095; slen = 4096; } else { s0 = TP + ((row - TP) & ~8191); slen = 8192; }
    const int t = row - s0;
    const float slope = exp2f(-(float)(j + 1));
    float sc[3][3];
#pragma unroll
    for (int g = 0; g < 3; ++g) {
      const int d = g == 0 ? 1 : (g == 1 ? 4 : 16);
      u32x4 qv[8];
      { const u32x4* qp = (const u32x4*)(base + (size_t)row * 4608 + g * 512 + j * 64);
#pragma unroll
        for (int i = 0; i < 8; ++i) qv[i] = qp[i]; }
#pragma unroll
      for (int r = 0; r < 3; ++r) {
        const int joff = lane + 64 * r - 64; const int pos = t + d * joff;
        const bool valid = (r < 2 || lane == 0) && pos >= 0 && pos < slen;
        float s = -1e30f;
        if (valid) {
          const u32x4* kp = (const u32x4*)(base + (size_t)(s0 + pos) * 4608 + 1536 + g * 512 + j * 64);
          float dot = 0.f;
#pragma unroll
          for (int i = 0; i < 8; ++i) { const u32x4 kv = kp[i];
#pragma unroll
            for (int e = 0; e < 4; ++e) dot += bflo(kv[e]) * bflo(qv[i][e]) + bfhi(kv[e]) * bfhi(qv[i][e]); }
          s = dot * 0.125f - slope * (float)(d * (joff < 0 ? -joff : joff));
        }
        sc[g][r] = s;
      }
    }
    float m = -1e30f;
#pragma unroll
    for (int g = 0; g < 3; ++g)
#pragma unroll
      for (int r = 0; r < 3; ++r) m = fmaxf(m, sc[g][r]);
    m = wave_max(m);
    float l = 0.f;
#pragma unroll
    for (int g = 0; g < 3; ++g)
#pragma unroll
      for (int r = 0; r < 3; ++r) { sc[g][r] = sc[g][r] > -1e29f ? __expf(sc[g][r] - m) : 0.f; l += sc[g][r]; }
    l = wave_sum(l);
    float o = 0.f;
#pragma unroll
    for (int g = 0; g < 3; ++g) {
      const int d = g == 0 ? 1 : (g == 1 ? 4 : 16);
      const bf16_t* vb = base + 3072 + g * 512 + j * 64 + lane;
#pragma unroll
      for (int r = 0; r < 3; ++r) {
        const int ntl = r < 2 ? 64 : 1;
        for (int tl = 0; tl < ntl; ++tl) {
          const float pb = __uint_as_float(__builtin_amdgcn_readlane(__float_as_uint(sc[g][r]), tl));
          if (pb != 0.f) { const int pos = t + d * (tl + 64 * r - 64); o += pb * bf1(vb[(size_t)(s0 + pos) * 4608]); }
        }
      }
    }
    ya[(size_t)row * 512 + j * 64 + lane] = (bf16_t)(pk2(o / l, 0.f) & 0xffffu);
  }
}


typedef float f32x16 __attribute__((ext_vector_type(16)));
typedef short s16x4 __attribute__((ext_vector_type(4)));
typedef __bf16 bf16v2_t __attribute__((ext_vector_type(2)));
typedef float f32v2_t __attribute__((ext_vector_type(2)));
DI unsigned pk2c(float a, float b) { f32v2_t v = {a, b}; bf16v2_t r = __builtin_convertvector(v, bf16v2_t); return __builtin_bit_cast(unsigned, r); }
#define MFMA32(a, b, c) __builtin_amdgcn_mfma_f32_32x32x16_bf16((a), (b), (c), 0, 0, 0)
DI int crow(int i, int h) { return (i & 3) + 8 * (i >> 2) + 4 * h; }
DI void tr_read4(unsigned a0, unsigned a1, unsigned a2, unsigned a3, s16x4& r0, s16x4& r1, s16x4& r2, s16x4& r3) {
  asm volatile("ds_read_b64_tr_b16 %0, %4\n\tds_read_b64_tr_b16 %1, %5\n\tds_read_b64_tr_b16 %2, %6\n\tds_read_b64_tr_b16 %3, %7\n\ts_waitcnt lgkmcnt(0)"
               : "=&v"(r0), "=&v"(r1), "=&v"(r2), "=&v"(r3) : "v"(a0), "v"(a1), "v"(a2), "v"(a3) : "memory");
}
constexpr int AROW = 144;
constexpr int AV_OFF = 384 * AROW;

DI void attn_phase(const Params& p, int half, unsigned char* shm) {
  const int tid = opq_tid(), wid = tid >> 6, lane = tid & 63, bid = opq_bid();
  const int q32 = lane & 31, h = lane >> 5;
  const bf16_t* qkv = (const bf16_t*)(p.ws + OFF_BIG + B_QKV);
  bf16_t* og = (bf16_t*)(p.ws + OFF_BIG + B_OG);
  float* ml = (float*)(p.ws + OFF_BIG + B_LSE);
  const unsigned lbase = (unsigned)(size_t)(PG8_LAS unsigned char*)shm;
  for (int unit = bid; unit < 2304; unit += (int)gridDim.x) {
    const int g = unit / 768, rem = unit % 768, j = rem & 7, cidx = rem >> 3;
    const int d = g == 0 ? 1 : (g == 1 ? 4 : 16);
    int seq_row0, S, w;
    if (half == 0) { if (cidx < 64) { seq_row0 = (cidx >> 4) * 4096; S = 4096; w = cidx & 15; } else { seq_row0 = TP; S = 8192; w = cidx - 64; } }
    else { seq_row0 = TP + (1 + (cidx >> 5)) * 8192; S = 8192; w = cidx & 31; }
    const int r = w % d, c = w / d, L = S / d;
    const int lrow0 = seq_row0 - half * THALF;
    const int ki0 = 256 * c - 64;
    const size_t colq = (size_t)g * 512 + j * 64;
    __syncthreads();
#pragma unroll
    for (int it = 0; it < 6; ++it) {
      const int idx = tid + 512 * it, slot = idx >> 3, ch = idx & 7, ki = ki0 + slot;
      u32x4 kv = {0u, 0u, 0u, 0u}, vv = {0u, 0u, 0u, 0u};
      if (ki >= 0 && ki < L) { const bf16_t* rp = qkv + (size_t)(lrow0 + r + d * ki) * 4608 + colq + ch * 8; kv = *(const u32x4*)(rp + 1536); vv = *(const u32x4*)(rp + 3072); }
      *(u32x4*)(shm + slot * AROW + ch * 16) = kv; *(u32x4*)(shm + AV_OFF + slot * AROW + ch * 16) = vv;
    }
    pg8::bf16x8 qf[4];
    { const bf16_t* qp = qkv + (size_t)(lrow0 + r + d * (256 * c + 32 * wid + q32)) * 4608 + colq + 8 * h;
#pragma unroll
      for (int ks = 0; ks < 4; ++ks) qf[ks] = *(const pg8::bf16x8*)(qp + 16 * ks); }
    __syncthreads();
    f32x16 st[5];
#pragma unroll
    for (int kt = 0; kt < 5; ++kt) {
#pragma unroll
      for (int i = 0; i < 16; ++i) st[kt][i] = 0.f;
#pragma unroll
      for (int ks = 0; ks < 4; ++ks) {
        const pg8::bf16x8 kf = *(const pg8::bf16x8*)(shm + (32 * wid + 32 * kt + q32) * AROW + (16 * ks + 8 * h) * 2);
        st[kt] = MFMA32(kf, qf[ks], st[kt]);
      }
    }
    const float slope_d = exp2f(-(float)(j + 1)) * (float)d;
    int hu = h, qu = q32; asm volatile("" : "+v"(hu), "+v"(qu));
    float m = -1e30f;
#pragma unroll
    for (int kt = 0; kt < 5; ++kt)
#pragma unroll
      for (int i = 0; i < 16; ++i) {
        const int rel = 32 * kt + crow(i, hu) - qu - 64; const int ki = ki0 + 32 * wid + 32 * kt + crow(i, hu);
        const int arel = rel < 0 ? -rel : rel;
        const bool valid = arel <= 64 && ki >= 0 && ki < L;
        const float s = valid ? st[kt][i] * 0.125f - slope_d * (float)arel : -1e30f;
        st[kt][i] = s; m = fmaxf(m, s);
      }
    m = fmaxf(m, __shfl_xor(m, 32));
    float l = 0.f;
#pragma unroll
    for (int kt = 0; kt < 5; ++kt)
#pragma unroll
      for (int i = 0; i < 16; ++i) { const float s = st[kt][i]; const float e = s > -1e29f ? __expf(s - m) : 0.f; st[kt][i] = e; l += e; }
    l += __shfl_xor(l, 32);
    f32x16 o[2];
#pragma unroll
    for (int et = 0; et < 2; ++et)
#pragma unroll
      for (int i = 0; i < 16; ++i) o[et][i] = 0.f;
    const int i16 = lane & 15, q4 = i16 >> 2, p4 = i16 & 3, blk = (lane >> 4) & 1;
    const unsigned vaddr0 = lbase + AV_OFF + (32 * wid + 4 * h + q4) * AROW + 32 * blk + 8 * p4;
#pragma unroll
    for (int kt = 0; kt < 5; ++kt)
#pragma unroll
      for (int s2 = 0; s2 < 2; ++s2) {
        u32x4 pw; pw.x = pk2c(st[kt][8 * s2 + 0], st[kt][8 * s2 + 1]); pw.y = pk2c(st[kt][8 * s2 + 2], st[kt][8 * s2 + 3]);
        pw.z = pk2c(st[kt][8 * s2 + 4], st[kt][8 * s2 + 5]); pw.w = pk2c(st[kt][8 * s2 + 6], st[kt][8 * s2 + 7]);
        const pg8::bf16x8 pa = __builtin_bit_cast(pg8::bf16x8, pw);
        const unsigned a = vaddr0 + (32 * kt + 16 * s2) * AROW;
        s16x4 lo0, hi0, lo1, hi1;
        tr_read4(a, a + 8 * AROW, a + 64, a + 8 * AROW + 64, lo0, hi0, lo1, hi1);
        const pg8::bf16x8 v0 = __builtin_shufflevector(lo0, hi0, 0, 1, 2, 3, 4, 5, 6, 7), v1 = __builtin_shufflevector(lo1, hi1, 0, 1, 2, 3, 4, 5, 6, 7);
        o[0] = MFMA32(pa, v0, o[0]); o[1] = MFMA32(pa, v1, o[1]);
      }
    const int rowq0 = half * THALF + lrow0 + r + d * (256 * c + 32 * wid);
#pragma unroll
    for (int et = 0; et < 2; ++et)
#pragma unroll
      for (int i = 0; i < 16; ++i) {
        const int row = rowq0 + d * crow(i, h);
        og[((size_t)g * T + row) * 512 + j * 64 + 32 * et + q32] = (bf16_t)(pk2c(o[et][i], 0.f) & 0xffffu);
      }
    if (h == 0) { const int row = rowq0 + d * q32; f32v2_t v = {m, l}; *(f32v2_t*)(ml + (((size_t)g * T + row) * 8 + j) * 2) = v; }
  }
}

DI void merge_phase(const Params& p) {
  const int tid = opq_tid(), wid = tid >> 6, lane = tid & 63;
  const int bid = opq_bid(); const int gw = bid * 8 + wid, NGW = gridDim.x * 8;
  const bf16_t* og = (const bf16_t*)(p.ws + OFF_BIG + B_OG); const float* ml = (const float*)(p.ws + OFF_BIG + B_LSE);
  bf16_t* ya = (bf16_t*)(p.ws + OFF_BIG + B_YA);
  const int c0 = lane * 8, j = lane >> 3;
  for (int row = gw; row < T; row += NGW) {
    float mg[3], lg[3];
#pragma unroll
    for (int g = 0; g < 3; ++g) { const f32v2_t v = *(const f32v2_t*)(ml + (((size_t)g * T + row) * 8 + j) * 2); mg[g] = v[0]; lg[g] = v[1]; }
    const float M = fmaxf(mg[0], fmaxf(mg[1], mg[2]));
    float acc[8]; float den = 0.f;
#pragma unroll
    for (int e = 0; e < 8; ++e) acc[e] = 0.f;
#pragma unroll
    for (int g = 0; g < 3; ++g) {
      const float wg = __expf(mg[g] - M); den += wg * lg[g];
      const u32x4 a = *(const u32x4*)(og + ((size_t)g * T + row) * 512 + c0);
#pragma unroll
      for (int e = 0; e < 4; ++e) { acc[2 * e] += wg * bflo(a[e]); acc[2 * e + 1] += wg * bfhi(a[e]); }
    }
    const float inv = 1.0f / den;
    u32x4 w; w.x = pk2c(acc[0] * inv, acc[1] * inv); w.y = pk2c(acc[2] * inv, acc[3] * inv); w.z = pk2c(acc[4] * inv, acc[5] * inv); w.w = pk2c(acc[6] * inv, acc[7] * inv);
    *(u32x4*)(ya + (size_t)row * 512 + c0) = w;
  }
}

DI void final_phase(const Params& p) {
  const int tid = opq_tid(), wid = tid >> 6, lane = tid & 63;
  const int bid = opq_bid(); const int gw = bid * 8 + wid, NGW = gridDim.x * 8;
  const float* ss3 = (const float*)(p.ws + OFF_SS) + (size_t)3 * T * 16; const float* g = p.in[16];
  f32x4 g4[4];
#pragma unroll
  for (int j = 0; j < 4; ++j) g4[j] = *(const f32x4*)(g + 4 * lane + 256 * j);
  for (int row = gw; row < T; row += NGW) {
    const float rs = rsqrtf(ss16(ss3 + (size_t)row * 16) * (1.0f / 1024.0f) + EPS);
    float* xr = p.out + (size_t)row * D;
#pragma unroll
    for (int j = 0; j < 4; ++j) { f32x4 v = *(const f32x4*)(xr + 4 * lane + 256 * j); v = v * rs * g4[j]; *(f32x4*)(xr + 4 * lane + 256 * j) = v; }
  }
}

enum { PT_GEMM = 0, PT_HGRN = 1, PT_COMBINE = 2, PT_ATTN0 = 3, PT_ATTN1 = 4, PT_FINAL = 5, PT_MERGE = 6 };
constexpr int NPH = 18;
__global__ void __launch_bounds__(512, 2) fwd_megakernel(Params p) {
  extern __shared__ __attribute__((aligned(16))) unsigned char shm[];
  cg::grid_group grid = cg::this_grid();
  prep_phase(p, shm);
  grid.sync();
  for (int ph = 0; ph < NPH; ++ph) {
    const int type = p.ph[ph].type;
    if (type == PT_GEMM) {
      __syncthreads();
      if (threadIdx.x == 0) *(EpiP*)(shm + 131072) = p.ph[ph].e;
      __syncthreads();
      pg8::Gemm g; g.A = p.ph[ph].A; g.Bt = p.ph[ph].Bt; g.M = p.ph[ph].M; g.N = p.ph[ph].N; g.K = p.ph[ph].K;
      Epi E; E.lp = (const PG8_LAS EpiP*)((PG8_LAS unsigned char*)shm + 131072);
      pg8::StaticOrder S; S.init(g.M, g.N, (int)gridDim.x, opq_bid());
      pg8::gemm_phase<Epi, pg8::StaticOrder>((PG8_LAS unsigned char*)shm, g, S, E);
    } else if (type == PT_HGRN) hgrn_naive_phase(p, shm);
    else if (type == PT_COMBINE) combine_phase(p);
    else if (type == PT_ATTN0) attn_phase(p, 0, shm);
    else if (type == PT_ATTN1) attn_phase(p, 1, shm);
    else if (type == PT_MERGE) merge_phase(p);
    else final_phase(p);
    if (ph < NPH - 1) grid.sync();
  }
}

static void fill_phases(Params& p) {
  unsigned char* ws = p.ws; unsigned char* big = ws + OFF_BIG;
  float* ssb = (float*)(ws + OFF_SS); bf16_t* xb = (bf16_t*)(ws + OFF_XB);
  float* ss0 = ssb; float* ss1 = ssb + (size_t)T * 16; float* ss2 = ssb + (size_t)2 * T * 16; float* ss3 = ssb + (size_t)3 * T * 16;
  const bf16_t* win = (const bf16_t*)(ws + OFF_WIN);
  auto gemm = [&](int i, const bf16_t* A, const bf16_t* Bt, int M, int N, int K) -> EpiP& {
    PhaseDesc& d = p.ph[i]; d.type = PT_GEMM; d.M = M; d.N = N; d.K = K; d.A = A; d.Bt = Bt; d.e.mode = M_BF16S; d.e.ldo = D; d.e.alpha = 1.0f; return d.e; };
  auto other = [&](int i, int type) { p.ph[i].type = type; };
  { EpiP& e = gemm(0, xb, (const bf16_t*)(ws + OFF_WGU1), T, 2 * FF, D); e.mode = M_SWIGLU; e.ss = ss0; e.ob = (bf16_t*)(big + B_ACT); }
  { EpiP& e = gemm(1, (const bf16_t*)(big + B_ACT), (const bf16_t*)(ws + OFF_WD1), T, D, FF); e.mode = M_RESID; e.alpha = 0.5f; e.of = p.out; e.r0 = p.in[0]; e.r1 = p.in[1]; e.ob = xb; e.ss_out = ss1; }
  { EpiP& e = gemm(2, xb, win + (size_t)4608 * D, T, 4096, D); e.ss = ss1; e.ob = (bf16_t*)(big + B_PROJH); e.ldo = 4096; }
  other(3, PT_HGRN);
  { EpiP& e = gemm(4, xb, win + (size_t)8704 * D, T, 1024, D); e.ss = ss1; e.ob = (bf16_t*)(big + B_HG); e.ldo = 1024; }
  other(5, PT_COMBINE);
  for (int half = 0; half < 2; ++half) {
    EpiP& e = gemm(6 + 2 * half, xb + (size_t)half * THALF * D, win, THALF, 4608, D); e.ss = ss1 + (size_t)half * THALF * 16; e.ob = (bf16_t*)(big + B_QKV); e.ldo = 4608;
    other(7 + 2 * half, half ? PT_ATTN1 : PT_ATTN0);
  }
  other(10, PT_MERGE);
  { EpiP& e = gemm(11, xb, win + (size_t)9728 * D, T, 2048, D); e.ss = ss1; e.sig = 1; e.ob = (bf16_t*)(big + B_SGA); e.ldo = 1024; e.split_tiles = 4; e.split_stride = (size_t)T * D; }
  { EpiP& e = gemm(12, (const bf16_t*)(big + B_YA), (const bf16_t*)(ws + OFF_WA), T, D, 512); e.mode = M_MUL; e.sg = (const bf16_t*)(big + B_SGA); e.of = (float*)(big + B_TMP); }
  { EpiP& e = gemm(13, (const bf16_t*)(big + B_YB), (const bf16_t*)(ws + OFF_WB), T, D, D); e.mode = M_FMA; e.sg = (const bf16_t*)(big + B_SGB); e.tmp = (const float*)(big + B_TMP); e.ob = (bf16_t*)(big + B_SGB); }
  { EpiP& e = gemm(14, (const bf16_t*)(big + B_SGB), (const bf16_t*)(ws + OFF_WO), T, D, D); e.mode = M_RESID; e.alpha = 1.0f; e.of = p.out; e.r0 = p.out; e.r1 = p.out + (size_t)TP * D; e.ob = xb; e.ss_out = ss2; }
  { EpiP& e = gemm(15, xb, (const bf16_t*)(ws + OFF_WGU2), T, 2 * FF, D); e.mode = M_SWIGLU; e.ss = ss2; e.ob = (bf16_t*)(big + B_ACT); }
  { EpiP& e = gemm(16, (const bf16_t*)(big + B_ACT), (const bf16_t*)(ws + OFF_WD2), T, D, FF); e.mode = M_RESID; e.alpha = 0.5f; e.of = p.out; e.r0 = p.out; e.r1 = p.out + (size_t)TP * D; e.ob = nullptr; e.ss_out = ss3; }
  other(17, PT_FINAL);
}

extern "C" void kernel_launch(void* const* d_in, const int* in_sizes, int n_in, void* d_out, int out_size, void* d_ws, size_t ws_size, hipStream_t stream) {
  constexpr int kDynLds = 131072 + 256;
  static int grid_blocks = 0;
  if (!grid_blocks) {
    if (n_in != 17 || out_size != T * D || ws_size < WS_NEED) { fprintf(stderr, "kernel_launch: unexpected shapes (n_in %d out %d ws %zu need %zu)\n", n_in, out_size, ws_size, (size_t)WS_NEED); grid_blocks = -1; return; }
    int dev = 0, cus = 0, per_cu = 0;
    (void)hipGetDevice(&dev);
    (void)hipDeviceGetAttribute(&cus, hipDeviceAttributeMultiprocessorCount, dev);
    (void)hipFuncSetAttribute((const void*)fwd_megakernel, hipFuncAttributeMaxDynamicSharedMemorySize, kDynLds);
    (void)hipOccupancyMaxActiveBlocksPerMultiprocessor(&per_cu, (const void*)fwd_megakernel, 512, kDynLds);
    if (per_cu < 1) per_cu = 1;
    grid_blocks = cus * per_cu;
  }
  if (grid_blocks < 0) return;
  static Params p;
  memset(&p, 0, sizeof(p));
  for (int i = 0; i < 17; ++i) p.in[i] = (const float*)d_in[i];
  p.out = (float*)d_out; p.ws = (unsigned char*)d_ws;
  fill_phases(p);
  void* args[] = {&p};
  hipError_t e = hipLaunchCooperativeKernel((const void*)fwd_megakernel, dim3(grid_blocks), dim3(512), args, kDynLds, stream);
  if (e != hipSuccess) fprintf(stderr, "cooperative launch failed: %s (grid %d)\n", hipGetErrorString(e), grid_blocks);
}
```

```cpp
#include <hip/hip_runtime.h>
#include <hip/hip_cooperative_groups.h>
#include <cstdio>
#include <cstdint>
#include <cstring>
namespace cg = cooperative_groups;
__device__ __forceinline__ int opq_tid() { int t = threadIdx.x; asm volatile("" : "+v"(t)); return t; }
__device__ __forceinline__ int opq_bid() { int b = blockIdx.x; asm volatile("" : "+s"(b)); return b; }
namespace pg8 {
#define PG8_LAS __attribute__((address_space(3)))
typedef unsigned short bf16_t;
typedef short bf16x8 __attribute__((ext_vector_type(8)));
typedef float f32x4 __attribute__((ext_vector_type(4)));
typedef unsigned u32x4 __attribute__((ext_vector_type(4)));
constexpr int BM = 256, BK = 64, HALF = 128, HTB = HALF * BK * 2  , STAGE_BYTES = 8 * HTB, NXCD = 8, WGM = 8;

__host__ __device__ __forceinline__ int lds_byte(int r, int c) { const int st = (r >> 4) * 2 + (c >> 5), rr = r & 15, cc = c & 31, ob = rr * 64 + cc * 2; return st * 1024 + (ob ^ (((ob >> 9) & 1) << 5)); }
__host__ __device__ __forceinline__ void stage_rc(int b, int& R, int& C) { const int st = b / 1024, sb = b % 1024, swz = sb ^ (((sb >> 9) & 1) << 5); R = (st >> 1) * 16 + swz / 64; C = (st & 1) * 32 + (swz % 64) / 2; }
__host__ __device__ __forceinline__ int perm32(int rho) { const int n = rho >> 4, i = rho & 15; return 8 * (i >> 2) + 4 * n + (i & 3); }

struct Unit { int pm, pn; };
struct Gemm { const bf16_t* A; const bf16_t* Bt; int M, N, K; };

struct StaticOrder {
    int nM, nN, nwg, G, c;
    __host__ __device__ void init(int M, int N, int G_, int c_) { nM = M / BM; nN = N / BM; nwg = nM * nN; G = G_; c = c_; }
    __host__ __device__ bool next(int i, Unit& u) const {
        const long L = (long)i * G + c; if (L >= nwg) return false;
        int wgid = (int)L; { const int q = nwg / NXCD, r = nwg % NXCD, xcd = wgid % NXCD, off = wgid / NXCD; wgid = (xcd < r ? xcd * (q + 1) : r * (q + 1) + (xcd - r) * q) + off; }
        const int nig = WGM * nN, gid = wgid / nig, fm = gid * WGM, gsz = (nM - fm) < WGM ? (nM - fm) : WGM;
        u.pm = fm + ((wgid % nig) % gsz); u.pn = (wgid % nig) / gsz; return true;
    }
    __device__ __forceinline__ void a_ready(const Unit&) const {}
    __device__ __forceinline__ void done(const Unit&) const {}
};
template <class Epi, class Sched>
__device__ __forceinline__ void gemm_phase(PG8_LAS unsigned char* lds, const Gemm g, const Sched& S, const Epi& E) {
    const int tid = opq_tid(), wid = __builtin_amdgcn_readfirstlane(tid >> 6), lane = tid & 63, wr = wid >> 2, wc = wid & 3, fr = lane & 15, fq = lane >> 4;
    const int K = g.K, nt = K / BK;
    unsigned voffA[2], voffB[2];
#pragma unroll
    for (int i = 0; i < 2; ++i) { int R, C; stage_rc(tid * 16 + i * 8192, R, C); const int Rb = Epi::PERM ? ((R & ~31) + perm32(R & 31)) : R;
        voffA[i] = (unsigned)(R * K + C) * 2u; voffB[i] = (unsigned)(Rb * K + C) * 2u; }
    const size_t kstep = (size_t)(BK * 2);
    const size_t hstep = (size_t)HALF * K * 2;
    const size_t tstep = 2 * hstep;
    const unsigned ldsw = (unsigned)wid * 1024u;
    const int aoff = lds_byte(wr * 64 + fr, fq * 8), boff = lds_byte(wc * 32 + fr, fq * 8);
#define PG8_SA(b, h) (((b) * 2 + (h)) * HTB)
#define PG8_SB(b, h) ((4 + (b) * 2 + (h)) * HTB)
#define PG8_STAGE(bufoff, gbase, voff) do { _Pragma("unroll") for (int _i = 0; _i < 2; ++_i) \
        __builtin_amdgcn_global_load_lds((const unsigned*)((const char*)(gbase) + (voff)[_i]), (PG8_LAS unsigned*)(lds + (bufoff) + ldsw + _i * 8192), 16, 0, 0); } while (0)
#define PG8_LDA(dst, b, h) do { _Pragma("unroll") for (int m = 0; m < 4; ++m) _Pragma("unroll") for (int k = 0; k < 2; ++k) dst[m][k] = *(const PG8_LAS bf16x8*)(lds + PG8_SA(b, h) + aoff + m * 2048 + k * 1024); } while (0)
#define PG8_LDB(dst, b, h) do { _Pragma("unroll") for (int n = 0; n < 2; ++n) _Pragma("unroll") for (int k = 0; k < 2; ++k) dst[n][k] = *(const PG8_LAS bf16x8*)(lds + PG8_SB(b, h) + boff + n * 2048 + k * 1024); } while (0)
#define PG8_MMA(ai, bj, At, Bt) do { __builtin_amdgcn_s_setprio(1); _Pragma("unroll") for (int m = 0; m < 4; ++m) _Pragma("unroll") for (int n = 0; n < 2; ++n) _Pragma("unroll") for (int k = 0; k < 2; ++k) \
        acc[ai][bj][m][n] = __builtin_amdgcn_mfma_f32_16x16x32_bf16(Bt[n][k], At[m][k], acc[ai][bj][m][n], 0, 0, 0); __builtin_amdgcn_s_setprio(0); } while (0)
#define PG8_WAIT_V(n) asm volatile("s_waitcnt vmcnt(" #n ")" ::: "memory")
#define PG8_WAIT_L(n) asm volatile("s_waitcnt lgkmcnt(" #n ")" ::: "memory")
#define PG8_BAR __builtin_amdgcn_s_barrier()
#define PG8_SCHED __builtin_amdgcn_sched_barrier(0)
    Unit cur, nxt; int ui = 0;
    if (!S.next(0, cur)) return;
    f32x4 acc[2][2][4][2];
#pragma unroll
    for (int a = 0; a < 2; ++a)
#pragma unroll
        for (int b = 0; b < 2; ++b)
#pragma unroll
            for (int m = 0; m < 4; ++m)
#pragma unroll
                for (int n = 0; n < 2; ++n) acc[a][b][m][n] = (f32x4){0.f, 0.f, 0.f, 0.f};
    bf16x8 At[4][2], B0[2][2], B1[2][2];
    const char* cA = (const char*)g.A + (size_t)cur.pm * tstep; const char* cB = (const char*)g.Bt + (size_t)cur.pn * tstep;
    S.a_ready(cur);
    PG8_STAGE(PG8_SB(0, 0), cB, voffB); PG8_STAGE(PG8_SA(0, 0), cA, voffA); PG8_STAGE(PG8_SB(0, 1), cB + hstep, voffB); PG8_STAGE(PG8_SA(0, 1), cA + hstep, voffA);
    if (wr == 1) PG8_BAR;
    PG8_WAIT_V(4); PG8_BAR;
    PG8_STAGE(PG8_SB(1, 0), cB + kstep, voffB); PG8_STAGE(PG8_SA(1, 0), cA + kstep, voffA); PG8_STAGE(PG8_SB(1, 1), cB + hstep + kstep, voffB);
    PG8_WAIT_V(6); PG8_BAR;
    for (;;) {
        const bool has_next = S.next(ui + 1, nxt);
        const char* nA = has_next ? (const char*)g.A + (size_t)nxt.pm * tstep : cA; const char* nB = has_next ? (const char*)g.Bt + (size_t)nxt.pn * tstep : cB;
        for (int t = 0; t < nt; t += 2) {
            const bool last = (t == nt - 2);
            const char* a1 = cA + (size_t)(t + 1) * kstep;
            const char* a2 = last ? nA : cA + (size_t)(t + 2) * kstep; const char* b2 = last ? nB : cB + (size_t)(t + 2) * kstep;
            const char* a3 = a2 + kstep; const char* b3 = b2 + kstep;
            if (last && has_next) S.a_ready(nxt);
            PG8_LDB(B0, 0, 0); PG8_SCHED; PG8_LDA(At, 0, 0); PG8_STAGE(PG8_SA(1, 1), a1 + hstep, voffA);
            PG8_WAIT_L(8); PG8_BAR; PG8_WAIT_L(0); PG8_MMA(0, 0, At, B0); PG8_BAR; PG8_SCHED;
            PG8_LDB(B1, 0, 1); PG8_STAGE(PG8_SB(0, 0), b2, voffB);
            PG8_BAR; PG8_WAIT_L(0); PG8_MMA(0, 1, At, B1); PG8_BAR;
            PG8_LDA(At, 0, 1); PG8_STAGE(PG8_SA(0, 0), a2, voffA);
            PG8_BAR; PG8_WAIT_L(0); PG8_MMA(1, 0, At, B0); PG8_BAR; PG8_SCHED;
            PG8_STAGE(PG8_SB(0, 1), b2 + hstep, voffB);
            PG8_WAIT_V(6); PG8_BAR; PG8_MMA(1, 1, At, B1); PG8_BAR;
            PG8_LDB(B0, 1, 0); PG8_SCHED; PG8_LDA(At, 1, 0); PG8_STAGE(PG8_SA(0, 1), a2 + hstep, voffA);
            PG8_WAIT_L(8); PG8_BAR; PG8_WAIT_L(0); PG8_MMA(0, 0, At, B0); PG8_BAR; PG8_SCHED;
            PG8_LDB(B1, 1, 1); PG8_STAGE(PG8_SB(1, 0), b3, voffB);
            PG8_BAR; PG8_WAIT_L(0); PG8_MMA(0, 1, At, B1); PG8_BAR;
            PG8_LDA(At, 1, 1); PG8_STAGE(PG8_SA(1, 0), a3, voffA);
            PG8_BAR; PG8_WAIT_L(0); PG8_MMA(1, 0, At, B0); PG8_BAR; PG8_SCHED;
            PG8_STAGE(PG8_SB(1, 1), b3 + hstep, voffB);
            PG8_WAIT_V(6); PG8_BAR; PG8_MMA(1, 1, At, B1); PG8_BAR;
        }
        if constexpr (!Epi::AFTER_DRAIN) { E(acc, cur, wr, wc, fr, fq); S.done(cur); }
        if (!has_next) break;
#pragma unroll
        for (int a = 0; a < 2; ++a)
#pragma unroll
            for (int b = 0; b < 2; ++b)
#pragma unroll
                for (int m = 0; m < 4; ++m)
#pragma unroll
                    for (int n = 0; n < 2; ++n) acc[a][b][m][n] = (f32x4){0.f, 0.f, 0.f, 0.f};
        cur = nxt; cA = nA; cB = nB; ++ui;
    }
    PG8_WAIT_V(0);
    if (wr == 0) PG8_BAR;
    PG8_BAR;
    if constexpr (Epi::AFTER_DRAIN) { E.fused(acc, cur, wr, wc, fr, fq, lds, wid, lane); S.done(cur); }
#undef PG8_SA
#undef PG8_SB
#undef PG8_STAGE
#undef PG8_LDA
#undef PG8_LDB
#undef PG8_MMA
#undef PG8_WAIT_V
#undef PG8_WAIT_L
#undef PG8_BAR
#undef PG8_SCHED
}
}

using pg8::f32x4; using pg8::bf16_t; using pg8::u32x4;
typedef unsigned u32x2 __attribute__((ext_vector_type(2)));
#define DI __device__ __forceinline__

constexpr int T = 49152, TP = 16384, D = 1024, FF = 2816, NIN = 11776, THALF = 24576;
constexpr float EPS = 1e-6f;

DI unsigned pk2(float lo, float hi) { unsigned r; asm volatile("v_cvt_pk_bf16_f32 %0, %1, %2" : "=v"(r) : "v"(lo), "v"(hi)); return r; }
DI float bflo(unsigned u) { return __uint_as_float(u << 16); }
DI float bfhi(unsigned u) { return __uint_as_float(u & 0xffff0000u); }
DI float bf1(bf16_t b) { return __uint_as_float(((unsigned)b) << 16); }
DI float sigm(float x) { return 1.0f / (1.0f + __expf(-x)); }
DI float wave_sum(float v) {
#pragma unroll
  for (int o = 1; o < 64; o <<= 1) v += __shfl_xor(v, o);
  return v;
}
DI float wave_max(float v) {
#pragma unroll
  for (int o = 1; o < 64; o <<= 1) v = fmaxf(v, __shfl_xor(v, o));
  return v;
}

DI float ss16(const float* p) { const f32x4 a = *(const f32x4*)p, b = *(const f32x4*)(p + 4), c = *(const f32x4*)(p + 8), d = *(const f32x4*)(p + 12);
  return ((a[0] + a[1]) + (a[2] + a[3])) + ((b[0] + b[1]) + (b[2] + b[3])) + ((c[0] + c[1]) + (c[2] + c[3])) + ((d[0] + d[1]) + (d[2] + d[3])); }
enum { M_SWIGLU = 0, M_BF16S = 1, M_RESID = 2, M_MUL = 3, M_FMA = 4 };

struct EpiP {
  int mode, sig, split_tiles, ldo;
  const float* ss; bf16_t* ob; size_t split_stride;
  float* of; const float* r0; const float* r1; float alpha; int pad; float* ss_out;
  const bf16_t* sg; const float* tmp;
};
struct Epi {
  static constexpr bool PERM = false, AFTER_DRAIN = false;
  const PG8_LAS EpiP* lp;
  __device__ __forceinline__ void operator()(const f32x4 (&acc)[2][2][4][2], const pg8::Unit& u, int wr, int wc, int fr, int fq) const {
    const int mode = lp->mode, sig = lp->sig, split_tiles = lp->split_tiles, ldo = lp->ldo;
    const float* ss = lp->ss; bf16_t* ob = lp->ob; const size_t split_stride = lp->split_stride;
    float* of = lp->of; const float* r0 = lp->r0; const float* r1 = lp->r1; const float alpha = lp->alpha; float* ss_out = lp->ss_out;
    const bf16_t* sg = lp->sg; const float* tmp = lp->tmp;
    const int rowb = u.pm * 256 + wr * 64 + fr;
    if (mode == M_SWIGLU) {
#pragma unroll
      for (int ai = 0; ai < 2; ++ai)
#pragma unroll
        for (int m = 0; m < 4; ++m) {
          const int row = rowb + ai * 128 + m * 16;
          const float rs = rsqrtf(ss16(ss + (size_t)row * 16) * (1.0f / 1024.0f) + EPS);
          float h[8];
#pragma unroll
          for (int n = 0; n < 2; ++n)
#pragma unroll
            for (int j = 0; j < 4; ++j) { const float a = acc[ai][0][m][n][j] * rs, b = acc[ai][1][m][n][j] * rs; h[n * 4 + j] = a * sigm(a) * b; }
          u32x4 w; w.x = pk2(h[0], h[1]); w.y = pk2(h[2], h[3]); w.z = pk2(h[4], h[5]); w.w = pk2(h[6], h[7]);
          *(u32x4*)(ob + (size_t)row * FF + u.pn * 128 + wc * 32 + fq * 8) = w;
        }
    } else if (mode == M_BF16S) {
      int pn = u.pn; bf16_t* base = ob;
      if (split_tiles) { const int t = pn / split_tiles; base += (size_t)t * split_stride; pn -= t * split_tiles; }
#pragma unroll
      for (int ai = 0; ai < 2; ++ai)
#pragma unroll
        for (int m = 0; m < 4; ++m) {
          const int row = rowb + ai * 128 + m * 16;
          const float rs = rsqrtf(ss16(ss + (size_t)row * 16) * (1.0f / 1024.0f) + EPS);
#pragma unroll
          for (int bj = 0; bj < 2; ++bj) {
            float v[8];
#pragma unroll
            for (int n = 0; n < 2; ++n)
#pragma unroll
              for (int j = 0; j < 4; ++j) { float x = acc[ai][bj][m][n][j] * rs; if (sig) x = sigm(x); v[n * 4 + j] = x; }
            u32x4 w; w.x = pk2(v[0], v[1]); w.y = pk2(v[2], v[3]); w.z = pk2(v[4], v[5]); w.w = pk2(v[6], v[7]);
            *(u32x4*)(base + (size_t)row * ldo + pn * 256 + bj * 128 + wc * 32 + fq * 8) = w;
          }
        }
    } else if (mode == M_RESID) {
#pragma unroll
      for (int ai = 0; ai < 2; ++ai)
#pragma unroll
        for (int m = 0; m < 4; ++m) {
          const int row = rowb + ai * 128 + m * 16;
          const float* rp = row < TP ? r0 + (size_t)row * D : r1 + (size_t)(row - TP) * D;
          float s2 = 0.f;
#pragma unroll
          for (int bj = 0; bj < 2; ++bj)
#pragma unroll
            for (int n = 0; n < 2; ++n) {
              const int c0 = u.pn * 256 + bj * 128 + wc * 32 + n * 16 + fq * 4;
              const f32x4 r = *(const f32x4*)(rp + c0);
              const f32x4 o = r + alpha * acc[ai][bj][m][n];
              *(f32x4*)(of + (size_t)row * D + c0) = o;
              if (ob) { u32x2 w; w.x = pk2(o[0], o[1]); w.y = pk2(o[2], o[3]); *(u32x2*)(ob + (size_t)row * D + c0) = w; }
              s2 += (o[0] * o[0] + o[1] * o[1]) + (o[2] * o[2] + o[3] * o[3]);
            }
          s2 += __shfl_xor(s2, 16); s2 += __shfl_xor(s2, 32);
          if (fq == 0) ss_out[(size_t)row * 16 + u.pn * 4 + wc] = s2;
        }
    } else {
#pragma unroll
      for (int ai = 0; ai < 2; ++ai)
#pragma unroll
        for (int m = 0; m < 4; ++m) {
          const int row = rowb + ai * 128 + m * 16;
#pragma unroll
          for (int bj = 0; bj < 2; ++bj)
#pragma unroll
            for (int n = 0; n < 2; ++n) {
              const int c0 = u.pn * 256 + bj * 128 + wc * 32 + n * 16 + fq * 4;
              const u32x2 g2 = *(const u32x2*)(sg + (size_t)row * D + c0);
              f32x4 gv; gv[0] = bflo(g2.x); gv[1] = bfhi(g2.x); gv[2] = bflo(g2.y); gv[3] = bfhi(g2.y);
              if (mode == M_MUL) {
                *(f32x4*)(of + (size_t)row * D + c0) = gv * acc[ai][bj][m][n];
              } else {
                const f32x4 t4 = *(const f32x4*)(tmp + (size_t)row * D + c0);
                const f32x4 o = t4 + gv * acc[ai][bj][m][n];
                u32x2 w; w.x = pk2(o[0], o[1]); w.y = pk2(o[2], o[3]); *(u32x2*)(ob + (size_t)row * D + c0) = w;
              }
            }
        }
    }
  }
};

constexpr size_t SZ_WGU = (size_t)2 * FF * D * 2, SZ_WD = (size_t)D * FF * 2, SZ_WIN = (size_t)NIN * D * 2;
constexpr size_t OFF_WGU1 = 0, OFF_WD1 = OFF_WGU1 + SZ_WGU, OFF_WGU2 = OFF_WD1 + SZ_WD, OFF_WD2 = OFF_WGU2 + SZ_WGU, OFF_WIN = OFF_WD2 + SZ_WD;
constexpr size_t OFF_WA = OFF_WIN + SZ_WIN, OFF_WB = OFF_WA + (size_t)D * 512 * 2, OFF_WO = OFF_WB + (size_t)D * D * 2, OFF_XB = OFF_WO + (size_t)D * D * 2;
constexpr size_t OFF_SS = OFF_XB + (size_t)T * D * 2, OFF_CTR = OFF_SS + (size_t)4 * T * 16 * 4, OFF_BIG = OFF_CTR + 256;
constexpr size_t B_ACT = 0, B_PROJH = 0, B_OFB = (size_t)T * 4096 * 2, B_HG = 0, B_YB = (size_t)T * D * 2, B_QKV = B_YB + (size_t)T * D * 2;
constexpr size_t B_OG = B_QKV + (size_t)THALF * 4608 * 2, B_LSE = B_OG + (size_t)3 * T * 512 * 2, B_YA = 0, B_SGA = B_QKV, B_SGB = B_SGA + (size_t)T * D * 2, B_TMP = B_SGB + (size_t)T * D * 2;
constexpr size_t WS_NEED = OFF_BIG + B_TMP + (size_t)T * D * 4;

struct PhaseDesc { int type, M, N, K; const bf16_t* A; const bf16_t* Bt; EpiP e; };
struct Params {
  const float* in[17];
  float* out; unsigned char* ws;
  PhaseDesc ph[18];
};

enum { MAP_NAT = 0, MAP_P32 = 1, MAP_GU = 2 };
DI int srccol(int map, int np) {
  if (map == MAP_NAT) return np;
  if (map == MAP_P32) return (np & ~31) + pg8::perm32(np & 31);
  const int pn = np >> 8, w = np & 255, bj = w >> 7, wc = (w & 127) >> 5, n = (w & 31) >> 4, fq = (w & 15) >> 2, j = w & 3;
  return bj * FF + 128 * pn + 32 * wc + 8 * fq + 4 * n + j;
}
DI void transpose_item(const float* W, int K, int Nsrc, const float* gain, bf16_t* WT, int map, float* scr, int item, int nblk, int lane) {
  const int kb = item / nblk, nb = item % nblk, k0 = 64 * kb, n0 = 32 * nb;
  const int sc = srccol(map, n0 + (lane & 31));
#pragma unroll 8
  for (int i = 0; i < 32; ++i) { const int kk = 2 * i + (lane >> 5); scr[kk * 33 + (lane & 31)] = W[(size_t)(k0 + kk) * Nsrc + sc]; }
  asm volatile("s_waitcnt lgkmcnt(0)" ::: "memory");
  const int c = lane & 7;
  float g8[8];
#pragma unroll
  for (int e = 0; e < 8; ++e) g8[e] = gain ? gain[k0 + 8 * c + e] : 1.0f;
#pragma unroll
  for (int j = 0; j < 4; ++j) {
    const int n = (lane >> 3) + 8 * j; const float* s = scr + (8 * c) * 33 + n;
    u32x4 o; o.x = pk2(s[0 * 33] * g8[0], s[1 * 33] * g8[1]); o.y = pk2(s[2 * 33] * g8[2], s[3 * 33] * g8[3]);
    o.z = pk2(s[4 * 33] * g8[4], s[5 * 33] * g8[5]); o.w = pk2(s[6 * 33] * g8[6], s[7 * 33] * g8[7]);
    *(u32x4*)(WT + (size_t)(n0 + n) * K + k0 + 8 * c) = o;
  }
  asm volatile("s_waitcnt lgkmcnt(0)" ::: "memory");
}

DI void prep_phase(const Params& p, unsigned char* shm) {
  const int tid = opq_tid(), wid = tid >> 6, lane = tid & 63;
  const int bid = opq_bid(); const int gw = bid * 8 + wid, NGW = gridDim.x * 8;
  unsigned char* ws = p.ws;
  if (bid == 0 && tid < 64) ((unsigned*)(ws + OFF_CTR))[tid] = 0u;
  { float* ss0 = (float*)(ws + OFF_SS); bf16_t* xb = (bf16_t*)(ws + OFF_XB);
    for (int row = gw; row < T; row += NGW) {
      const float* xr = row < TP ? p.in[0] + (size_t)row * D : p.in[1] + (size_t)(row - TP) * D;
      f32x4 v[4]; float s = 0.f;
#pragma unroll
      for (int j = 0; j < 4; ++j) { v[j] = *(const f32x4*)(xr + 4 * lane + 256 * j); s += (v[j][0] * v[j][0] + v[j][1] * v[j][1]) + (v[j][2] * v[j][2] + v[j][3] * v[j][3]); }
      s = wave_sum(s);
      if (lane < 16) ss0[(size_t)row * 16 + lane] = lane == 0 ? s : 0.f;
#pragma unroll
      for (int j = 0; j < 4; ++j) { u32x2 w; w.x = pk2(v[j][0], v[j][1]); w.y = pk2(v[j][2], v[j][3]); *(u32x2*)(xb + (size_t)row * D + 4 * lane + 256 * j) = w; }
    } }
  float* scr = (float*)(shm + wid * 8704);
  for (int wsel = 0; wsel < 8; ++wsel) {
    const float* W; const float* gain = nullptr; bf16_t* WT; int K, Nsrc, Nd, map;
    switch (wsel) {
      case 0: W = p.in[3]; gain = p.in[2]; WT = (bf16_t*)(ws + OFF_WGU1); K = D; Nsrc = 2 * FF; Nd = 2 * FF; map = MAP_GU; break;
      case 1: W = p.in[4]; WT = (bf16_t*)(ws + OFF_WD1); K = FF; Nsrc = D; Nd = D; map = MAP_NAT; break;
      case 2: W = p.in[6]; gain = p.in[5]; WT = (bf16_t*)(ws + OFF_WIN); K = D; Nsrc = NIN; Nd = NIN; map = MAP_P32; break;
      case 3: W = p.in[10]; WT = (bf16_t*)(ws + OFF_WA); K = 512; Nsrc = D; Nd = D; map = MAP_NAT; break;
      case 4: W = p.in[11]; WT = (bf16_t*)(ws + OFF_WB); K = D; Nsrc = D; Nd = D; map = MAP_NAT; break;
      case 5: W = p.in[12]; WT = (bf16_t*)(ws + OFF_WO); K = D; Nsrc = D; Nd = D; map = MAP_NAT; break;
      case 6: W = p.in[14]; gain = p.in[13]; WT = (bf16_t*)(ws + OFF_WGU2); K = D; Nsrc = 2 * FF; Nd = 2 * FF; map = MAP_GU; break;
      default: W = p.in[15]; WT = (bf16_t*)(ws + OFF_WD2); K = FF; Nsrc = D; Nd = D; map = MAP_NAT; break;
    }
    const int nblk = Nd / 32, nitems = (K / 64) * nblk;
    for (int it = gw; it < nitems; it += NGW) transpose_item(W, K, Nsrc, gain, WT, map, scr, it, nblk, lane);
  }
}

DI void hgrn_naive_phase(const Params& p, unsigned char* shm) {
  const int chain = opq_bid();
  if (chain >= 128) return;
  const int tid = opq_tid(), wid = tid >> 6, lane = tid & 63;
  const int seq = chain >> 4, head = (chain >> 1) & 7, dir = chain & 1;
  const int slen = seq < 4 ? 4096 : 8192, row0 = seq < 4 ? seq * 4096 : TP + (seq - 4) * 8192;
  const bf16_t* pj = (const bf16_t*)(p.ws + OFF_BIG + B_PROJH);
  bf16_t* od = (bf16_t*)(p.ws + OFF_BIG + B_OFB) + (size_t)dir * T * D;
  const float* lbw = dir ? p.in[8] : p.in[7];
  float* gq = (float*)shm; float* gf = gq + 2048; float* gk = gf + 2048; float* gv = gk + 2048;
  const int vl = lane & 15, kq = lane >> 4, v = 16 * wid + vl;
  float S[32];
#pragma unroll
  for (int i = 0; i < 32; ++i) S[i] = 0.f;
  const int fk = tid & 127;
  const float lb = 1.0f / (1.0f + __expf(lbw[D + head * 128 + fk] - lbw[head * 128 + fk]));
  for (int i0 = 0; i0 < slen; i0 += 16) {
    __syncthreads();
#pragma unroll
    for (int r = 0; r < 4; ++r) {
      const int tt = (tid >> 7) + 4 * r; const int t = dir ? slen - 1 - (i0 + tt) : i0 + tt; const size_t rb = (size_t)(row0 + t) * 4096 + head * 128 + fk;
      const float hq = bf1(pj[rb]), hf = bf1(pj[rb + 1024 * (1 + dir)]), hi = bf1(pj[rb + 3072]);
      const float s = sigm(hf);
      gq[tt * 128 + fk] = hq * sigm(hq); gf[tt * 128 + fk] = lb + (1.0f - lb) * s; gk[tt * 128 + fk] = (1.0f - lb) * (1.0f - s); gv[tt * 128 + fk] = hi;
    }
    __syncthreads();
    for (int tt = 0; tt < 16; ++tt) {
      const float val = gv[tt * 128 + v]; float o = 0.f;
#pragma unroll
      for (int k4 = 0; k4 < 8; ++k4) {
        const f32x4 f4 = *(const f32x4*)(gf + tt * 128 + 32 * kq + 4 * k4), k4v = *(const f32x4*)(gk + tt * 128 + 32 * kq + 4 * k4), q4 = *(const f32x4*)(gq + tt * 128 + 32 * kq + 4 * k4);
#pragma unroll
        for (int e = 0; e < 4; ++e) { S[4 * k4 + e] = f4[e] * S[4 * k4 + e] + k4v[e] * val; o += q4[e] * S[4 * k4 + e]; }
      }
      o += __shfl_xor(o, 16); o += __shfl_xor(o, 32);
      const int t = dir ? slen - 1 - (i0 + tt) : i0 + tt;
      if (kq == 0) od[(size_t)(row0 + t) * D + head * 128 + v] = (bf16_t)(pk2(o, 0.f) & 0xffffu);
    }
  }
}

DI void combine_phase(const Params& p) {
  const int tid = opq_tid(), wid = tid >> 6, lane = tid & 63;
  const int bid = opq_bid(); const int gw = bid * 8 + wid, NGW = gridDim.x * 8;
  const bf16_t* oF = (const bf16_t*)(p.ws + OFF_BIG + B_OFB); const bf16_t* oB = oF + (size_t)T * D;
  const bf16_t* hg = (const bf16_t*)(p.ws + OFF_BIG + B_HG); bf16_t* yb = (bf16_t*)(p.ws + OFF_BIG + B_YB);
  const float* ng = p.in[9];
  const int c0 = lane * 16;
  float g[16];
#pragma unroll
  for (int i = 0; i < 16; ++i) g[i] = ng[c0 + i];
  for (int row = gw; row < T; row += NGW) {
    const size_t b = (size_t)row * D + c0;
    float o[16]; float s = 0.f;
#pragma unroll
    for (int h = 0; h < 2; ++h) {
      const u32x4 a = *(const u32x4*)(oF + b + 8 * h), c = *(const u32x4*)(oB + b + 8 * h);
#pragma unroll
      for (int e = 0; e < 4; ++e) { o[8 * h + 2 * e] = bflo(a[e]) + bflo(c[e]); o[8 * h + 2 * e + 1] = bfhi(a[e]) + bfhi(c[e]); }
    }
#pragma unroll
    for (int i = 0; i < 16; ++i) s += o[i] * o[i];
    s += __shfl_xor(s, 1); s += __shfl_xor(s, 2); s += __shfl_xor(s, 4);
    const float rs = rsqrtf(s * (1.0f / 128.0f) + EPS);
#pragma unroll
    for (int h = 0; h < 2; ++h) {
      const u32x4 gg = *(const u32x4*)(hg + b + 8 * h); u32x4 w;
#pragma unroll
      for (int e = 0; e < 4; ++e) {
        const float g0 = bflo(gg[e]), g1 = bfhi(gg[e]);
        w[e] = pk2(o[8 * h + 2 * e] * rs * g[8 * h + 2 * e] * g0 * sigm(g0), o[8 * h + 2 * e + 1] * rs * g[8 * h + 2 * e + 1] * g1 * sigm(g1));
      }
      *(u32x4*)(yb + b + 8 * h) = w;
    }
  }
}

DI void attn_naive_phase(const Params& p, int half) {
  const int tid = opq_tid(), wid = tid >> 6, lane = tid & 63;
  const int bid = opq_bid(); const int gw = bid * 8 + wid, NGW = gridDim.x * 8;
  const int row_base = half * THALF;
  const bf16_t* base = (const bf16_t*)(p.ws + OFF_BIG + B_QKV) - (size_t)row_base * 4608;
  bf16_t* ya = (bf16_t*)(p.ws + OFF_BIG + B_YA);
  for (int unit = gw; unit < THALF * 8; unit += NGW) {
    const int row = row_base + (unit >> 3), j = unit & 7;
    int s0, slen; if (row < TP) { s0 = row & ~4095; slen = 4096; } else { s0 = TP + ((row - TP) & ~8191); slen = 8192; }
    const int t = row - s0;
    const float slope = exp2f(-(float)(j + 1));
    float sc[3][3];
#pragma unroll
    for (int g = 0; g < 3; ++g) {
      const int d = g == 0 ? 1 : (g == 1 ? 4 : 16);
      u32x4 qv[8];
      { const u32x4* qp = (const u32x4*)(base + (size_t)row * 4608 + g * 512 + j * 64);
#pragma unroll
        for (int i = 0; i < 8; ++i) qv[i] = qp[i]; }
#pragma unroll
      for (int r = 0; r < 3; ++r) {
        const int joff = lane + 64 * r - 64; const int pos = t + d * joff;
        const bool valid = (r < 2 || lane == 0) && pos >= 0 && pos < slen;
        float s = -1e30f;
        if (valid) {
          const u32x4* kp = (const u32x4*)(base + (size_t)(s0 + pos) * 4608 + 1536 + g * 512 + j * 64);
          float dot = 0.f;
#pragma unroll
          for (int i = 0; i < 8; ++i) { const u32x4 kv = kp[i];
#pragma unroll
            for (int e = 0; e < 4; ++e) dot += bflo(kv[e]) * bflo(qv[i][e]) + bfhi(kv[e]) * bfhi(qv[i][e]); }
          s = dot * 0.125f - slope * (float)(d * (joff < 0 ? -joff : joff));
        }
        sc[g][r] = s;
      }
    }
    float m = -1e30f;
#pragma unroll
    for (int g = 0; g < 3; ++g)
#pragma unroll
      for (int r = 0; r < 3; ++r) m = fmaxf(m, sc[g][r]);
    m = wave_max(m);
    float l = 0.f;
#pragma unroll
    for (int g = 0; g < 3; ++g)
#pragma unroll
      for (int r = 0; r < 3; ++r) { sc[g][r] = sc[g][r] > -1e29f ? __expf(sc[g][r] - m) : 0.f; l += sc[g][r]; }
    l = wave_sum(l);
    float o = 0.f;
#pragma unroll
    for (int g = 0; g < 3; ++g) {
      const int d = g == 0 ? 1 : (g == 1 ? 4 : 16);
      const bf16_t* vb = base + 3072 + g * 512 + j * 64 + lane;
#pragma unroll
      for (int r = 0; r < 3; ++r) {
        const int ntl = r < 2 ? 64 : 1;
        for (int tl = 0; tl < ntl; ++tl) {
          const float pb = __uint_as_float(__builtin_amdgcn_readlane(__float_as_uint(sc[g][r]), tl));
          if (pb != 0.f) { const int pos = t + d * (tl + 64 * r - 64); o += pb * bf1(vb[(size_t)(s0 + pos) * 4608]); }
        }
      }
    }
    ya[(size_t)row * 512 + j * 64 + lane] = (bf16_t)(pk2(o / l, 0.f) & 0xffffu);
  }
}


typedef float f32x16 __attribute__((ext_vector_type(16)));
typedef short s16x4 __attribute__((ext_vector_type(4)));
typedef __bf16 bf16v2_t __attribute__((ext_vector_type(2)));
typedef float f32v2_t __attribute__((ext_vector_type(2)));
DI unsigned pk2c(float a, float b) { f32v2_t v = {a, b}; bf16v2_t r = __builtin_convertvector(v, bf16v2_t); return __builtin_bit_cast(unsigned, r); }
#define MFMA32(a, b, c) __builtin_amdgcn_mfma_f32_32x32x16_bf16((a), (b), (c), 0, 0, 0)
DI int crow(int i, int h) { return (i & 3) + 8 * (i >> 2) + 4 * h; }
DI void tr_read4(unsigned a0, unsigned a1, unsigned a2, unsigned a3, s16x4& r0, s16x4& r1, s16x4& r2, s16x4& r3) {
  asm volatile("ds_read_b64_tr_b16 %0, %4\n\tds_read_b64_tr_b16 %1, %5\n\tds_read_b64_tr_b16 %2, %6\n\tds_read_b64_tr_b16 %3, %7\n\ts_waitcnt lgkmcnt(0)"
               : "=&v"(r0), "=&v"(r1), "=&v"(r2), "=&v"(r3) : "v"(a0), "v"(a1), "v"(a2), "v"(a3) : "memory");
}
constexpr int AROW = 144;
constexpr int AV_OFF = 384 * AROW;

DI void attn_phase(const Params& p, int half, unsigned char* shm) {
  const int tid = opq_tid(), wid = tid >> 6, lane = tid & 63, bid = opq_bid();
  const int q32 = lane & 31, h = lane >> 5;
  const bf16_t* qkv = (const bf16_t*)(p.ws + OFF_BIG + B_QKV);
  bf16_t* og = (bf16_t*)(p.ws + OFF_BIG + B_OG);
  float* ml = (float*)(p.ws + OFF_BIG + B_LSE);
  const unsigned lbase = (unsigned)(size_t)(PG8_LAS unsigned char*)shm;
  for (int unit = bid; unit < 2304; unit += (int)gridDim.x) {
    const int g = unit / 768, rem = unit % 768, j = rem & 7, cidx = rem >> 3;
    const int d = g == 0 ? 1 : (g == 1 ? 4 : 16);
    int seq_row0, S, w;
    if (half == 0) { if (cidx < 64) { seq_row0 = (cidx >> 4) * 4096; S = 4096; w = cidx & 15; } else { seq_row0 = TP; S = 8192; w = cidx - 64; } }
    else { seq_row0 = TP + (1 + (cidx >> 5)) * 8192; S = 8192; w = cidx & 31; }
    const int r = w % d, c = w / d, L = S / d;
    const int lrow0 = seq_row0 - half * THALF;
    const int ki0 = 256 * c - 64;
    const size_t colq = (size_t)g * 512 + j * 64;
    __syncthreads();
#pragma unroll
    for (int it = 0; it < 6; ++it) {
      const int idx = tid + 512 * it, slot = idx >> 3, ch = idx & 7, ki = ki0 + slot;
      u32x4 kv = {0u, 0u, 0u, 0u}, vv = {0u, 0u, 0u, 0u};
      if (ki >= 0 && ki < L) { const bf16_t* rp = qkv + (size_t)(lrow0 + r + d * ki) * 4608 + colq + ch * 8; kv = *(const u32x4*)(rp + 1536); vv = *(const u32x4*)(rp + 3072); }
      *(u32x4*)(shm + slot * AROW + ch * 16) = kv; *(u32x4*)(shm + AV_OFF + slot * AROW + ch * 16) = vv;
    }
    pg8::bf16x8 qf[4];
    { const bf16_t* qp = qkv + (size_t)(lrow0 + r + d * (256 * c + 32 * wid + q32)) * 4608 + colq + 8 * h;
#pragma unroll
      for (int ks = 0; ks < 4; ++ks) qf[ks] = *(const pg8::bf16x8*)(qp + 16 * ks); }
    __syncthreads();
    f32x16 st[5];
#pragma unroll
    for (int kt = 0; kt < 5; ++kt) {
#pragma unroll
      for (int i = 0; i < 16; ++i) st[kt][i] = 0.f;
#pragma unroll
      for (int ks = 0; ks < 4; ++ks) {
        const pg8::bf16x8 kf = *(const pg8::bf16x8*)(shm + (32 * wid + 32 * kt + q32) * AROW + (16 * ks + 8 * h) * 2);
        st[kt] = MFMA32(kf, qf[ks], st[kt]);
      }
    }
    const float slope_d = exp2f(-(float)(j + 1)) * (float)d;
    int hu = h, qu = q32; asm volatile("" : "+v"(hu), "+v"(qu));
    float m = -1e30f;
#pragma unroll
    for (int kt = 0; kt < 5; ++kt)
#pragma unroll
      for (int i = 0; i < 16; ++i) {
        const int rel = 32 * kt + crow(i, hu) - qu - 64; const int ki = ki0 + 32 * wid + 32 * kt + crow(i, hu);
        const int arel = rel < 0 ? -rel : rel;
        const bool valid = arel <= 64 && ki >= 0 && ki < L;
        const float s = valid ? st[kt][i] * 0.125f - slope_d * (float)arel : -1e30f;
        st[kt][i] = s; m = fmaxf(m, s);
      }
    m = fmaxf(m, __shfl_xor(m, 32));
    float l = 0.f;
#pragma unroll
    for (int kt = 0; kt < 5; ++kt)
#pragma unroll
      for (int i = 0; i < 16; ++i) { const float s = st[kt][i]; const float e = s > -1e29f ? __expf(s - m) : 0.f; st[kt][i] = e; l += e; }
    l += __shfl_xor(l, 32);
    f32x16 o[2];
#pragma unroll
    for (int et = 0; et < 2; ++et)
#pragma unroll
      for (int i = 0; i < 16; ++i) o[et][i] = 0.f;
    const int i16 = lane & 15, q4 = i16 >> 2, p4 = i16 & 3, blk = (lane >> 4) & 1;
    const unsigned vaddr0 = lbase + AV_OFF + (32 * wid + 4 * h + q4) * AROW + 32 * blk + 8 * p4;
#pragma unroll
    for (int kt = 0; kt < 5; ++kt)
#pragma unroll
      for (int s2 = 0; s2 < 2; ++s2) {
        u32x4 pw; pw.x = pk2c(st[kt][8 * s2 + 0], st[kt][8 * s2 + 1]); pw.y = pk2c(st[kt][8 * s2 + 2], st[kt][8 * s2 + 3]);
        pw.z = pk2c(st[kt][8 * s2 + 4], st[kt][8 * s2 + 5]); pw.w = pk2c(st[kt][8 * s2 + 6], st[kt][8 * s2 + 7]);
        const pg8::bf16x8 pa = __builtin_bit_cast(pg8::bf16x8, pw);
        const unsigned a = vaddr0 + (32 * kt + 16 * s2) * AROW;
        s16x4 lo0, hi0, lo1, hi1;
        tr_read4(a, a + 8 * AROW, a + 64, a + 8 * AROW + 64, lo0, hi0, lo1, hi1);
        const pg8::bf16x8 v0 = __builtin_shufflevector(lo0, hi0, 0, 1, 2, 3, 4, 5, 6, 7), v1 = __builtin_shufflevector(lo1, hi1, 0, 1, 2, 3, 4, 5, 6, 7);
        o[0] = MFMA32(pa, v0, o[0]); o[1] = MFMA32(pa, v1, o[1]);
      }
    const int rowq0 = half * THALF + lrow0 + r + d * (256 * c + 32 * wid);
#pragma unroll
    for (int et = 0; et < 2; ++et)
#pragma unroll
      for (int i = 0; i < 16; ++i) {
        const int row = rowq0 + d * crow(i, h);
        og[((size_t)g * T + row) * 512 + j * 64 + 32 * et + q32] = (bf16_t)(pk2c(o[et][i], 0.f) & 0xffffu);
      }
    if (h == 0) { const int row = rowq0 + d * q32; f32v2_t v = {m, l}; *(f32v2_t*)(ml + (((size_t)g * T + row) * 8 + j) * 2) = v; }
  }
}


DI void tr_read2(unsigned a0, unsigned a1, s16x4& r0, s16x4& r1) {
  asm volatile("ds_read_b64_tr_b16 %0, %2\n\tds_read_b64_tr_b16 %1, %3\n\ts_waitcnt lgkmcnt(0)" : "=&v"(r0), "=&v"(r1) : "v"(a0), "v"(a1) : "memory");
}
constexpr int HP = 272;
constexpr int H_QT = 0, H_KT = 64 * HP, H_KE = 2 * 64 * HP, H_VV = 3 * 64 * HP, H_ST = H_VV + 64 * AROW, H_DEC = H_ST + 64 * HP, H_GG = H_DEC + 512;
DI void hgrn_phase(const Params& p, unsigned char* shm) {
  const int chain = opq_bid();
  if (chain >= 256) return;
  const int tid = opq_tid(), wid = tid >> 6, lane = tid & 63;
  const int vh = chain & 1, dir = (chain >> 1) & 1, head = (chain >> 2) & 7, seq = chain >> 5;
  const int slen = seq < 4 ? 4096 : 8192, row0 = seq < 4 ? seq * 4096 : TP + (seq - 4) * 8192, nchunks = slen >> 6;
  const bf16_t* pj = (const bf16_t*)(p.ws + OFF_BIG + B_PROJH);
  bf16_t* od = (bf16_t*)(p.ws + OFF_BIG + B_OFB) + (size_t)dir * T * D;
  const float* lbw = dir ? p.in[8] : p.in[7];
  const unsigned lbase = (unsigned)(size_t)(PG8_LAS unsigned char*)shm;
  const int c2 = 2 * lane;
  const float lb0 = 1.0f / (1.0f + __expf(lbw[D + head * 128 + c2] - lbw[head * 128 + c2]));
  const float lb1 = 1.0f / (1.0f + __expf(lbw[D + head * 128 + c2 + 1] - lbw[head * 128 + c2 + 1]));
  for (int i = tid; i < 64 * HP / 4; i += 512) ((unsigned*)(shm + H_ST))[i] = 0u;
  f32x16 Sacc[2];
#pragma unroll
  for (int b = 0; b < 2; ++b)
#pragma unroll
    for (int i = 0; i < 16; ++i) Sacc[b][i] = 0.f;
  unsigned rq[8], rf[8]; u32x4 rv;
#define HG_LOAD(cc) do { _Pragma("unroll") for (int ii = 0; ii < 8; ++ii) { const int il = 64 * (cc) + 8 * wid + ii; const int t = dir ? slen - 1 - il : il; \
      const bf16_t* bp = pj + (size_t)(row0 + t) * 4096 + head * 128 + c2; rq[ii] = *(const unsigned*)bp; rf[ii] = *(const unsigned*)(bp + 1024 * (1 + dir)); } \
    { const int il = 64 * (cc) + (tid >> 3); const int t = dir ? slen - 1 - il : il; rv = *(const u32x4*)(pj + (size_t)(row0 + t) * 4096 + 3072 + head * 128 + vh * 64 + (tid & 7) * 8); } } while (0)
  HG_LOAD(0);
  for (int c = 0; c < nchunks; ++c) {
    int hu = lane >> 5, qu = lane & 31; asm volatile("" : "+v"(hu), "+v"(qu));
    float q0[8], q1[8], k0[8], k1[8], P0[8], P1[8];
    float run0 = 1.f, run1 = 1.f;
#pragma unroll
    for (int ii = 0; ii < 8; ++ii) {
      const float hq0 = bflo(rq[ii]), hq1 = bfhi(rq[ii]), hf0 = bflo(rf[ii]), hf1 = bfhi(rf[ii]);
      const float s0 = sigm(hf0), s1 = sigm(hf1);
      run0 *= lb0 + (1.0f - lb0) * s0; run1 *= lb1 + (1.0f - lb1) * s1;
      P0[ii] = run0; P1[ii] = run1;
      k0[ii] = (1.0f - lb0) * (1.0f - s0); k1[ii] = (1.0f - lb1) * (1.0f - s1);
      q0[ii] = hq0 * sigm(hq0); q1[ii] = hq1 * sigm(hq1);
    }
    { f32v2_t gg = {run0, run1}; *(f32v2_t*)(shm + H_GG + (wid * 128 + c2) * 4) = gg; }
    *(u32x4*)(shm + H_VV + (tid >> 3) * AROW + (tid & 7) * 16) = rv;
    __syncthreads();
    float pre0 = 1.f, pre1 = 1.f, dec0 = 1.f, dec1 = 1.f;
#pragma unroll
    for (int w2 = 0; w2 < 8; ++w2) { const f32v2_t gg = *(const f32v2_t*)(shm + H_GG + (w2 * 128 + c2) * 4); dec0 *= gg[0]; dec1 *= gg[1]; if (w2 < wid) { pre0 *= gg[0]; pre1 *= gg[1]; } }
#pragma unroll
    for (int ii = 0; ii < 8; ++ii) {
      const float Pa = pre0 * P0[ii], Pb = pre1 * P1[ii];
      const float ia = 1.0f / Pa, ib = 1.0f / Pb;
      const float kta = k0[ii] * ia, ktb = k1[ii] * ib;
      const int off = (8 * wid + ii) * HP + c2 * 2;
      *(unsigned*)(shm + H_QT + off) = pk2c(q0[ii] * Pa, q1[ii] * Pb);
      *(unsigned*)(shm + H_KT + off) = pk2c(kta, ktb);
      *(unsigned*)(shm + H_KE + off) = pk2c(kta * dec0, ktb * dec1);
    }
    if (wid == 0) { f32v2_t dd = {dec0, dec1}; *(f32v2_t*)(shm + H_DEC + c2 * 4) = dd; }
    __syncthreads();
    if (c + 1 < nchunks) HG_LOAD(c + 1);
    const int i16 = lane & 15, q4 = i16 >> 2, p4 = i16 & 3, blk = (lane >> 4) & 1;
    if (wid < 4) {
      const int tb = wid >> 1, vb = wid & 1;
      f32x16 o;
#pragma unroll
      for (int i = 0; i < 16; ++i) o[i] = 0.f;
#pragma unroll
      for (int ks = 0; ks < 8; ++ks) {
        const pg8::bf16x8 a = *(const pg8::bf16x8*)(shm + H_QT + (32 * tb + qu) * HP + (16 * ks + 8 * hu) * 2);
        const pg8::bf16x8 b = *(const pg8::bf16x8*)(shm + H_ST + (32 * vb + qu) * HP + (16 * ks + 8 * hu) * 2);
        o = MFMA32(a, b, o);
      }
      for (int sb = 0; sb <= tb; ++sb) {
        f32x16 at;
#pragma unroll
        for (int i = 0; i < 16; ++i) at[i] = 0.f;
#pragma unroll
        for (int ks = 0; ks < 8; ++ks) {
          const pg8::bf16x8 a = *(const pg8::bf16x8*)(shm + H_KT + (32 * sb + qu) * HP + (16 * ks + 8 * hu) * 2);
          const pg8::bf16x8 b = *(const pg8::bf16x8*)(shm + H_QT + (32 * tb + qu) * HP + (16 * ks + 8 * hu) * 2);
          at = MFMA32(a, b, at);
        }
        if (sb == tb) {
#pragma unroll
          for (int i = 0; i < 16; ++i) at[i] = crow(i, hu) > qu ? 0.f : at[i];
        }
#pragma unroll
        for (int s2 = 0; s2 < 2; ++s2) {
          u32x4 pw; pw.x = pk2c(at[8 * s2 + 0], at[8 * s2 + 1]); pw.y = pk2c(at[8 * s2 + 2], at[8 * s2 + 3]); pw.z = pk2c(at[8 * s2 + 4], at[8 * s2 + 5]); pw.w = pk2c(at[8 * s2 + 6], at[8 * s2 + 7]);
          const pg8::bf16x8 pa = __builtin_bit_cast(pg8::bf16x8, pw);
          const unsigned a = lbase + H_VV + (32 * sb + 16 * s2 + 4 * hu + q4) * AROW + (32 * vb + 16 * blk) * 2 + 8 * p4;
          s16x4 lo, hi; tr_read2(a, a + 8 * AROW, lo, hi);
          const pg8::bf16x8 vf = __builtin_shufflevector(lo, hi, 0, 1, 2, 3, 4, 5, 6, 7);
          o = MFMA32(pa, vf, o);
        }
      }
#pragma unroll
      for (int i = 0; i < 16; ++i) {
        const int il = 64 * c + 32 * tb + crow(i, hu); const int t = dir ? slen - 1 - il : il;
        od[(size_t)(row0 + t) * D + head * 128 + vh * 64 + 32 * vb + qu] = (bf16_t)(pk2c(o[i], 0.f) & 0xffffu);
      }
    } else {
      const int kb = wid - 4;
#pragma unroll
      for (int i = 0; i < 16; ++i) { const float dv = *(const float*)(shm + H_DEC + (32 * kb + crow(i, hu)) * 4); Sacc[0][i] *= dv; Sacc[1][i] *= dv; }
#pragma unroll
      for (int s = 0; s < 4; ++s) {
        const unsigned aa = lbase + H_KE + (16 * s + 8 * hu + q4) * HP + (32 * kb + 16 * blk) * 2 + 8 * p4;
        const unsigned ab = lbase + H_VV + (16 * s + 8 * hu + q4) * AROW + (16 * blk) * 2 + 8 * p4;
        s16x4 alo, ahi, b0lo, b0hi, b1lo, b1hi;
        tr_read2(aa, aa + 4 * HP, alo, ahi); tr_read2(ab, ab + 4 * AROW, b0lo, b0hi); tr_read2(ab + 64, ab + 4 * AROW + 64, b1lo, b1hi);
        const pg8::bf16x8 af = __builtin_shufflevector(alo, ahi, 0, 1, 2, 3, 4, 5, 6, 7);
        const pg8::bf16x8 bf0 = __builtin_shufflevector(b0lo, b0hi, 0, 1, 2, 3, 4, 5, 6, 7), bf1v = __builtin_shufflevector(b1lo, b1hi, 0, 1, 2, 3, 4, 5, 6, 7);
        Sacc[0] = MFMA32(af, bf0, Sacc[0]); Sacc[1] = MFMA32(af, bf1v, Sacc[1]);
      }
    }
    __syncthreads();
    if (wid >= 4) {
      const int kb = wid - 4;
#pragma unroll
      for (int b = 0; b < 2; ++b)
#pragma unroll
        for (int g4 = 0; g4 < 4; ++g4) {
          u32x2 w; w.x = pk2c(Sacc[b][4 * g4 + 0], Sacc[b][4 * g4 + 1]); w.y = pk2c(Sacc[b][4 * g4 + 2], Sacc[b][4 * g4 + 3]);
          *(u32x2*)(shm + H_ST + (32 * b + qu) * HP + (32 * kb + 8 * g4 + 4 * hu) * 2) = w;
        }
    }
  }
#undef HG_LOAD
}

DI void merge_phase(const Params& p) {
  const int tid = opq_tid(), wid = tid >> 6, lane = tid & 63;
  const int bid = opq_bid(); const int gw = bid * 8 + wid, NGW = gridDim.x * 8;
  const bf16_t* og = (const bf16_t*)(p.ws + OFF_BIG + B_OG); const float* ml = (const float*)(p.ws + OFF_BIG + B_LSE);
  bf16_t* ya = (bf16_t*)(p.ws + OFF_BIG + B_YA);
  const int c0 = lane * 8, j = lane >> 3;
  for (int row = gw; row < T; row += NGW) {
    float mg[3], lg[3];
#pragma unroll
    for (int g = 0; g < 3; ++g) { const f32v2_t v = *(const f32v2_t*)(ml + (((size_t)g * T + row) * 8 + j) * 2); mg[g] = v[0]; lg[g] = v[1]; }
    const float M = fmaxf(mg[0], fmaxf(mg[1], mg[2]));
    float acc[8]; float den = 0.f;
#pragma unroll
    for (int e = 0; e < 8; ++e) acc[e] = 0.f;
#pragma unroll
    for (int g = 0; g < 3; ++g) {
      const float wg = __expf(mg[g] - M); den += wg * lg[g];
      const u32x4 a = *(const u32x4*)(og + ((size_t)g * T + row) * 512 + c0);
#pragma unroll
      for (int e = 0; e < 4; ++e) { acc[2 * e] += wg * bflo(a[e]); acc[2 * e + 1] += wg * bfhi(a[e]); }
    }
    const float inv = 1.0f / den;
    u32x4 w; w.x = pk2c(acc[0] * inv, acc[1] * inv); w.y = pk2c(acc[2] * inv, acc[3] * inv); w.z = pk2c(acc[4] * inv, acc[5] * inv); w.w = pk2c(acc[6] * inv, acc[7] * inv);
    *(u32x4*)(ya + (size_t)row * 512 + c0) = w;
  }
}

DI void final_phase(const Params& p) {
  const int tid = opq_tid(), wid = tid >> 6, lane = tid & 63;
  const int bid = opq_bid(); const int gw = bid * 8 + wid, NGW = gridDim.x * 8;
  const float* ss3 = (const float*)(p.ws + OFF_SS) + (size_t)3 * T * 16; const float* g = p.in[16];
  f32x4 g4[4];
#pragma unroll
  for (int j = 0; j < 4; ++j) g4[j] = *(const f32x4*)(g + 4 * lane + 256 * j);
  for (int row = gw; row < T; row += NGW) {
    const float rs = rsqrtf(ss16(ss3 + (size_t)row * 16) * (1.0f / 1024.0f) + EPS);
    float* xr = p.out + (size_t)row * D;
#pragma unroll
    for (int j = 0; j < 4; ++j) { f32x4 v = *(const f32x4*)(xr + 4 * lane + 256 * j); v = v * rs * g4[j]; *(f32x4*)(xr + 4 * lane + 256 * j) = v; }
  }
}

enum { PT_GEMM = 0, PT_HGRN = 1, PT_COMBINE = 2, PT_ATTN0 = 3, PT_ATTN1 = 4, PT_FINAL = 5, PT_MERGE = 6 };
constexpr int NPH = 18;
__global__ void __launch_bounds__(512, 2) fwd_megakernel(Params p) {
  extern __shared__ __attribute__((aligned(16))) unsigned char shm[];
  cg::grid_group grid = cg::this_grid();
  prep_phase(p, shm);
  grid.sync();
  for (int ph = 0; ph < NPH; ++ph) {
    const int type = p.ph[ph].type;
    if (type == PT_GEMM) {
      __syncthreads();
      if (threadIdx.x == 0) *(EpiP*)(shm + 131072) = p.ph[ph].e;
      __syncthreads();
      pg8::Gemm g; g.A = p.ph[ph].A; g.Bt = p.ph[ph].Bt; g.M = p.ph[ph].M; g.N = p.ph[ph].N; g.K = p.ph[ph].K;
      Epi E; E.lp = (const PG8_LAS EpiP*)((PG8_LAS unsigned char*)shm + 131072);
      pg8::StaticOrder S; S.init(g.M, g.N, (int)gridDim.x, opq_bid());
      pg8::gemm_phase<Epi, pg8::StaticOrder>((PG8_LAS unsigned char*)shm, g, S, E);
    } else if (type == PT_HGRN) hgrn_phase(p, shm);
    else if (type == PT_COMBINE) combine_phase(p);
    else if (type == PT_ATTN0) attn_phase(p, 0, shm);
    else if (type == PT_ATTN1) attn_phase(p, 1, shm);
    else if (type == PT_MERGE) merge_phase(p);
    else final_phase(p);
    if (ph < NPH - 1) grid.sync();
  }
}

static void fill_phases(Params& p) {
  unsigned char* ws = p.ws; unsigned char* big = ws + OFF_BIG;
  float* ssb = (float*)(ws + OFF_SS); bf16_t* xb = (bf16_t*)(ws + OFF_XB);
  float* ss0 = ssb; float* ss1 = ssb + (size_t)T * 16; float* ss2 = ssb + (size_t)2 * T * 16; float* ss3 = ssb + (size_t)3 * T * 16;
  const bf16_t* win = (const bf16_t*)(ws + OFF_WIN);
  auto gemm = [&](int i, const bf16_t* A, const bf16_t* Bt, int M, int N, int K) -> EpiP& {
    PhaseDesc& d = p.ph[i]; d.type = PT_GEMM; d.M = M; d.N = N; d.K = K; d.A = A; d.Bt = Bt; d.e.mode = M_BF16S; d.e.ldo = D; d.e.alpha = 1.0f; return d.e; };
  auto other = [&](int i, int type) { p.ph[i].type = type; };
  { EpiP& e = gemm(0, xb, (const bf16_t*)(ws + OFF_WGU1), T, 2 * FF, D); e.mode = M_SWIGLU; e.ss = ss0; e.ob = (bf16_t*)(big + B_ACT); }
  { EpiP& e = gemm(1, (const bf16_t*)(big + B_ACT), (const bf16_t*)(ws + OFF_WD1), T, D, FF); e.mode = M_RESID; e.alpha = 0.5f; e.of = p.out; e.r0 = p.in[0]; e.r1 = p.in[1]; e.ob = xb; e.ss_out = ss1; }
  { EpiP& e = gemm(2, xb, win + (size_t)4608 * D, T, 4096, D); e.ss = ss1; e.ob = (bf16_t*)(big + B_PROJH); e.ldo = 4096; }
  other(3, PT_HGRN);
  { EpiP& e = gemm(4, xb, win + (size_t)8704 * D, T, 1024, D); e.ss = ss1; e.ob = (bf16_t*)(big + B_HG); e.ldo = 1024; }
  other(5, PT_COMBINE);
  for (int half = 0; half < 2; ++half) {
    EpiP& e = gemm(6 + 2 * half, xb + (size_t)half * THALF * D, win, THALF, 4608, D); e.ss = ss1 + (size_t)half * THALF * 16; e.ob = (bf16_t*)(big + B_QKV); e.ldo = 4608;
    other(7 + 2 * half, half ? PT_ATTN1 : PT_ATTN0);
  }
  other(10, PT_MERGE);
  { EpiP& e = gemm(11, xb, win + (size_t)9728 * D, T, 2048, D); e.ss = ss1; e.sig = 1; e.ob = (bf16_t*)(big + B_SGA); e.ldo = 1024; e.split_tiles = 4; e.split_stride = (size_t)T * D; }
  { EpiP& e = gemm(12, (const bf16_t*)(big + B_YA), (const bf16_t*)(ws + OFF_WA), T, D, 512); e.mode = M_MUL; e.sg = (const bf16_t*)(big + B_SGA); e.of = (float*)(big + B_TMP); }
  { EpiP& e = gemm(13, (const bf16_t*)(big + B_YB), (const bf16_t*)(ws + OFF_WB), T, D, D); e.mode = M_FMA; e.sg = (const bf16_t*)(big + B_SGB); e.tmp = (const float*)(big + B_TMP); e.ob = (bf16_t*)(big + B_SGB); }
  { EpiP& e = gemm(14, (const bf16_t*)(big + B_SGB), (const bf16_t*)(ws + OFF_WO), T, D, D); e.mode = M_RESID; e.alpha = 1.0f; e.of = p.out; e.r0 = p.out; e.r1 = p.out + (size_t)TP * D; e.ob = xb; e.ss_out = ss2; }
  { EpiP& e = gemm(15, xb, (const bf16_t*)(ws + OFF_WGU2), T, 2 * FF, D); e.mode = M_SWIGLU; e.ss = ss2; e.ob = (bf16_t*)(big + B_ACT); }
  { EpiP& e = gemm(16, (const bf16_t*)(big + B_ACT), (const bf16_t*)(ws + OFF_WD2), T, D, FF); e.mode = M_RESID; e.alpha = 0.5f; e.of = p.out; e.r0 = p.out; e.r1 = p.out + (size_t)TP * D; e.ob = nullptr; e.ss_out = ss3; }
  other(17, PT_FINAL);
}

extern "C" void kernel_launch(void* const* d_in, const int* in_sizes, int n_in, void* d_out, int out_size, void* d_ws, size_t ws_size, hipStream_t stream) {
  constexpr int kDynLds = 131072 + 256;
  static int grid_blocks = 0;
  if (!grid_blocks) {
    if (n_in != 17 || out_size != T * D || ws_size < WS_NEED) { fprintf(stderr, "kernel_launch: unexpected shapes (n_in %d out %d ws %zu need %zu)\n", n_in, out_size, ws_size, (size_t)WS_NEED); grid_blocks = -1; return; }
    int dev = 0, cus = 0, per_cu = 0;
    (void)hipGetDevice(&dev);
    (void)hipDeviceGetAttribute(&cus, hipDeviceAttributeMultiprocessorCount, dev);
    (void)hipFuncSetAttribute((const void*)fwd_megakernel, hipFuncAttributeMaxDynamicSharedMemorySize, kDynLds);
    (void)hipOccupancyMaxActiveBlocksPerMultiprocessor(&per_cu, (const void*)fwd_megakernel, 512, kDynLds);
    if (per_cu < 1) per_cu = 1;
    grid_blocks = cus * per_cu;
  }
  if (grid_blocks < 0) return;
  static Params p;
  memset(&p, 0, sizeof(p));
  for (int i = 0; i < 17; ++i) p.in[i] = (const float*)d_in[i];
  p.out = (float*)d_out; p.ws = (unsigned char*)d_ws;
  fill_phases(p);
  void* args[] = {&p};
  hipError_t e = hipLaunchCooperativeKernel((const void*)fwd_megakernel, dim3(grid_blocks), dim3(512), args, kDynLds, stream);
  if (e != hipSuccess) fprintf(stderr, "cooperative launch failed: %s (grid %d)\n", hipGetErrorString(e), grid_blocks);
}
```

```cpp
#include <hip/hip_runtime.h>
#include <hip/hip_cooperative_groups.h>
#include <cstdio>
#include <cstdint>
#include <cstring>
namespace cg = cooperative_groups;
__device__ __forceinline__ int opq_tid() { int t = threadIdx.x; asm volatile("" : "+v"(t)); return t; }
__device__ __forceinline__ int opq_bid() { int b = blockIdx.x; asm volatile("" : "+s"(b)); return b; }
namespace pg8 {
#define PG8_LAS __attribute__((address_space(3)))
typedef unsigned short bf16_t;
typedef short bf16x8 __attribute__((ext_vector_type(8)));
typedef float f32x4 __attribute__((ext_vector_type(4)));
typedef unsigned u32x4 __attribute__((ext_vector_type(4)));
constexpr int BM = 256, BK = 64, HALF = 128, HTB = HALF * BK * 2  , STAGE_BYTES = 8 * HTB, NXCD = 8, WGM = 8;

__host__ __device__ __forceinline__ int lds_byte(int r, int c) { const int st = (r >> 4) * 2 + (c >> 5), rr = r & 15, cc = c & 31, ob = rr * 64 + cc * 2; return st * 1024 + (ob ^ (((ob >> 9) & 1) << 5)); }
__host__ __device__ __forceinline__ void stage_rc(int b, int& R, int& C) { const int st = b / 1024, sb = b % 1024, swz = sb ^ (((sb >> 9) & 1) << 5); R = (st >> 1) * 16 + swz / 64; C = (st & 1) * 32 + (swz % 64) / 2; }
__host__ __device__ __forceinline__ int perm32(int rho) { const int n = rho >> 4, i = rho & 15; return 8 * (i >> 2) + 4 * n + (i & 3); }

struct Unit { int pm, pn; };
struct Gemm { const bf16_t* A; const bf16_t* Bt; int M, N, K; };

struct StaticOrder {
    int nM, nN, nwg, G, c;
    __host__ __device__ void init(int M, int N, int G_, int c_) { nM = M / BM; nN = N / BM; nwg = nM * nN; G = G_; c = c_; }
    __host__ __device__ bool next(int i, Unit& u) const {
        const long L = (long)i * G + c; if (L >= nwg) return false;
        int wgid = (int)L; { const int q = nwg / NXCD, r = nwg % NXCD, xcd = wgid % NXCD, off = wgid / NXCD; wgid = (xcd < r ? xcd * (q + 1) : r * (q + 1) + (xcd - r) * q) + off; }
        const int nig = WGM * nN, gid = wgid / nig, fm = gid * WGM, gsz = (nM - fm) < WGM ? (nM - fm) : WGM;
        u.pm = fm + ((wgid % nig) % gsz); u.pn = (wgid % nig) / gsz; return true;
    }
    __device__ __forceinline__ void a_ready(const Unit&) const {}
    __device__ __forceinline__ void done(const Unit&) const {}
};
template <class Epi, class Sched>
__device__ __forceinline__ void gemm_phase(PG8_LAS unsigned char* lds, const Gemm g, const Sched& S, const Epi& E) {
    const int tid = opq_tid(), wid = __builtin_amdgcn_readfirstlane(tid >> 6), lane = tid & 63, wr = wid >> 2, wc = wid & 3, fr = lane & 15, fq = lane >> 4;
    const int K = g.K, nt = K / BK;
    unsigned voffA[2], voffB[2];
#pragma unroll
    for (int i = 0; i < 2; ++i) { int R, C; stage_rc(tid * 16 + i * 8192, R, C); const int Rb = Epi::PERM ? ((R & ~31) + perm32(R & 31)) : R;
        voffA[i] = (unsigned)(R * K + C) * 2u; voffB[i] = (unsigned)(Rb * K + C) * 2u; }
    const size_t kstep = (size_t)(BK * 2);
    const size_t hstep = (size_t)HALF * K * 2;
    const size_t tstep = 2 * hstep;
    const unsigned ldsw = (unsigned)wid * 1024u;
    const int aoff = lds_byte(wr * 64 + fr, fq * 8), boff = lds_byte(wc * 32 + fr, fq * 8);
#define PG8_SA(b, h) (((b) * 2 + (h)) * HTB)
#define PG8_SB(b, h) ((4 + (b) * 2 + (h)) * HTB)
#define PG8_STAGE(bufoff, gbase, voff) do { _Pragma("unroll") for (int _i = 0; _i < 2; ++_i) \
        __builtin_amdgcn_global_load_lds((const unsigned*)((const char*)(gbase) + (voff)[_i]), (PG8_LAS unsigned*)(lds + (bufoff) + ldsw + _i * 8192), 16, 0, 0); } while (0)
#define PG8_LDA(dst, b, h) do { _Pragma("unroll") for (int m = 0; m < 4; ++m) _Pragma("unroll") for (int k = 0; k < 2; ++k) dst[m][k] = *(const PG8_LAS bf16x8*)(lds + PG8_SA(b, h) + aoff + m * 2048 + k * 1024); } while (0)
#define PG8_LDB(dst, b, h) do { _Pragma("unroll") for (int n = 0; n < 2; ++n) _Pragma("unroll") for (int k = 0; k < 2; ++k) dst[n][k] = *(const PG8_LAS bf16x8*)(lds + PG8_SB(b, h) + boff + n * 2048 + k * 1024); } while (0)
#define PG8_MMA(ai, bj, At, Bt) do { __builtin_amdgcn_s_setprio(1); _Pragma("unroll") for (int m = 0; m < 4; ++m) _Pragma("unroll") for (int n = 0; n < 2; ++n) _Pragma("unroll") for (int k = 0; k < 2; ++k) \
        acc[ai][bj][m][n] = __builtin_amdgcn_mfma_f32_16x16x32_bf16(Bt[n][k], At[m][k], acc[ai][bj][m][n], 0, 0, 0); __builtin_amdgcn_s_setprio(0); } while (0)
#define PG8_WAIT_V(n) asm volatile("s_waitcnt vmcnt(" #n ")" ::: "memory")
#define PG8_WAIT_L(n) asm volatile("s_waitcnt lgkmcnt(" #n ")" ::: "memory")
#define PG8_BAR __builtin_amdgcn_s_barrier()
#define PG8_SCHED __builtin_amdgcn_sched_barrier(0)
    Unit cur, nxt; int ui = 0;
    if (!S.next(0, cur)) return;
    f32x4 acc[2][2][4][2];
#pragma unroll
    for (int a = 0; a < 2; ++a)
#pragma unroll
        for (int b = 0; b < 2; ++b)
#pragma unroll
            for (int m = 0; m < 4; ++m)
#pragma unroll
                for (int n = 0; n < 2; ++n) acc[a][b][m][n] = (f32x4){0.f, 0.f, 0.f, 0.f};
    bf16x8 At[4][2], B0[2][2], B1[2][2];
    const char* cA = (const char*)g.A + (size_t)cur.pm * tstep; const char* cB = (const char*)g.Bt + (size_t)cur.pn * tstep;
    S.a_ready(cur);
    PG8_STAGE(PG8_SB(0, 0), cB, voffB); PG8_STAGE(PG8_SA(0, 0), cA, voffA); PG8_STAGE(PG8_SB(0, 1), cB + hstep, voffB); PG8_STAGE(PG8_SA(0, 1), cA + hstep, voffA);
    if (wr == 1) PG8_BAR;
    PG8_WAIT_V(4); PG8_BAR;
    PG8_STAGE(PG8_SB(1, 0), cB + kstep, voffB); PG8_STAGE(PG8_SA(1, 0), cA + kstep, voffA); PG8_STAGE(PG8_SB(1, 1), cB + hstep + kstep, voffB);
    PG8_WAIT_V(6); PG8_BAR;
    for (;;) {
        const bool has_next = S.next(ui + 1, nxt);
        const char* nA = has_next ? (const char*)g.A + (size_t)nxt.pm * tstep : cA; const char* nB = has_next ? (const char*)g.Bt + (size_t)nxt.pn * tstep : cB;
        for (int t = 0; t < nt; t += 2) {
            const bool last = (t == nt - 2);
            const char* a1 = cA + (size_t)(t + 1) * kstep;
            const char* a2 = last ? nA : cA + (size_t)(t + 2) * kstep; const char* b2 = last ? nB : cB + (size_t)(t + 2) * kstep;
            const char* a3 = a2 + kstep; const char* b3 = b2 + kstep;
            if (last && has_next) S.a_ready(nxt);
            PG8_LDB(B0, 0, 0); PG8_SCHED; PG8_LDA(At, 0, 0); PG8_STAGE(PG8_SA(1, 1), a1 + hstep, voffA);
            PG8_WAIT_L(8); PG8_BAR; PG8_WAIT_L(0); PG8_MMA(0, 0, At, B0); PG8_BAR; PG8_SCHED;
            PG8_LDB(B1, 0, 1); PG8_STAGE(PG8_SB(0, 0), b2, voffB);
            PG8_BAR; PG8_WAIT_L(0); PG8_MMA(0, 1, At, B1); PG8_BAR;
            PG8_LDA(At, 0, 1); PG8_STAGE(PG8_SA(0, 0), a2, voffA);
            PG8_BAR; PG8_WAIT_L(0); PG8_MMA(1, 0, At, B0); PG8_BAR; PG8_SCHED;
            PG8_STAGE(PG8_SB(0, 1), b2 + hstep, voffB);
            PG8_WAIT_V(6); PG8_BAR; PG8_MMA(1, 1, At, B1); PG8_BAR;
            PG8_LDB(B0, 1, 0); PG8_SCHED; PG8_LDA(At, 1, 0); PG8_STAGE(PG8_SA(0, 1), a2 + hstep, voffA);
            PG8_WAIT_L(8); PG8_BAR; PG8_WAIT_L(0); PG8_MMA(0, 0, At, B0); PG8_BAR; PG8_SCHED;
            PG8_LDB(B1, 1, 1); PG8_STAGE(PG8_SB(1, 0), b3, voffB);
            PG8_BAR; PG8_WAIT_L(0); PG8_MMA(0, 1, At, B1); PG8_BAR;
            PG8_LDA(At, 1, 1); PG8_STAGE(PG8_SA(1, 0), a3, voffA);
            PG8_BAR; PG8_WAIT_L(0); PG8_MMA(1, 0, At, B0); PG8_BAR; PG8_SCHED;
            PG8_STAGE(PG8_SB(1, 1), b3 + hstep, voffB);
            PG8_WAIT_V(6); PG8_BAR; PG8_MMA(1, 1, At, B1); PG8_BAR;
        }
        if constexpr (!Epi::AFTER_DRAIN) { E(acc, cur, wr, wc, fr, fq); S.done(cur); }
        if (!has_next) break;
#pragma unroll
        for (int a = 0; a < 2; ++a)
#pragma unroll
            for (int b = 0; b < 2; ++b)
#pragma unroll
                for (int m = 0; m < 4; ++m)
#pragma unroll
                    for (int n = 0; n < 2; ++n) acc[a][b][m][n] = (f32x4){0.f, 0.f, 0.f, 0.f};
        cur = nxt; cA = nA; cB = nB; ++ui;
    }
    PG8_WAIT_V(0);
    if (wr == 0) PG8_BAR;
    PG8_BAR;
    if constexpr (Epi::AFTER_DRAIN) { E.fused(acc, cur, wr, wc, fr, fq, lds, wid, lane); S.done(cur); }
#undef PG8_SA
#undef PG8_SB
#undef PG8_STAGE
#undef PG8_LDA
#undef PG8_LDB
#undef PG8_MMA
#undef PG8_WAIT_V
#undef PG8_WAIT_L
#undef PG8_BAR
#undef PG8_SCHED
}
}

using pg8::f32x4; using pg8::bf16_t; using pg8::u32x4;
typedef unsigned u32x2 __attribute__((ext_vector_type(2)));
#define DI __device__ __forceinline__

constexpr int T = 49152, TP = 16384, D = 1024, FF = 2816, NIN = 11776, THALF = 24576;
constexpr float EPS = 1e-6f;

DI unsigned pk2(float lo, float hi) { unsigned r; asm volatile("v_cvt_pk_bf16_f32 %0, %1, %2" : "=v"(r) : "v"(lo), "v"(hi)); return r; }
DI float bflo(unsigned u) { return __uint_as_float(u << 16); }
DI float bfhi(unsigned u) { return __uint_as_float(u & 0xffff0000u); }
DI float bf1(bf16_t b) { return __uint_as_float(((unsigned)b) << 16); }
DI float sigm(float x) { return __builtin_amdgcn_rcpf(1.0f + __expf(-x)); }
DI float wave_sum(float v) {
#pragma unroll
  for (int o = 1; o < 64; o <<= 1) v += __shfl_xor(v, o);
  return v;
}
DI float wave_max(float v) {
#pragma unroll
  for (int o = 1; o < 64; o <<= 1) v = fmaxf(v, __shfl_xor(v, o));
  return v;
}

DI float ss16(const float* p) { const f32x4 a = *(const f32x4*)p, b = *(const f32x4*)(p + 4), c = *(const f32x4*)(p + 8), d = *(const f32x4*)(p + 12);
  return ((a[0] + a[1]) + (a[2] + a[3])) + ((b[0] + b[1]) + (b[2] + b[3])) + ((c[0] + c[1]) + (c[2] + c[3])) + ((d[0] + d[1]) + (d[2] + d[3])); }
enum { M_SWIGLU = 0, M_BF16S = 1, M_RESID = 2, M_MUL = 3, M_FMA = 4 };

struct EpiP {
  int mode, sig, split_tiles, ldo;
  const float* ss; bf16_t* ob; size_t split_stride;
  float* of; const float* r0; const float* r1; float alpha; int pad; float* ss_out;
  const bf16_t* sg; const float* tmp;
};
struct Epi {
  static constexpr bool PERM = false, AFTER_DRAIN = false;
  const PG8_LAS EpiP* lp;
  __device__ __forceinline__ void operator()(const f32x4 (&acc)[2][2][4][2], const pg8::Unit& u, int wr, int wc, int fr, int fq) const {
    const int mode = lp->mode, sig = lp->sig, split_tiles = lp->split_tiles, ldo = lp->ldo;
    const float* ss = lp->ss; bf16_t* ob = lp->ob; const size_t split_stride = lp->split_stride;
    float* of = lp->of; const float* r0 = lp->r0; const float* r1 = lp->r1; const float alpha = lp->alpha; float* ss_out = lp->ss_out;
    const bf16_t* sg = lp->sg; const float* tmp = lp->tmp;
    const int rowb = u.pm * 256 + wr * 64 + fr;
    if (mode == M_SWIGLU) {
#pragma unroll
      for (int ai = 0; ai < 2; ++ai)
#pragma unroll
        for (int m = 0; m < 4; ++m) {
          const int row = rowb + ai * 128 + m * 16;
          const float rs = rsqrtf(ss16(ss + (size_t)row * 16) * (1.0f / 1024.0f) + EPS);
          float h[8];
#pragma unroll
          for (int n = 0; n < 2; ++n)
#pragma unroll
            for (int j = 0; j < 4; ++j) { const float a = acc[ai][0][m][n][j] * rs, b = acc[ai][1][m][n][j] * rs; h[n * 4 + j] = a * sigm(a) * b; }
          u32x4 w; w.x = pk2(h[0], h[1]); w.y = pk2(h[2], h[3]); w.z = pk2(h[4], h[5]); w.w = pk2(h[6], h[7]);
          *(u32x4*)(ob + (size_t)row * FF + u.pn * 128 + wc * 32 + fq * 8) = w;
        }
    } else if (mode == M_BF16S) {
      int pn = u.pn; bf16_t* base = ob;
      if (split_tiles) { const int t = pn / split_tiles; base += (size_t)t * split_stride; pn -= t * split_tiles; }
#pragma unroll
      for (int ai = 0; ai < 2; ++ai)
#pragma unroll
        for (int m = 0; m < 4; ++m) {
          const int row = rowb + ai * 128 + m * 16;
          const float rs = rsqrtf(ss16(ss + (size_t)row * 16) * (1.0f / 1024.0f) + EPS);
#pragma unroll
          for (int bj = 0; bj < 2; ++bj) {
            float v[8];
#pragma unroll
            for (int n = 0; n < 2; ++n)
#pragma unroll
              for (int j = 0; j < 4; ++j) { float x = acc[ai][bj][m][n][j] * rs; if (sig) x = sigm(x); v[n * 4 + j] = x; }
            u32x4 w; w.x = pk2(v[0], v[1]); w.y = pk2(v[2], v[3]); w.z = pk2(v[4], v[5]); w.w = pk2(v[6], v[7]);
            *(u32x4*)(base + (size_t)row * ldo + pn * 256 + bj * 128 + wc * 32 + fq * 8) = w;
          }
        }
    } else if (mode == M_RESID) {
#pragma unroll
      for (int ai = 0; ai < 2; ++ai)
#pragma unroll
        for (int m = 0; m < 4; ++m) {
          const int row = rowb + ai * 128 + m * 16;
          const float* rp = row < TP ? r0 + (size_t)row * D : r1 + (size_t)(row - TP) * D;
          float s2 = 0.f;
#pragma unroll
          for (int bj = 0; bj < 2; ++bj)
#pragma unroll
            for (int n = 0; n < 2; ++n) {
              const int c0 = u.pn * 256 + bj * 128 + wc * 32 + n * 16 + fq * 4;
              const f32x4 r = *(const f32x4*)(rp + c0);
              const f32x4 o = r + alpha * acc[ai][bj][m][n];
              *(f32x4*)(of + (size_t)row * D + c0) = o;
              if (ob) { u32x2 w; w.x = pk2(o[0], o[1]); w.y = pk2(o[2], o[3]); *(u32x2*)(ob + (size_t)row * D + c0) = w; }
              s2 += (o[0] * o[0] + o[1] * o[1]) + (o[2] * o[2] + o[3] * o[3]);
            }
          s2 += __shfl_xor(s2, 16); s2 += __shfl_xor(s2, 32);
          if (fq == 0) ss_out[(size_t)row * 16 + u.pn * 4 + wc] = s2;
        }
    } else {
#pragma unroll
      for (int ai = 0; ai < 2; ++ai)
#pragma unroll
        for (int m = 0; m < 4; ++m) {
          const int row = rowb + ai * 128 + m * 16;
#pragma unroll
          for (int bj = 0; bj < 2; ++bj)
#pragma unroll
            for (int n = 0; n < 2; ++n) {
              const int c0 = u.pn * 256 + bj * 128 + wc * 32 + n * 16 + fq * 4;
              const u32x2 g2 = *(const u32x2*)(sg + (size_t)row * D + c0);
              f32x4 gv; gv[0] = bflo(g2.x); gv[1] = bfhi(g2.x); gv[2] = bflo(g2.y); gv[3] = bfhi(g2.y);
              if (mode == M_MUL) {
                *(f32x4*)(of + (size_t)row * D + c0) = gv * acc[ai][bj][m][n];
              } else {
                const f32x4 t4 = *(const f32x4*)(tmp + (size_t)row * D + c0);
                const f32x4 o = t4 + gv * acc[ai][bj][m][n];
                u32x2 w; w.x = pk2(o[0], o[1]); w.y = pk2(o[2], o[3]); *(u32x2*)(ob + (size_t)row * D + c0) = w;
              }
            }
        }
    }
  }
};

constexpr size_t SZ_WGU = (size_t)2 * FF * D * 2, SZ_WD = (size_t)D * FF * 2, SZ_WIN = (size_t)NIN * D * 2;
constexpr size_t OFF_WGU1 = 0, OFF_WD1 = OFF_WGU1 + SZ_WGU, OFF_WGU2 = OFF_WD1 + SZ_WD, OFF_WD2 = OFF_WGU2 + SZ_WGU, OFF_WIN = OFF_WD2 + SZ_WD;
constexpr size_t OFF_WA = OFF_WIN + SZ_WIN, OFF_WB = OFF_WA + (size_t)D * 512 * 2, OFF_WO = OFF_WB + (size_t)D * D * 2, OFF_XB = OFF_WO + (size_t)D * D * 2;
constexpr size_t OFF_SS = OFF_XB + (size_t)T * D * 2, OFF_CTR = OFF_SS + (size_t)4 * T * 16 * 4, OFF_BIG = OFF_CTR + 256;
constexpr size_t B_ACT = 0, B_PROJH = 0, B_OFB = (size_t)T * 4096 * 2, B_HG = 0, B_YB = (size_t)T * D * 2, B_QKV = B_YB + (size_t)T * D * 2;
constexpr size_t B_OG = B_QKV + (size_t)THALF * 4608 * 2, B_LSE = B_OG + (size_t)3 * T * 512 * 2, B_YA = 0, B_SGA = B_QKV, B_SGB = B_SGA + (size_t)T * D * 2, B_TMP = B_SGB + (size_t)T * D * 2;
constexpr size_t WS_NEED = OFF_BIG + B_TMP + (size_t)T * D * 4;

struct PhaseDesc { int type, M, N, K; const bf16_t* A; const bf16_t* Bt; EpiP e; };
struct Params {
  const float* in[17];
  float* out; unsigned char* ws;
  PhaseDesc ph[18];
};

enum { MAP_NAT = 0, MAP_P32 = 1, MAP_GU = 2 };
DI int srccol(int map, int np) {
  if (map == MAP_NAT) return np;
  if (map == MAP_P32) return (np & ~31) + pg8::perm32(np & 31);
  const int pn = np >> 8, w = np & 255, bj = w >> 7, wc = (w & 127) >> 5, n = (w & 31) >> 4, fq = (w & 15) >> 2, j = w & 3;
  return bj * FF + 128 * pn + 32 * wc + 8 * fq + 4 * n + j;
}
DI void transpose_item(const float* W, int K, int Nsrc, const float* gain, bf16_t* WT, int map, float* scr, int item, int nblk, int lane) {
  const int kb = item / nblk, nb = item % nblk, k0 = 64 * kb, n0 = 32 * nb;
  const int sc = srccol(map, n0 + (lane & 31));
#pragma unroll 8
  for (int i = 0; i < 32; ++i) { const int kk = 2 * i + (lane >> 5); scr[kk * 33 + (lane & 31)] = W[(size_t)(k0 + kk) * Nsrc + sc]; }
  asm volatile("s_waitcnt lgkmcnt(0)" ::: "memory");
  const int c = lane & 7;
  float g8[8];
#pragma unroll
  for (int e = 0; e < 8; ++e) g8[e] = gain ? gain[k0 + 8 * c + e] : 1.0f;
#pragma unroll
  for (int j = 0; j < 4; ++j) {
    const int n = (lane >> 3) + 8 * j; const float* s = scr + (8 * c) * 33 + n;
    u32x4 o; o.x = pk2(s[0 * 33] * g8[0], s[1 * 33] * g8[1]); o.y = pk2(s[2 * 33] * g8[2], s[3 * 33] * g8[3]);
    o.z = pk2(s[4 * 33] * g8[4], s[5 * 33] * g8[5]); o.w = pk2(s[6 * 33] * g8[6], s[7 * 33] * g8[7]);
    *(u32x4*)(WT + (size_t)(n0 + n) * K + k0 + 8 * c) = o;
  }
  asm volatile("s_waitcnt lgkmcnt(0)" ::: "memory");
}

DI void prep_phase(const Params& p, unsigned char* shm) {
  const int tid = opq_tid(), wid = tid >> 6, lane = tid & 63;
  const int bid = opq_bid(); const int gw = bid * 8 + wid, NGW = gridDim.x * 8;
  unsigned char* ws = p.ws;
  if (bid == 0 && tid < 64) ((unsigned*)(ws + OFF_CTR))[tid] = 0u;
  { float* ss0 = (float*)(ws + OFF_SS); bf16_t* xb = (bf16_t*)(ws + OFF_XB);
    for (int row = gw; row < T; row += NGW) {
      const float* xr = row < TP ? p.in[0] + (size_t)row * D : p.in[1] + (size_t)(row - TP) * D;
      f32x4 v[4]; float s = 0.f;
#pragma unroll
      for (int j = 0; j < 4; ++j) { v[j] = *(const f32x4*)(xr + 4 * lane + 256 * j); s += (v[j][0] * v[j][0] + v[j][1] * v[j][1]) + (v[j][2] * v[j][2] + v[j][3] * v[j][3]); }
      s = wave_sum(s);
      if (lane < 16) ss0[(size_t)row * 16 + lane] = lane == 0 ? s : 0.f;
#pragma unroll
      for (int j = 0; j < 4; ++j) { u32x2 w; w.x = pk2(v[j][0], v[j][1]); w.y = pk2(v[j][2], v[j][3]); *(u32x2*)(xb + (size_t)row * D + 4 * lane + 256 * j) = w; }
    } }
  float* scr = (float*)(shm + wid * 8704);
  for (int wsel = 0; wsel < 8; ++wsel) {
    const float* W; const float* gain = nullptr; bf16_t* WT; int K, Nsrc, Nd, map;
    switch (wsel) {
      case 0: W = p.in[3]; gain = p.in[2]; WT = (bf16_t*)(ws + OFF_WGU1); K = D; Nsrc = 2 * FF; Nd = 2 * FF; map = MAP_GU; break;
      case 1: W = p.in[4]; WT = (bf16_t*)(ws + OFF_WD1); K = FF; Nsrc = D; Nd = D; map = MAP_NAT; break;
      case 2: W = p.in[6]; gain = p.in[5]; WT = (bf16_t*)(ws + OFF_WIN); K = D; Nsrc = NIN; Nd = NIN; map = MAP_P32; break;
      case 3: W = p.in[10]; WT = (bf16_t*)(ws + OFF_WA); K = 512; Nsrc = D; Nd = D; map = MAP_NAT; break;
      case 4: W = p.in[11]; WT = (bf16_t*)(ws + OFF_WB); K = D; Nsrc = D; Nd = D; map = MAP_NAT; break;
      case 5: W = p.in[12]; WT = (bf16_t*)(ws + OFF_WO); K = D; Nsrc = D; Nd = D; map = MAP_NAT; break;
      case 6: W = p.in[14]; gain = p.in[13]; WT = (bf16_t*)(ws + OFF_WGU2); K = D; Nsrc = 2 * FF; Nd = 2 * FF; map = MAP_GU; break;
      default: W = p.in[15]; WT = (bf16_t*)(ws + OFF_WD2); K = FF; Nsrc = D; Nd = D; map = MAP_NAT; break;
    }
    const int nblk = Nd / 32, nitems = (K / 64) * nblk;
    for (int it = gw; it < nitems; it += NGW) transpose_item(W, K, Nsrc, gain, WT, map, scr, it, nblk, lane);
  }
}

DI void hgrn_naive_phase(const Params& p, unsigned char* shm) {
  const int chain = opq_bid();
  if (chain >= 128) return;
  const int tid = opq_tid(), wid = tid >> 6, lane = tid & 63;
  const int seq = chain >> 4, head = (chain >> 1) & 7, dir = chain & 1;
  const int slen = seq < 4 ? 4096 : 8192, row0 = seq < 4 ? seq * 4096 : TP + (seq - 4) * 8192;
  const bf16_t* pj = (const bf16_t*)(p.ws + OFF_BIG + B_PROJH);
  bf16_t* od = (bf16_t*)(p.ws + OFF_BIG + B_OFB) + (size_t)dir * T * D;
  const float* lbw = dir ? p.in[8] : p.in[7];
  float* gq = (float*)shm; float* gf = gq + 2048; float* gk = gf + 2048; float* gv = gk + 2048;
  const int vl = lane & 15, kq = lane >> 4, v = 16 * wid + vl;
  float S[32];
#pragma unroll
  for (int i = 0; i < 32; ++i) S[i] = 0.f;
  const int fk = tid & 127;
  const float lb = 1.0f / (1.0f + __expf(lbw[D + head * 128 + fk] - lbw[head * 128 + fk]));
  for (int i0 = 0; i0 < slen; i0 += 16) {
    __syncthreads();
#pragma unroll
    for (int r = 0; r < 4; ++r) {
      const int tt = (tid >> 7) + 4 * r; const int t = dir ? slen - 1 - (i0 + tt) : i0 + tt; const size_t rb = (size_t)(row0 + t) * 4096 + head * 128 + fk;
      const float hq = bf1(pj[rb]), hf = bf1(pj[rb + 1024 * (1 + dir)]), hi = bf1(pj[rb + 3072]);
      const float s = sigm(hf);
      gq[tt * 128 + fk] = hq * sigm(hq); gf[tt * 128 + fk] = lb + (1.0f - lb) * s; gk[tt * 128 + fk] = (1.0f - lb) * (1.0f - s); gv[tt * 128 + fk] = hi;
    }
    __syncthreads();
    for (int tt = 0; tt < 16; ++tt) {
      const float val = gv[tt * 128 + v]; float o = 0.f;
#pragma unroll
      for (int k4 = 0; k4 < 8; ++k4) {
        const f32x4 f4 = *(const f32x4*)(gf + tt * 128 + 32 * kq + 4 * k4), k4v = *(const f32x4*)(gk + tt * 128 + 32 * kq + 4 * k4), q4 = *(const f32x4*)(gq + tt * 128 + 32 * kq + 4 * k4);
#pragma unroll
        for (int e = 0; e < 4; ++e) { S[4 * k4 + e] = f4[e] * S[4 * k4 + e] + k4v[e] * val; o += q4[e] * S[4 * k4 + e]; }
      }
      o += __shfl_xor(o, 16); o += __shfl_xor(o, 32);
      const int t = dir ? slen - 1 - (i0 + tt) : i0 + tt;
      if (kq == 0) od[(size_t)(row0 + t) * D + head * 128 + v] = (bf16_t)(pk2(o, 0.f) & 0xffffu);
    }
  }
}

DI void combine_phase(const Params& p) {
  const int tid = opq_tid(), wid = tid >> 6, lane = tid & 63;
  const int bid = opq_bid(); const int gw = bid * 8 + wid, NGW = gridDim.x * 8;
  const bf16_t* oF = (const bf16_t*)(p.ws + OFF_BIG + B_OFB); const bf16_t* oB = oF + (size_t)T * D;
  const bf16_t* hg = (const bf16_t*)(p.ws + OFF_BIG + B_HG); bf16_t* yb = (bf16_t*)(p.ws + OFF_BIG + B_YB);
  const float* ng = p.in[9];
  const int c0 = lane * 16;
  float g[16];
#pragma unroll
  for (int i = 0; i < 16; ++i) g[i] = ng[c0 + i];
  for (int row = gw; row < T; row += NGW) {
    const size_t b = (size_t)row * D + c0;
    float o[16]; float s = 0.f;
#pragma unroll
    for (int h = 0; h < 2; ++h) {
      const u32x4 a = *(const u32x4*)(oF + b + 8 * h), c = *(const u32x4*)(oB + b + 8 * h);
#pragma unroll
      for (int e = 0; e < 4; ++e) { o[8 * h + 2 * e] = bflo(a[e]) + bflo(c[e]); o[8 * h + 2 * e + 1] = bfhi(a[e]) + bfhi(c[e]); }
    }
#pragma unroll
    for (int i = 0; i < 16; ++i) s += o[i] * o[i];
    s += __shfl_xor(s, 1); s += __shfl_xor(s, 2); s += __shfl_xor(s, 4);
    const float rs = rsqrtf(s * (1.0f / 128.0f) + EPS);
#pragma unroll
    for (int h = 0; h < 2; ++h) {
      const u32x4 gg = *(const u32x4*)(hg + b + 8 * h); u32x4 w;
#pragma unroll
      for (int e = 0; e < 4; ++e) {
        const float g0 = bflo(gg[e]), g1 = bfhi(gg[e]);
        w[e] = pk2(o[8 * h + 2 * e] * rs * g[8 * h + 2 * e] * g0 * sigm(g0), o[8 * h + 2 * e + 1] * rs * g[8 * h + 2 * e + 1] * g1 * sigm(g1));
      }
      *(u32x4*)(yb + b + 8 * h) = w;
    }
  }
}

DI void attn_naive_phase(const Params& p, int half) {
  const int tid = opq_tid(), wid = tid >> 6, lane = tid & 63;
  const int bid = opq_bid(); const int gw = bid * 8 + wid, NGW = gridDim.x * 8;
  const int row_base = half * THALF;
  const bf16_t* base = (const bf16_t*)(p.ws + OFF_BIG + B_QKV) - (size_t)row_base * 4608;
  bf16_t* ya = (bf16_t*)(p.ws + OFF_BIG + B_YA);
  for (int unit = gw; unit < THALF * 8; unit += NGW) {
    const int row = row_base + (unit >> 3), j = unit & 7;
    int s0, slen; if (row < TP) { s0 = row & ~4095; slen = 4096; } else { s0 = TP + ((row - TP) & ~8191); slen = 8192; }
    const int t = row - s0;
    const float slope = exp2f(-(float)(j + 1));
    float sc[3][3];
#pragma unroll
    for (int g = 0; g < 3; ++g) {
      const int d = g == 0 ? 1 : (g == 1 ? 4 : 16);
      u32x4 qv[8];
      { const u32x4* qp = (const u32x4*)(base + (size_t)row * 4608 + g * 512 + j * 64);
#pragma unroll
        for (int i = 0; i < 8; ++i) qv[i] = qp[i]; }
#pragma unroll
      for (int r = 0; r < 3; ++r) {
        const int joff = lane + 64 * r - 64; const int pos = t + d * joff;
        const bool valid = (r < 2 || lane == 0) && pos >= 0 && pos < slen;
        float s = -1e30f;
        if (valid) {
          const u32x4* kp = (const u32x4*)(base + (size_t)(s0 + pos) * 4608 + 1536 + g * 512 + j * 64);
          float dot = 0.f;
#pragma unroll
          for (int i = 0; i < 8; ++i) { const u32x4 kv = kp[i];
#pragma unroll
            for (int e = 0; e < 4; ++e) dot += bflo(kv[e]) * bflo(qv[i][e]) + bfhi(kv[e]) * bfhi(qv[i][e]); }
          s = dot * 0.125f - slope * (float)(d * (joff < 0 ? -joff : joff));
        }
        sc[g][r] = s;
      }
    }
    float m = -1e30f;
#pragma unroll
    for (int g = 0; g < 3; ++g)
#pragma unroll
      for (int r = 0; r < 3; ++r) m = fmaxf(m, sc[g][r]);
    m = wave_max(m);
    float l = 0.f;
#pragma unroll
    for (int g = 0; g < 3; ++g)
#pragma unroll
      for (int r = 0; r < 3; ++r) { sc[g][r] = sc[g][r] > -1e29f ? __expf(sc[g][r] - m) : 0.f; l += sc[g][r]; }
    l = wave_sum(l);
    float o = 0.f;
#pragma unroll
    for (int g = 0; g < 3; ++g) {
      const int d = g == 0 ? 1 : (g == 1 ? 4 : 16);
      const bf16_t* vb = base + 3072 + g * 512 + j * 64 + lane;
#pragma unroll
      for (int r = 0; r < 3; ++r) {
        const int ntl = r < 2 ? 64 : 1;
        for (int tl = 0; tl < ntl; ++tl) {
          const float pb = __uint_as_float(__builtin_amdgcn_readlane(__float_as_uint(sc[g][r]), tl));
          if (pb != 0.f) { const int pos = t + d * (tl + 64 * r - 64); o += pb * bf1(vb[(size_t)(s0 + pos) * 4608]); }
        }
      }
    }
    ya[(size_t)row * 512 + j * 64 + lane] = (bf16_t)(pk2(o / l, 0.f) & 0xffffu);
  }
}


typedef float f32x16 __attribute__((ext_vector_type(16)));
typedef short s16x4 __attribute__((ext_vector_type(4)));
typedef __bf16 bf16v2_t __attribute__((ext_vector_type(2)));
typedef float f32v2_t __attribute__((ext_vector_type(2)));
DI unsigned pk2c(float a, float b) { f32v2_t v = {a, b}; bf16v2_t r = __builtin_convertvector(v, bf16v2_t); return __builtin_bit_cast(unsigned, r); }
#define MFMA32(a, b, c) __builtin_amdgcn_mfma_f32_32x32x16_bf16((a), (b), (c), 0, 0, 0)
DI int crow(int i, int h) { return (i & 3) + 8 * (i >> 2) + 4 * h; }
DI void tr_read4(unsigned a0, unsigned a1, unsigned a2, unsigned a3, s16x4& r0, s16x4& r1, s16x4& r2, s16x4& r3) {
  asm volatile("ds_read_b64_tr_b16 %0, %4\n\tds_read_b64_tr_b16 %1, %5\n\tds_read_b64_tr_b16 %2, %6\n\tds_read_b64_tr_b16 %3, %7\n\ts_waitcnt lgkmcnt(0)"
               : "=&v"(r0), "=&v"(r1), "=&v"(r2), "=&v"(r3) : "v"(a0), "v"(a1), "v"(a2), "v"(a3) : "memory");
}
constexpr int AROW = 144;
constexpr int AV_OFF = 384 * AROW;

DI void attn_phase(const Params& p, int half, unsigned char* shm) {
  const int tid = opq_tid(), wid = tid >> 6, lane = tid & 63, bid = opq_bid();
  const int q32 = lane & 31, h = lane >> 5;
  const bf16_t* qkv = (const bf16_t*)(p.ws + OFF_BIG + B_QKV);
  bf16_t* og = (bf16_t*)(p.ws + OFF_BIG + B_OG);
  float* ml = (float*)(p.ws + OFF_BIG + B_LSE);
  const unsigned lbase = (unsigned)(size_t)(PG8_LAS unsigned char*)shm;
  for (int unit = bid; unit < 2304; unit += (int)gridDim.x) {
    const int g = unit / 768, rem = unit % 768, j = rem & 7, cidx = rem >> 3;
    const int d = g == 0 ? 1 : (g == 1 ? 4 : 16);
    int seq_row0, S, w;
    if (half == 0) { if (cidx < 64) { seq_row0 = (cidx >> 4) * 4096; S = 4096; w = cidx & 15; } else { seq_row0 = TP; S = 8192; w = cidx - 64; } }
    else { seq_row0 = TP + (1 + (cidx >> 5)) * 8192; S = 8192; w = cidx & 31; }
    const int r = w % d, c = w / d, L = S / d;
    const int lrow0 = seq_row0 - half * THALF;
    const int ki0 = 256 * c - 64;
    const size_t colq = (size_t)g * 512 + j * 64;
    __syncthreads();
#pragma unroll
    for (int it = 0; it < 6; ++it) {
      const int idx = tid + 512 * it, slot = idx >> 3, ch = idx & 7, ki = ki0 + slot;
      u32x4 kv = {0u, 0u, 0u, 0u}, vv = {0u, 0u, 0u, 0u};
      if (ki >= 0 && ki < L) { const bf16_t* rp = qkv + (size_t)(lrow0 + r + d * ki) * 4608 + colq + ch * 8; kv = *(const u32x4*)(rp + 1536); vv = *(const u32x4*)(rp + 3072); }
      *(u32x4*)(shm + slot * AROW + ch * 16) = kv; *(u32x4*)(shm + AV_OFF + slot * AROW + ch * 16) = vv;
    }
    pg8::bf16x8 qf[4];
    { const bf16_t* qp = qkv + (size_t)(lrow0 + r + d * (256 * c + 32 * wid + q32)) * 4608 + colq + 8 * h;
#pragma unroll
      for (int ks = 0; ks < 4; ++ks) qf[ks] = *(const pg8::bf16x8*)(qp + 16 * ks); }
    __syncthreads();
    f32x16 st[5];
#pragma unroll
    for (int kt = 0; kt < 5; ++kt) {
#pragma unroll
      for (int i = 0; i < 16; ++i) st[kt][i] = 0.f;
#pragma unroll
      for (int ks = 0; ks < 4; ++ks) {
        const pg8::bf16x8 kf = *(const pg8::bf16x8*)(shm + (32 * wid + 32 * kt + q32) * AROW + (16 * ks + 8 * h) * 2);
        st[kt] = MFMA32(kf, qf[ks], st[kt]);
      }
    }
    const float slope_d = exp2f(-(float)(j + 1)) * (float)d;
    int hu = h, qu = q32; asm volatile("" : "+v"(hu), "+v"(qu));
    float m = -1e30f;
#pragma unroll
    for (int kt = 0; kt < 5; ++kt)
#pragma unroll
      for (int i = 0; i < 16; ++i) {
        const int rel = 32 * kt + crow(i, hu) - qu - 64; const int ki = ki0 + 32 * wid + 32 * kt + crow(i, hu);
        const int arel = rel < 0 ? -rel : rel;
        const bool valid = arel <= 64 && ki >= 0 && ki < L;
        const float s = valid ? st[kt][i] * 0.125f - slope_d * (float)arel : -1e30f;
        st[kt][i] = s; m = fmaxf(m, s);
      }
    m = fmaxf(m, __shfl_xor(m, 32));
    float l = 0.f;
#pragma unroll
    for (int kt = 0; kt < 5; ++kt)
#pragma unroll
      for (int i = 0; i < 16; ++i) { const float s = st[kt][i]; const float e = s > -1e29f ? __expf(s - m) : 0.f; st[kt][i] = e; l += e; }
    l += __shfl_xor(l, 32);
    f32x16 o[2];
#pragma unroll
    for (int et = 0; et < 2; ++et)
#pragma unroll
      for (int i = 0; i < 16; ++i) o[et][i] = 0.f;
    const int i16 = lane & 15, q4 = i16 >> 2, p4 = i16 & 3, blk = (lane >> 4) & 1;
    const unsigned vaddr0 = lbase + AV_OFF + (32 * wid + 4 * h + q4) * AROW + 32 * blk + 8 * p4;
#pragma unroll
    for (int kt = 0; kt < 5; ++kt)
#pragma unroll
      for (int s2 = 0; s2 < 2; ++s2) {
        u32x4 pw; pw.x = pk2c(st[kt][8 * s2 + 0], st[kt][8 * s2 + 1]); pw.y = pk2c(st[kt][8 * s2 + 2], st[kt][8 * s2 + 3]);
        pw.z = pk2c(st[kt][8 * s2 + 4], st[kt][8 * s2 + 5]); pw.w = pk2c(st[kt][8 * s2 + 6], st[kt][8 * s2 + 7]);
        const pg8::bf16x8 pa = __builtin_bit_cast(pg8::bf16x8, pw);
        const unsigned a = vaddr0 + (32 * kt + 16 * s2) * AROW;
        s16x4 lo0, hi0, lo1, hi1;
        tr_read4(a, a + 8 * AROW, a + 64, a + 8 * AROW + 64, lo0, hi0, lo1, hi1);
        const pg8::bf16x8 v0 = __builtin_shufflevector(lo0, hi0, 0, 1, 2, 3, 4, 5, 6, 7), v1 = __builtin_shufflevector(lo1, hi1, 0, 1, 2, 3, 4, 5, 6, 7);
        o[0] = MFMA32(pa, v0, o[0]); o[1] = MFMA32(pa, v1, o[1]);
      }
    const int rowq0 = half * THALF + lrow0 + r + d * (256 * c + 32 * wid);
#pragma unroll
    for (int et = 0; et < 2; ++et)
#pragma unroll
      for (int i = 0; i < 16; ++i) {
        const int row = rowq0 + d * crow(i, h);
        og[((size_t)g * T + row) * 512 + j * 64 + 32 * et + q32] = (bf16_t)(pk2c(o[et][i], 0.f) & 0xffffu);
      }
    if (h == 0) { const int row = rowq0 + d * q32; f32v2_t v = {m, l}; *(f32v2_t*)(ml + (((size_t)g * T + row) * 8 + j) * 2) = v; }
  }
}


DI void tr_read2(unsigned a0, unsigned a1, s16x4& r0, s16x4& r1) {
  asm volatile("ds_read_b64_tr_b16 %0, %2\n\tds_read_b64_tr_b16 %1, %3\n\ts_waitcnt lgkmcnt(0)" : "=&v"(r0), "=&v"(r1) : "v"(a0), "v"(a1) : "memory");
}
constexpr int HP = 272;
constexpr int H_QT = 0, H_KT = 64 * HP, H_KE = 2 * 64 * HP, H_VV = 3 * 64 * HP, H_ST = H_VV + 64 * AROW, H_DEC = H_ST + 64 * HP, H_GG = H_DEC + 512;
DI void hgrn_phase(const Params& p, unsigned char* shm) {
  const int chain = opq_bid();
  if (chain >= 256) return;
  const int tid = opq_tid(), wid = tid >> 6, lane = tid & 63;
  const int vh = chain & 1, dir = (chain >> 1) & 1, head = (chain >> 2) & 7, seq = chain >> 5;
  const int slen = seq < 4 ? 4096 : 8192, row0 = seq < 4 ? seq * 4096 : TP + (seq - 4) * 8192, nchunks = slen >> 6;
  const bf16_t* pj = (const bf16_t*)(p.ws + OFF_BIG + B_PROJH);
  bf16_t* od = (bf16_t*)(p.ws + OFF_BIG + B_OFB) + (size_t)dir * T * D;
  const float* lbw = dir ? p.in[8] : p.in[7];
  const unsigned lbase = (unsigned)(size_t)(PG8_LAS unsigned char*)shm;
  const int c2 = 2 * lane;
  const float lb0 = 1.0f / (1.0f + __expf(lbw[D + head * 128 + c2] - lbw[head * 128 + c2]));
  const float lb1 = 1.0f / (1.0f + __expf(lbw[D + head * 128 + c2 + 1] - lbw[head * 128 + c2 + 1]));
  for (int i = tid; i < 64 * HP / 4; i += 512) ((unsigned*)(shm + H_ST))[i] = 0u;
  f32x16 Sacc[2];
#pragma unroll
  for (int b = 0; b < 2; ++b)
#pragma unroll
    for (int i = 0; i < 16; ++i) Sacc[b][i] = 0.f;
  unsigned rq[8], rf[8]; u32x4 rv;
#define HG_LOAD(cc) do { _Pragma("unroll") for (int ii = 0; ii < 8; ++ii) { const int il = 64 * (cc) + 8 * wid + ii; const int t = dir ? slen - 1 - il : il; \
      const bf16_t* bp = pj + (size_t)(row0 + t) * 4096 + head * 128 + c2; rq[ii] = *(const unsigned*)bp; rf[ii] = *(const unsigned*)(bp + 1024 * (1 + dir)); } \
    { const int il = 64 * (cc) + (tid >> 3); const int t = dir ? slen - 1 - il : il; rv = *(const u32x4*)(pj + (size_t)(row0 + t) * 4096 + 3072 + head * 128 + vh * 64 + (tid & 7) * 8); } } while (0)
  HG_LOAD(0);
  for (int c = 0; c < nchunks; ++c) {
    int hu = lane >> 5, qu = lane & 31; asm volatile("" : "+v"(hu), "+v"(qu));
    float q0[8], q1[8], k0[8], k1[8], P0[8], P1[8];
    float run0 = 1.f, run1 = 1.f;
#pragma unroll
    for (int ii = 0; ii < 8; ++ii) {
      const float hq0 = bflo(rq[ii]), hq1 = bfhi(rq[ii]), hf0 = bflo(rf[ii]), hf1 = bfhi(rf[ii]);
      const float s0 = sigm(hf0), s1 = sigm(hf1);
      run0 *= lb0 + (1.0f - lb0) * s0; run1 *= lb1 + (1.0f - lb1) * s1;
      P0[ii] = run0; P1[ii] = run1;
      k0[ii] = (1.0f - lb0) * (1.0f - s0); k1[ii] = (1.0f - lb1) * (1.0f - s1);
      q0[ii] = hq0 * sigm(hq0); q1[ii] = hq1 * sigm(hq1);
    }
    { f32v2_t gg = {run0, run1}; *(f32v2_t*)(shm + H_GG + (wid * 128 + c2) * 4) = gg; }
    *(u32x4*)(shm + H_VV + (tid >> 3) * AROW + (tid & 7) * 16) = rv;
    __syncthreads();
    float pre0 = 1.f, pre1 = 1.f, dec0 = 1.f, dec1 = 1.f;
#pragma unroll
    for (int w2 = 0; w2 < 8; ++w2) { const f32v2_t gg = *(const f32v2_t*)(shm + H_GG + (w2 * 128 + c2) * 4); dec0 *= gg[0]; dec1 *= gg[1]; if (w2 < wid) { pre0 *= gg[0]; pre1 *= gg[1]; } }
#pragma unroll
    for (int ii = 0; ii < 8; ++ii) {
      const float Pa = pre0 * P0[ii], Pb = pre1 * P1[ii];
      const float ia = __builtin_amdgcn_rcpf(Pa), ib = __builtin_amdgcn_rcpf(Pb);
      const float kta = k0[ii] * ia, ktb = k1[ii] * ib;
      const int off = (8 * wid + ii) * HP + c2 * 2;
      *(unsigned*)(shm + H_QT + off) = pk2c(q0[ii] * Pa, q1[ii] * Pb);
      *(unsigned*)(shm + H_KT + off) = pk2c(kta, ktb);
      *(unsigned*)(shm + H_KE + off) = pk2c(kta * dec0, ktb * dec1);
    }
    if (wid == 0) { f32v2_t dd = {dec0, dec1}; *(f32v2_t*)(shm + H_DEC + c2 * 4) = dd; }
    __syncthreads();
    if (c + 1 < nchunks) HG_LOAD(c + 1);
    const int i16 = lane & 15, q4 = i16 >> 2, p4 = i16 & 3, blk = (lane >> 4) & 1;
    if (wid < 4) {
      const int tb = wid >> 1, vb = wid & 1;
      f32x16 o;
#pragma unroll
      for (int i = 0; i < 16; ++i) o[i] = 0.f;
#pragma unroll
      for (int ks = 0; ks < 8; ++ks) {
        const pg8::bf16x8 a = *(const pg8::bf16x8*)(shm + H_QT + (32 * tb + qu) * HP + (16 * ks + 8 * hu) * 2);
        const pg8::bf16x8 b = *(const pg8::bf16x8*)(shm + H_ST + (32 * vb + qu) * HP + (16 * ks + 8 * hu) * 2);
        o = MFMA32(a, b, o);
      }
      for (int sb = 0; sb <= tb; ++sb) {
        f32x16 at;
#pragma unroll
        for (int i = 0; i < 16; ++i) at[i] = 0.f;
#pragma unroll
        for (int ks = 0; ks < 8; ++ks) {
          const pg8::bf16x8 a = *(const pg8::bf16x8*)(shm + H_KT + (32 * sb + qu) * HP + (16 * ks + 8 * hu) * 2);
          const pg8::bf16x8 b = *(const pg8::bf16x8*)(shm + H_QT + (32 * tb + qu) * HP + (16 * ks + 8 * hu) * 2);
          at = MFMA32(a, b, at);
        }
        if (sb == tb) {
#pragma unroll
          for (int i = 0; i < 16; ++i) at[i] = crow(i, hu) > qu ? 0.f : at[i];
        }
#pragma unroll
        for (int s2 = 0; s2 < 2; ++s2) {
          u32x4 pw; pw.x = pk2c(at[8 * s2 + 0], at[8 * s2 + 1]); pw.y = pk2c(at[8 * s2 + 2], at[8 * s2 + 3]); pw.z = pk2c(at[8 * s2 + 4], at[8 * s2 + 5]); pw.w = pk2c(at[8 * s2 + 6], at[8 * s2 + 7]);
          const pg8::bf16x8 pa = __builtin_bit_cast(pg8::bf16x8, pw);
          const unsigned a = lbase + H_VV + (32 * sb + 16 * s2 + 4 * hu + q4) * AROW + (32 * vb + 16 * blk) * 2 + 8 * p4;
          s16x4 lo, hi; tr_read2(a, a + 8 * AROW, lo, hi);
          const pg8::bf16x8 vf = __builtin_shufflevector(lo, hi, 0, 1, 2, 3, 4, 5, 6, 7);
          o = MFMA32(pa, vf, o);
        }
      }
#pragma unroll
      for (int i = 0; i < 16; ++i) {
        const int il = 64 * c + 32 * tb + crow(i, hu); const int t = dir ? slen - 1 - il : il;
        od[(size_t)(row0 + t) * D + head * 128 + vh * 64 + 32 * vb + qu] = (bf16_t)(pk2c(o[i], 0.f) & 0xffffu);
      }
    } else {
      const int kb = wid - 4;
#pragma unroll
      for (int i = 0; i < 16; ++i) { const float dv = *(const float*)(shm + H_DEC + (32 * kb + crow(i, hu)) * 4); Sacc[0][i] *= dv; Sacc[1][i] *= dv; }
#pragma unroll
      for (int s = 0; s < 4; ++s) {
        const unsigned aa = lbase + H_KE + (16 * s + 8 * hu + q4) * HP + (32 * kb + 16 * blk) * 2 + 8 * p4;
        const unsigned ab = lbase + H_VV + (16 * s + 8 * hu + q4) * AROW + (16 * blk) * 2 + 8 * p4;
        s16x4 alo, ahi, b0lo, b0hi, b1lo, b1hi;
        tr_read2(aa, aa + 4 * HP, alo, ahi); tr_read2(ab, ab + 4 * AROW, b0lo, b0hi); tr_read2(ab + 64, ab + 4 * AROW + 64, b1lo, b1hi);
        const pg8::bf16x8 af = __builtin_shufflevector(alo, ahi, 0, 1, 2, 3, 4, 5, 6, 7);
        const pg8::bf16x8 bf0 = __builtin_shufflevector(b0lo, b0hi, 0, 1, 2, 3, 4, 5, 6, 7), bf1v = __builtin_shufflevector(b1lo, b1hi, 0, 1, 2, 3, 4, 5, 6, 7);
        Sacc[0] = MFMA32(af, bf0, Sacc[0]); Sacc[1] = MFMA32(af, bf1v, Sacc[1]);
      }
    }
    __syncthreads();
    if (wid >= 4) {
      const int kb = wid - 4;
#pragma unroll
      for (int b = 0; b < 2; ++b)
#pragma unroll
        for (int g4 = 0; g4 < 4; ++g4) {
          u32x2 w; w.x = pk2c(Sacc[b][4 * g4 + 0], Sacc[b][4 * g4 + 1]); w.y = pk2c(Sacc[b][4 * g4 + 2], Sacc[b][4 * g4 + 3]);
          *(u32x2*)(shm + H_ST + (32 * b + qu) * HP + (32 * kb + 8 * g4 + 4 * hu) * 2) = w;
        }
    }
  }
#undef HG_LOAD
}

DI void merge_phase(const Params& p) {
  const int tid = opq_tid(), wid = tid >> 6, lane = tid & 63;
  const int bid = opq_bid(); const int gw = bid * 8 + wid, NGW = gridDim.x * 8;
  const bf16_t* og = (const bf16_t*)(p.ws + OFF_BIG + B_OG); const float* ml = (const float*)(p.ws + OFF_BIG + B_LSE);
  bf16_t* ya = (bf16_t*)(p.ws + OFF_BIG + B_YA);
  const int c0 = lane * 8, j = lane >> 3;
  for (int row = gw; row < T; row += NGW) {
    float mg[3], lg[3];
#pragma unroll
    for (int g = 0; g < 3; ++g) { const f32v2_t v = *(const f32v2_t*)(ml + (((size_t)g * T + row) * 8 + j) * 2); mg[g] = v[0]; lg[g] = v[1]; }
    const float M = fmaxf(mg[0], fmaxf(mg[1], mg[2]));
    float acc[8]; float den = 0.f;
#pragma unroll
    for (int e = 0; e < 8; ++e) acc[e] = 0.f;
#pragma unroll
    for (int g = 0; g < 3; ++g) {
      const float wg = __expf(mg[g] - M); den += wg * lg[g];
      const u32x4 a = *(const u32x4*)(og + ((size_t)g * T + row) * 512 + c0);
#pragma unroll
      for (int e = 0; e < 4; ++e) { acc[2 * e] += wg * bflo(a[e]); acc[2 * e + 1] += wg * bfhi(a[e]); }
    }
    const float inv = __builtin_amdgcn_rcpf(den);
    u32x4 w; w.x = pk2c(acc[0] * inv, acc[1] * inv); w.y = pk2c(acc[2] * inv, acc[3] * inv); w.z = pk2c(acc[4] * inv, acc[5] * inv); w.w = pk2c(acc[6] * inv, acc[7] * inv);
    *(u32x4*)(ya + (size_t)row * 512 + c0) = w;
  }
}

DI void final_phase(const Params& p) {
  const int tid = opq_tid(), wid = tid >> 6, lane = tid & 63;
  const int bid = opq_bid(); const int gw = bid * 8 + wid, NGW = gridDim.x * 8;
  const float* ss3 = (const float*)(p.ws + OFF_SS) + (size_t)3 * T * 16; const float* g = p.in[16];
  f32x4 g4[4];
#pragma unroll
  for (int j = 0; j < 4; ++j) g4[j] = *(const f32x4*)(g + 4 * lane + 256 * j);
  for (int row = gw; row < T; row += NGW) {
    const float rs = rsqrtf(ss16(ss3 + (size_t)row * 16) * (1.0f / 1024.0f) + EPS);
    float* xr = p.out + (size_t)row * D;
#pragma unroll
    for (int j = 0; j < 4; ++j) { f32x4 v = *(const f32x4*)(xr + 4 * lane + 256 * j); v = v * rs * g4[j]; *(f32x4*)(xr + 4 * lane + 256 * j) = v; }
  }
}

enum { PT_GEMM = 0, PT_HGRN = 1, PT_COMBINE = 2, PT_ATTN0 = 3, PT_ATTN1 = 4, PT_FINAL = 5, PT_MERGE = 6 };
constexpr int NPH = 18;
__global__ void __launch_bounds__(512, 2) fwd_megakernel(Params p) {
  extern __shared__ __attribute__((aligned(16))) unsigned char shm[];
  cg::grid_group grid = cg::this_grid();
  prep_phase(p, shm);
  grid.sync();
  for (int ph = 0; ph < NPH; ++ph) {
    const int type = p.ph[ph].type;
    if (type == PT_GEMM) {
      __syncthreads();
      if (threadIdx.x == 0) *(EpiP*)(shm + 131072) = p.ph[ph].e;
      __syncthreads();
      pg8::Gemm g; g.A = p.ph[ph].A; g.Bt = p.ph[ph].Bt; g.M = p.ph[ph].M; g.N = p.ph[ph].N; g.K = p.ph[ph].K;
      Epi E; E.lp = (const PG8_LAS EpiP*)((PG8_LAS unsigned char*)shm + 131072);
      pg8::StaticOrder S; S.init(g.M, g.N, (int)gridDim.x, opq_bid());
      int nrep = 1;
#if defined(REP_PH)
      if (ph == REP_PH) nrep = 2;
#endif
      for (int rr = 0; rr < nrep; ++rr) {
        if (rr) grid.sync();
        pg8::gemm_phase<Epi, pg8::StaticOrder>((PG8_LAS unsigned char*)shm, g, S, E);
      }
    } else if (type == PT_HGRN) { hgrn_phase(p, shm);
#if defined(REP_HGRN)
      grid.sync(); hgrn_phase(p, shm);
#endif
    }
    else if (type == PT_COMBINE) combine_phase(p);
    else if (type == PT_ATTN0) { attn_phase(p, 0, shm);
#if defined(REP_ATTN)
      grid.sync(); attn_phase(p, 0, shm);
#endif
    }
    else if (type == PT_ATTN1) { attn_phase(p, 1, shm);
#if defined(REP_ATTN)
      grid.sync(); attn_phase(p, 1, shm);
#endif
    }
    else if (type == PT_MERGE) merge_phase(p);
    else final_phase(p);
    if (ph < NPH - 1) grid.sync();
  }
}

static void fill_phases(Params& p) {
  unsigned char* ws = p.ws; unsigned char* big = ws + OFF_BIG;
  float* ssb = (float*)(ws + OFF_SS); bf16_t* xb = (bf16_t*)(ws + OFF_XB);
  float* ss0 = ssb; float* ss1 = ssb + (size_t)T * 16; float* ss2 = ssb + (size_t)2 * T * 16; float* ss3 = ssb + (size_t)3 * T * 16;
  const bf16_t* win = (const bf16_t*)(ws + OFF_WIN);
  auto gemm = [&](int i, const bf16_t* A, const bf16_t* Bt, int M, int N, int K) -> EpiP& {
    PhaseDesc& d = p.ph[i]; d.type = PT_GEMM; d.M = M; d.N = N; d.K = K; d.A = A; d.Bt = Bt; d.e.mode = M_BF16S; d.e.ldo = D; d.e.alpha = 1.0f; return d.e; };
  auto other = [&](int i, int type) { p.ph[i].type = type; };
  { EpiP& e = gemm(0, xb, (const bf16_t*)(ws + OFF_WGU1), T, 2 * FF, D); e.mode = M_SWIGLU; e.ss = ss0; e.ob = (bf16_t*)(big + B_ACT); }
  { EpiP& e = gemm(1, (const bf16_t*)(big + B_ACT), (const bf16_t*)(ws + OFF_WD1), T, D, FF); e.mode = M_RESID; e.alpha = 0.5f; e.of = p.out; e.r0 = p.in[0]; e.r1 = p.in[1]; e.ob = xb; e.ss_out = ss1; }
  { EpiP& e = gemm(2, xb, win + (size_t)4608 * D, T, 4096, D); e.ss = ss1; e.ob = (bf16_t*)(big + B_PROJH); e.ldo = 4096; }
  other(3, PT_HGRN);
  { EpiP& e = gemm(4, xb, win + (size_t)8704 * D, T, 1024, D); e.ss = ss1; e.ob = (bf16_t*)(big + B_HG); e.ldo = 1024; }
  other(5, PT_COMBINE);
  for (int half = 0; half < 2; ++half) {
    EpiP& e = gemm(6 + 2 * half, xb + (size_t)half * THALF * D, win, THALF, 4608, D); e.ss = ss1 + (size_t)half * THALF * 16; e.ob = (bf16_t*)(big + B_QKV); e.ldo = 4608;
    other(7 + 2 * half, half ? PT_ATTN1 : PT_ATTN0);
  }
  other(10, PT_MERGE);
  { EpiP& e = gemm(11, xb, win + (size_t)9728 * D, T, 2048, D); e.ss = ss1; e.sig = 1; e.ob = (bf16_t*)(big + B_SGA); e.ldo = 1024; e.split_tiles = 4; e.split_stride = (size_t)T * D; }
  { EpiP& e = gemm(12, (const bf16_t*)(big + B_YA), (const bf16_t*)(ws + OFF_WA), T, D, 512); e.mode = M_MUL; e.sg = (const bf16_t*)(big + B_SGA); e.of = (float*)(big + B_TMP); }
  { EpiP& e = gemm(13, (const bf16_t*)(big + B_YB), (const bf16_t*)(ws + OFF_WB), T, D, D); e.mode = M_FMA; e.sg = (const bf16_t*)(big + B_SGB); e.tmp = (const float*)(big + B_TMP); e.ob = (bf16_t*)(big + B_SGB); }
  { EpiP& e = gemm(14, (const bf16_t*)(big + B_SGB), (const bf16_t*)(ws + OFF_WO), T, D, D); e.mode = M_RESID; e.alpha = 1.0f; e.of = p.out; e.r0 = p.out; e.r1 = p.out + (size_t)TP * D; e.ob = xb; e.ss_out = ss2; }
  { EpiP& e = gemm(15, xb, (const bf16_t*)(ws + OFF_WGU2), T, 2 * FF, D); e.mode = M_SWIGLU; e.ss = ss2; e.ob = (bf16_t*)(big + B_ACT); }
  { EpiP& e = gemm(16, (const bf16_t*)(big + B_ACT), (const bf16_t*)(ws + OFF_WD2), T, D, FF); e.mode = M_RESID; e.alpha = 0.5f; e.of = p.out; e.r0 = p.out; e.r1 = p.out + (size_t)TP * D; e.ob = nullptr; e.ss_out = ss3; }
  other(17, PT_FINAL);
}

extern "C" void kernel_launch(void* const* d_in, const int* in_sizes, int n_in, void* d_out, int out_size, void* d_ws, size_t ws_size, hipStream_t stream) {
  constexpr int kDynLds = 131072 + 256;
  static int grid_blocks = 0;
  if (!grid_blocks) {
    if (n_in != 17 || out_size != T * D || ws_size < WS_NEED) { fprintf(stderr, "kernel_launch: unexpected shapes (n_in %d out %d ws %zu need %zu)\n", n_in, out_size, ws_size, (size_t)WS_NEED); grid_blocks = -1; return; }
    int dev = 0, cus = 0, per_cu = 0;
    (void)hipGetDevice(&dev);
    (void)hipDeviceGetAttribute(&cus, hipDeviceAttributeMultiprocessorCount, dev);
    (void)hipFuncSetAttribute((const void*)fwd_megakernel, hipFuncAttributeMaxDynamicSharedMemorySize, kDynLds);
    (void)hipOccupancyMaxActiveBlocksPerMultiprocessor(&per_cu, (const void*)fwd_megakernel, 512, kDynLds);
    if (per_cu < 1) per_cu = 1;
    grid_blocks = cus * per_cu;
  }
  if (grid_blocks < 0) return;
  static Params p;
  memset(&p, 0, sizeof(p));
  for (int i = 0; i < 17; ++i) p.in[i] = (const float*)d_in[i];
  p.out = (float*)d_out; p.ws = (unsigned char*)d_ws;
  fill_phases(p);
  void* args[] = {&p};
  hipError_t e = hipLaunchCooperativeKernel((const void*)fwd_megakernel, dim3(grid_blocks), dim3(512), args, kDynLds, stream);
  if (e != hipSuccess) fprintf(stderr, "cooperative launch failed: %s (grid %d)\n", hipGetErrorString(e), grid_blocks);
}
```

```cpp
#include <hip/hip_runtime.h>
#include <hip/hip_cooperative_groups.h>
#include <cstdio>
#include <cstdint>
#include <cstring>
namespace cg = cooperative_groups;
__device__ __forceinline__ int opq_tid() { int t = threadIdx.x; asm volatile("" : "+v"(t)); return t; }
__device__ __forceinline__ int opq_bid() { int b = blockIdx.x; asm volatile("" : "+s"(b)); return b; }
namespace pg8 {
#define PG8_LAS __attribute__((address_space(3)))
typedef unsigned short bf16_t;
typedef short bf16x8 __attribute__((ext_vector_type(8)));
typedef float f32x4 __attribute__((ext_vector_type(4)));
typedef unsigned u32x4 __attribute__((ext_vector_type(4)));
constexpr int BM = 256, BK = 64, HALF = 128, HTB = HALF * BK * 2  , STAGE_BYTES = 8 * HTB, NXCD = 8, WGM = 8;

__host__ __device__ __forceinline__ int lds_byte(int r, int c) { const int st = (r >> 4) * 2 + (c >> 5), rr = r & 15, cc = c & 31, ob = rr * 64 + cc * 2; return st * 1024 + (ob ^ (((ob >> 9) & 1) << 5)); }
__host__ __device__ __forceinline__ void stage_rc(int b, int& R, int& C) { const int st = b / 1024, sb = b % 1024, swz = sb ^ (((sb >> 9) & 1) << 5); R = (st >> 1) * 16 + swz / 64; C = (st & 1) * 32 + (swz % 64) / 2; }
__host__ __device__ __forceinline__ int perm32(int rho) { const int n = rho >> 4, i = rho & 15; return 8 * (i >> 2) + 4 * n + (i & 3); }

struct Unit { int pm, pn; };
struct Gemm { const bf16_t* A; const bf16_t* Bt; int M, N, K; };

struct StaticOrder {
    int nM, nN, nwg, G, c;
    __host__ __device__ void init(int M, int N, int G_, int c_) { nM = M / BM; nN = N / BM; nwg = nM * nN; G = G_; c = c_; }
    __host__ __device__ bool next(int i, Unit& u) const {
        const long L = (long)i * G + c; if (L >= nwg) return false;
        int wgid = (int)L; { const int q = nwg / NXCD, r = nwg % NXCD, xcd = wgid % NXCD, off = wgid / NXCD; wgid = (xcd < r ? xcd * (q + 1) : r * (q + 1) + (xcd - r) * q) + off; }
        const int nig = WGM * nN, gid = wgid / nig, fm = gid * WGM, gsz = (nM - fm) < WGM ? (nM - fm) : WGM;
        u.pm = fm + ((wgid % nig) % gsz); u.pn = (wgid % nig) / gsz; return true;
    }
    __device__ __forceinline__ void a_ready(const Unit&) const {}
    __device__ __forceinline__ void done(const Unit&) const {}
};
template <class Epi, class Sched>
__device__ __forceinline__ void gemm_phase(PG8_LAS unsigned char* lds, const Gemm g, const Sched& S, const Epi& E) {
    const int tid = opq_tid(), wid = __builtin_amdgcn_readfirstlane(tid >> 6), lane = tid & 63, wr = wid >> 2, wc = wid & 3, fr = lane & 15, fq = lane >> 4;
    const int K = g.K, nt = K / BK;
    unsigned voffA[2], voffB[2];
#pragma unroll
    for (int i = 0; i < 2; ++i) { int R, C; stage_rc(tid * 16 + i * 8192, R, C); const int Rb = Epi::PERM ? ((R & ~31) + perm32(R & 31)) : R;
        voffA[i] = (unsigned)(R * K + C) * 2u; voffB[i] = (unsigned)(Rb * K + C) * 2u; }
    const size_t kstep = (size_t)(BK * 2);
    const size_t hstep = (size_t)HALF * K * 2;
    const size_t tstep = 2 * hstep;
    const unsigned ldsw = (unsigned)wid * 1024u;
    const int aoff = lds_byte(wr * 64 + fr, fq * 8), boff = lds_byte(wc * 32 + fr, fq * 8);
#define PG8_SA(b, h) (((b) * 2 + (h)) * HTB)
#define PG8_SB(b, h) ((4 + (b) * 2 + (h)) * HTB)
#define PG8_STAGE(bufoff, gbase, voff) do { _Pragma("unroll") for (int _i = 0; _i < 2; ++_i) \
        __builtin_amdgcn_global_load_lds((const unsigned*)((const char*)(gbase) + (voff)[_i]), (PG8_LAS unsigned*)(lds + (bufoff) + ldsw + _i * 8192), 16, 0, 0); } while (0)
#define PG8_LDA(dst, b, h) do { _Pragma("unroll") for (int m = 0; m < 4; ++m) _Pragma("unroll") for (int k = 0; k < 2; ++k) dst[m][k] = *(const PG8_LAS bf16x8*)(lds + PG8_SA(b, h) + aoff + m * 2048 + k * 1024); } while (0)
#define PG8_LDB(dst, b, h) do { _Pragma("unroll") for (int n = 0; n < 2; ++n) _Pragma("unroll") for (int k = 0; k < 2; ++k) dst[n][k] = *(const PG8_LAS bf16x8*)(lds + PG8_SB(b, h) + boff + n * 2048 + k * 1024); } while (0)
#define PG8_MMA(ai, bj, At, Bt) do { __builtin_amdgcn_s_setprio(1); _Pragma("unroll") for (int m = 0; m < 4; ++m) _Pragma("unroll") for (int n = 0; n < 2; ++n) _Pragma("unroll") for (int k = 0; k < 2; ++k) \
        acc[ai][bj][m][n] = __builtin_amdgcn_mfma_f32_16x16x32_bf16(Bt[n][k], At[m][k], acc[ai][bj][m][n], 0, 0, 0); __builtin_amdgcn_s_setprio(0); } while (0)
#define PG8_WAIT_V(n) asm volatile("s_waitcnt vmcnt(" #n ")" ::: "memory")
#define PG8_WAIT_L(n) asm volatile("s_waitcnt lgkmcnt(" #n ")" ::: "memory")
#define PG8_BAR __builtin_amdgcn_s_barrier()
#define PG8_SCHED __builtin_amdgcn_sched_barrier(0)
    Unit cur, nxt; int ui = 0;
    if (!S.next(0, cur)) return;
    f32x4 acc[2][2][4][2];
#pragma unroll
    for (int a = 0; a < 2; ++a)
#pragma unroll
        for (int b = 0; b < 2; ++b)
#pragma unroll
            for (int m = 0; m < 4; ++m)
#pragma unroll
                for (int n = 0; n < 2; ++n) acc[a][b][m][n] = (f32x4){0.f, 0.f, 0.f, 0.f};
    bf16x8 At[4][2], B0[2][2], B1[2][2];
    const char* cA = (const char*)g.A + (size_t)cur.pm * tstep; const char* cB = (const char*)g.Bt + (size_t)cur.pn * tstep;
    S.a_ready(cur);
    PG8_STAGE(PG8_SB(0, 0), cB, voffB); PG8_STAGE(PG8_SA(0, 0), cA, voffA); PG8_STAGE(PG8_SB(0, 1), cB + hstep, voffB); PG8_STAGE(PG8_SA(0, 1), cA + hstep, voffA);
    if (wr == 1) PG8_BAR;
    PG8_WAIT_V(4); PG8_BAR;
    PG8_STAGE(PG8_SB(1, 0), cB + kstep, voffB); PG8_STAGE(PG8_SA(1, 0), cA + kstep, voffA); PG8_STAGE(PG8_SB(1, 1), cB + hstep + kstep, voffB);
    PG8_WAIT_V(6); PG8_BAR;
    for (;;) {
        const bool has_next = S.next(ui + 1, nxt);
        const char* nA = has_next ? (const char*)g.A + (size_t)nxt.pm * tstep : cA; const char* nB = has_next ? (const char*)g.Bt + (size_t)nxt.pn * tstep : cB;
        for (int t = 0; t < nt; t += 2) {
            const bool last = (t == nt - 2);
            const char* a1 = cA + (size_t)(t + 1) * kstep;
            const char* a2 = last ? nA : cA + (size_t)(t + 2) * kstep; const char* b2 = last ? nB : cB + (size_t)(t + 2) * kstep;
            const char* a3 = a2 + kstep; const char* b3 = b2 + kstep;
            if (last && has_next) S.a_ready(nxt);
            PG8_LDB(B0, 0, 0); PG8_SCHED; PG8_LDA(At, 0, 0); PG8_STAGE(PG8_SA(1, 1), a1 + hstep, voffA);
            PG8_WAIT_L(8); PG8_BAR; PG8_WAIT_L(0); PG8_MMA(0, 0, At, B0); PG8_BAR; PG8_SCHED;
            PG8_LDB(B1, 0, 1); PG8_STAGE(PG8_SB(0, 0), b2, voffB);
            PG8_BAR; PG8_WAIT_L(0); PG8_MMA(0, 1, At, B1); PG8_BAR;
            PG8_LDA(At, 0, 1); PG8_STAGE(PG8_SA(0, 0), a2, voffA);
            PG8_BAR; PG8_WAIT_L(0); PG8_MMA(1, 0, At, B0); PG8_BAR; PG8_SCHED;
            PG8_STAGE(PG8_SB(0, 1), b2 + hstep, voffB);
            PG8_WAIT_V(6); PG8_BAR; PG8_MMA(1, 1, At, B1); PG8_BAR;
            PG8_LDB(B0, 1, 0); PG8_SCHED; PG8_LDA(At, 1, 0); PG8_STAGE(PG8_SA(0, 1), a2 + hstep, voffA);
            PG8_WAIT_L(8); PG8_BAR; PG8_WAIT_L(0); PG8_MMA(0, 0, At, B0); PG8_BAR; PG8_SCHED;
            PG8_LDB(B1, 1, 1); PG8_STAGE(PG8_SB(1, 0), b3, voffB);
            PG8_BAR; PG8_WAIT_L(0); PG8_MMA(0, 1, At, B1); PG8_BAR;
            PG8_LDA(At, 1, 1); PG8_STAGE(PG8_SA(1, 0), a3, voffA);
            PG8_BAR; PG8_WAIT_L(0); PG8_MMA(1, 0, At, B0); PG8_BAR; PG8_SCHED;
            PG8_STAGE(PG8_SB(1, 1), b3 + hstep, voffB);
            PG8_WAIT_V(6); PG8_BAR; PG8_MMA(1, 1, At, B1); PG8_BAR;
        }
        if constexpr (!Epi::AFTER_DRAIN) { E(acc, cur, wr, wc, fr, fq); S.done(cur); }
        if (!has_next) break;
#pragma unroll
        for (int a = 0; a < 2; ++a)
#pragma unroll
            for (int b = 0; b < 2; ++b)
#pragma unroll
                for (int m = 0; m < 4; ++m)
#pragma unroll
                    for (int n = 0; n < 2; ++n) acc[a][b][m][n] = (f32x4){0.f, 0.f, 0.f, 0.f};
        cur = nxt; cA = nA; cB = nB; ++ui;
    }
    PG8_WAIT_V(0);
    if (wr == 0) PG8_BAR;
    PG8_BAR;
    if constexpr (Epi::AFTER_DRAIN) { E.fused(acc, cur, wr, wc, fr, fq, lds, wid, lane); S.done(cur); }
#undef PG8_SA
#undef PG8_SB
#undef PG8_STAGE
#undef PG8_LDA
#undef PG8_LDB
#undef PG8_MMA
#undef PG8_WAIT_V
#undef PG8_WAIT_L
#undef PG8_BAR
#undef PG8_SCHED
}
}

using pg8::f32x4; using pg8::bf16_t; using pg8::u32x4;
typedef unsigned u32x2 __attribute__((ext_vector_type(2)));
#define DI __device__ __forceinline__

constexpr int T = 49152, TP = 16384, D = 1024, FF = 2816, NIN = 11776, THALF = 24576;
constexpr float EPS = 1e-6f;

DI unsigned pk2(float lo, float hi) { unsigned r; asm volatile("v_cvt_pk_bf16_f32 %0, %1, %2" : "=v"(r) : "v"(lo), "v"(hi)); return r; }
DI float bflo(unsigned u) { return __uint_as_float(u << 16); }
DI float bfhi(unsigned u) { return __uint_as_float(u & 0xffff0000u); }
DI float bf1(bf16_t b) { return __uint_as_float(((unsigned)b) << 16); }
DI float sigm(float x) { return __builtin_amdgcn_rcpf(1.0f + __expf(-x)); }
DI float wave_sum(float v) {
#pragma unroll
  for (int o = 1; o < 64; o <<= 1) v += __shfl_xor(v, o);
  return v;
}
DI float wave_max(float v) {
#pragma unroll
  for (int o = 1; o < 64; o <<= 1) v = fmaxf(v, __shfl_xor(v, o));
  return v;
}

DI float ss16(const float* p) { const f32x4 a = *(const f32x4*)p, b = *(const f32x4*)(p + 4), c = *(const f32x4*)(p + 8), d = *(const f32x4*)(p + 12);
  return ((a[0] + a[1]) + (a[2] + a[3])) + ((b[0] + b[1]) + (b[2] + b[3])) + ((c[0] + c[1]) + (c[2] + c[3])) + ((d[0] + d[1]) + (d[2] + d[3])); }
enum { M_SWIGLU = 0, M_BF16S = 1, M_RESID = 2, M_MUL = 3, M_FMA = 4 };

struct EpiP {
  int mode, sig, split_tiles, ldo;
  const float* ss; bf16_t* ob; size_t split_stride;
  float* of; const float* r0; const float* r1; float alpha; int silu_tiles; float* ss_out;
  const bf16_t* sg; const float* tmp;
};
struct Epi {
  static constexpr bool PERM = false, AFTER_DRAIN = false;
  const PG8_LAS EpiP* lp;
  __device__ __forceinline__ void operator()(const f32x4 (&acc)[2][2][4][2], const pg8::Unit& u, int wr, int wc, int fr, int fq) const {
    const int mode = lp->mode, sig = lp->sig, split_tiles = lp->split_tiles, ldo = lp->ldo, silu_tiles = lp->silu_tiles;
    const float* ss = lp->ss; bf16_t* ob = lp->ob; const size_t split_stride = lp->split_stride;
    float* of = lp->of; const float* r0 = lp->r0; const float* r1 = lp->r1; const float alpha = lp->alpha; float* ss_out = lp->ss_out;
    const bf16_t* sg = lp->sg; const float* tmp = lp->tmp;
    const int rowb = u.pm * 256 + wr * 64 + fr;
    if (mode == M_SWIGLU) {
#pragma unroll
      for (int ai = 0; ai < 2; ++ai)
#pragma unroll
        for (int m = 0; m < 4; ++m) {
          const int row = rowb + ai * 128 + m * 16;
          const float rs = rsqrtf(ss16(ss + (size_t)row * 16) * (1.0f / 1024.0f) + EPS);
          float h[8];
#pragma unroll
          for (int n = 0; n < 2; ++n)
#pragma unroll
            for (int j = 0; j < 4; ++j) { const float a = acc[ai][0][m][n][j] * rs, b = acc[ai][1][m][n][j] * rs; h[n * 4 + j] = a * sigm(a) * b; }
          u32x4 w; w.x = pk2(h[0], h[1]); w.y = pk2(h[2], h[3]); w.z = pk2(h[4], h[5]); w.w = pk2(h[6], h[7]);
          *(u32x4*)(ob + (size_t)row * FF + u.pn * 128 + wc * 32 + fq * 8) = w;
        }
    } else if (mode == M_BF16S) {
      int pn = u.pn; bf16_t* base = ob;
      if (split_tiles) { const int t = pn / split_tiles; base += (size_t)t * split_stride; pn -= t * split_tiles; }
#pragma unroll
      for (int ai = 0; ai < 2; ++ai)
#pragma unroll
        for (int m = 0; m < 4; ++m) {
          const int row = rowb + ai * 128 + m * 16;
          const float rs = rsqrtf(ss16(ss + (size_t)row * 16) * (1.0f / 1024.0f) + EPS);
#pragma unroll
          for (int bj = 0; bj < 2; ++bj) {
            float v[8];
#pragma unroll
            for (int n = 0; n < 2; ++n)
#pragma unroll
              for (int j = 0; j < 4; ++j) { float x = acc[ai][bj][m][n][j] * rs; if (sig) x = sigm(x); else if (u.pn < silu_tiles) x = x * sigm(x); v[n * 4 + j] = x; }
            u32x4 w; w.x = pk2(v[0], v[1]); w.y = pk2(v[2], v[3]); w.z = pk2(v[4], v[5]); w.w = pk2(v[6], v[7]);
            *(u32x4*)(base + (size_t)row * ldo + pn * 256 + bj * 128 + wc * 32 + fq * 8) = w;
          }
        }
    } else if (mode == M_RESID) {
#pragma unroll
      for (int ai = 0; ai < 2; ++ai)
#pragma unroll
        for (int m = 0; m < 4; ++m) {
          const int row = rowb + ai * 128 + m * 16;
          const float* rp = row < TP ? r0 + (size_t)row * D : r1 + (size_t)(row - TP) * D;
          float s2 = 0.f;
#pragma unroll
          for (int bj = 0; bj < 2; ++bj)
#pragma unroll
            for (int n = 0; n < 2; ++n) {
              const int c0 = u.pn * 256 + bj * 128 + wc * 32 + n * 16 + fq * 4;
              const f32x4 r = *(const f32x4*)(rp + c0);
              const f32x4 o = r + alpha * acc[ai][bj][m][n];
              *(f32x4*)(of + (size_t)row * D + c0) = o;
              if (ob) { u32x2 w; w.x = pk2(o[0], o[1]); w.y = pk2(o[2], o[3]); *(u32x2*)(ob + (size_t)row * D + c0) = w; }
              s2 += (o[0] * o[0] + o[1] * o[1]) + (o[2] * o[2] + o[3] * o[3]);
            }
          s2 += __shfl_xor(s2, 16); s2 += __shfl_xor(s2, 32);
          if (fq == 0) ss_out[(size_t)row * 16 + u.pn * 4 + wc] = s2;
        }
    } else {
#pragma unroll
      for (int ai = 0; ai < 2; ++ai)
#pragma unroll
        for (int m = 0; m < 4; ++m) {
          const int row = rowb + ai * 128 + m * 16;
#pragma unroll
          for (int bj = 0; bj < 2; ++bj)
#pragma unroll
            for (int n = 0; n < 2; ++n) {
              const int c0 = u.pn * 256 + bj * 128 + wc * 32 + n * 16 + fq * 4;
              const u32x2 g2 = *(const u32x2*)(sg + (size_t)row * D + c0);
              f32x4 gv; gv[0] = bflo(g2.x); gv[1] = bfhi(g2.x); gv[2] = bflo(g2.y); gv[3] = bfhi(g2.y);
              if (mode == M_MUL) {
                *(f32x4*)(of + (size_t)row * D + c0) = gv * acc[ai][bj][m][n];
              } else {
                const f32x4 t4 = *(const f32x4*)(tmp + (size_t)row * D + c0);
                const f32x4 o = t4 + gv * acc[ai][bj][m][n];
                u32x2 w; w.x = pk2(o[0], o[1]); w.y = pk2(o[2], o[3]); *(u32x2*)(ob + (size_t)row * D + c0) = w;
              }
            }
        }
    }
  }
};

constexpr size_t SZ_WGU = (size_t)2 * FF * D * 2, SZ_WD = (size_t)D * FF * 2, SZ_WIN = (size_t)NIN * D * 2;
constexpr size_t OFF_WGU1 = 0, OFF_WD1 = OFF_WGU1 + SZ_WGU, OFF_WGU2 = OFF_WD1 + SZ_WD, OFF_WD2 = OFF_WGU2 + SZ_WGU, OFF_WIN = OFF_WD2 + SZ_WD;
constexpr size_t OFF_WA = OFF_WIN + SZ_WIN, OFF_WB = OFF_WA + (size_t)D * 512 * 2, OFF_WO = OFF_WB + (size_t)D * D * 2, OFF_XB = OFF_WO + (size_t)D * D * 2;
constexpr size_t OFF_SS = OFF_XB + (size_t)T * D * 2, OFF_CTR = OFF_SS + (size_t)4 * T * 16 * 4, OFF_BAR = OFF_CTR + 256, OFF_BIG = OFF_BAR + (size_t)3456 * 4;
constexpr size_t B_ACT = 0, B_PROJH = 0, B_OFB = (size_t)T * 4096 * 2, B_HG = 0, B_YB = (size_t)T * D * 2, B_QKV = B_YB + (size_t)T * D * 2;
constexpr size_t B_OG = B_QKV + (size_t)THALF * 4608 * 2, B_LSE = B_OG + (size_t)3 * T * 512 * 2, B_YA = 0, B_SGA = B_QKV, B_SGB = B_SGA + (size_t)T * D * 2, B_TMP = B_SGB + (size_t)T * D * 2;
constexpr size_t WS_NEED = OFF_BIG + B_TMP + (size_t)T * D * 4;

struct PhaseDesc { int type, M, N, K; const bf16_t* A; const bf16_t* Bt; EpiP e; };
struct Params {
  const float* in[17];
  float* out; unsigned char* ws;
  PhaseDesc ph[18];
};

enum { MAP_NAT = 0, MAP_P32 = 1, MAP_GU = 2 };
DI int srccol(int map, int np) {
  if (map == MAP_NAT) return np;
  if (map == MAP_P32) return (np & ~31) + pg8::perm32(np & 31);
  const int pn = np >> 8, w = np & 255, bj = w >> 7, wc = (w & 127) >> 5, n = (w & 31) >> 4, fq = (w & 15) >> 2, j = w & 3;
  return bj * FF + 128 * pn + 32 * wc + 8 * fq + 4 * n + j;
}
DI void transpose_item(const float* W, int K, int Nsrc, const float* gain, bf16_t* WT, int map, float* scr, int item, int nblk, int lane) {
  const int kb = item / nblk, nb = item % nblk, k0 = 64 * kb, n0 = 32 * nb;
  const int sc = srccol(map, n0 + (lane & 31));
#pragma unroll 8
  for (int i = 0; i < 32; ++i) { const int kk = 2 * i + (lane >> 5); scr[kk * 33 + (lane & 31)] = W[(size_t)(k0 + kk) * Nsrc + sc]; }
  asm volatile("s_waitcnt lgkmcnt(0)" ::: "memory");
  const int c = lane & 7;
  float g8[8];
#pragma unroll
  for (int e = 0; e < 8; ++e) g8[e] = gain ? gain[k0 + 8 * c + e] : 1.0f;
#pragma unroll
  for (int j = 0; j < 4; ++j) {
    const int n = (lane >> 3) + 8 * j; const float* s = scr + (8 * c) * 33 + n;
    u32x4 o; o.x = pk2(s[0 * 33] * g8[0], s[1 * 33] * g8[1]); o.y = pk2(s[2 * 33] * g8[2], s[3 * 33] * g8[3]);
    o.z = pk2(s[4 * 33] * g8[4], s[5 * 33] * g8[5]); o.w = pk2(s[6 * 33] * g8[6], s[7 * 33] * g8[7]);
    *(u32x4*)(WT + (size_t)(n0 + n) * K + k0 + 8 * c) = o;
  }
  asm volatile("s_waitcnt lgkmcnt(0)" ::: "memory");
}

DI void prep_phase(const Params& p, unsigned char* shm) {
  const int tid = opq_tid(), wid = tid >> 6, lane = tid & 63;
  const int bid = opq_bid(); const int gw = bid * 8 + wid, NGW = gridDim.x * 8;
  unsigned char* ws = p.ws;
  { float* ss0 = (float*)(ws + OFF_SS); bf16_t* xb = (bf16_t*)(ws + OFF_XB);
    for (int row = gw; row < T; row += NGW) {
      const float* xr = row < TP ? p.in[0] + (size_t)row * D : p.in[1] + (size_t)(row - TP) * D;
      f32x4 v[4]; float s = 0.f;
#pragma unroll
      for (int j = 0; j < 4; ++j) { v[j] = *(const f32x4*)(xr + 4 * lane + 256 * j); s += (v[j][0] * v[j][0] + v[j][1] * v[j][1]) + (v[j][2] * v[j][2] + v[j][3] * v[j][3]); }
      s = wave_sum(s);
      if (lane < 16) ss0[(size_t)row * 16 + lane] = lane == 0 ? s : 0.f;
#pragma unroll
      for (int j = 0; j < 4; ++j) { u32x2 w; w.x = pk2(v[j][0], v[j][1]); w.y = pk2(v[j][2], v[j][3]); *(u32x2*)(xb + (size_t)row * D + 4 * lane + 256 * j) = w; }
    } }
  float* scr = (float*)(shm + wid * 8704);
  for (int wsel = 0; wsel < 8; ++wsel) {
    const float* W; const float* gain = nullptr; bf16_t* WT; int K, Nsrc, Nd, map;
    switch (wsel) {
      case 0: W = p.in[3]; gain = p.in[2]; WT = (bf16_t*)(ws + OFF_WGU1); K = D; Nsrc = 2 * FF; Nd = 2 * FF; map = MAP_GU; break;
      case 1: W = p.in[4]; WT = (bf16_t*)(ws + OFF_WD1); K = FF; Nsrc = D; Nd = D; map = MAP_NAT; break;
      case 2: W = p.in[6]; gain = p.in[5]; WT = (bf16_t*)(ws + OFF_WIN); K = D; Nsrc = NIN; Nd = NIN; map = MAP_P32; break;
      case 3: W = p.in[10]; WT = (bf16_t*)(ws + OFF_WA); K = 512; Nsrc = D; Nd = D; map = MAP_NAT; break;
      case 4: W = p.in[11]; WT = (bf16_t*)(ws + OFF_WB); K = D; Nsrc = D; Nd = D; map = MAP_NAT; break;
      case 5: W = p.in[12]; WT = (bf16_t*)(ws + OFF_WO); K = D; Nsrc = D; Nd = D; map = MAP_NAT; break;
      case 6: W = p.in[14]; gain = p.in[13]; WT = (bf16_t*)(ws + OFF_WGU2); K = D; Nsrc = 2 * FF; Nd = 2 * FF; map = MAP_GU; break;
      default: W = p.in[15]; WT = (bf16_t*)(ws + OFF_WD2); K = FF; Nsrc = D; Nd = D; map = MAP_NAT; break;
    }
    const int nblk = Nd / 32, nitems = (K / 64) * nblk;
    for (int it = gw; it < nitems; it += NGW) transpose_item(W, K, Nsrc, gain, WT, map, scr, it, nblk, lane);
  }
}

DI void hgrn_naive_phase(const Params& p, unsigned char* shm) {
  const int chain = opq_bid();
  if (chain >= 128) return;
  const int tid = opq_tid(), wid = tid >> 6, lane = tid & 63;
  const int seq = chain >> 4, head = (chain >> 1) & 7, dir = chain & 1;
  const int slen = seq < 4 ? 4096 : 8192, row0 = seq < 4 ? seq * 4096 : TP + (seq - 4) * 8192;
  const bf16_t* pj = (const bf16_t*)(p.ws + OFF_BIG + B_PROJH);
  bf16_t* od = (bf16_t*)(p.ws + OFF_BIG + B_OFB) + (size_t)dir * T * D;
  const float* lbw = dir ? p.in[8] : p.in[7];
  float* gq = (float*)shm; float* gf = gq + 2048; float* gk = gf + 2048; float* gv = gk + 2048;
  const int vl = lane & 15, kq = lane >> 4, v = 16 * wid + vl;
  float S[32];
#pragma unroll
  for (int i = 0; i < 32; ++i) S[i] = 0.f;
  const int fk = tid & 127;
  const float lb = 1.0f / (1.0f + __expf(lbw[D + head * 128 + fk] - lbw[head * 128 + fk]));
  for (int i0 = 0; i0 < slen; i0 += 16) {
    __syncthreads();
#pragma unroll
    for (int r = 0; r < 4; ++r) {
      const int tt = (tid >> 7) + 4 * r; const int t = dir ? slen - 1 - (i0 + tt) : i0 + tt; const size_t rb = (size_t)(row0 + t) * 4096 + head * 128 + fk;
      const float hq = bf1(pj[rb]), hf = bf1(pj[rb + 1024 * (1 + dir)]), hi = bf1(pj[rb + 3072]);
      const float s = sigm(hf);
      gq[tt * 128 + fk] = hq * sigm(hq); gf[tt * 128 + fk] = lb + (1.0f - lb) * s; gk[tt * 128 + fk] = (1.0f - lb) * (1.0f - s); gv[tt * 128 + fk] = hi;
    }
    __syncthreads();
    for (int tt = 0; tt < 16; ++tt) {
      const float val = gv[tt * 128 + v]; float o = 0.f;
#pragma unroll
      for (int k4 = 0; k4 < 8; ++k4) {
        const f32x4 f4 = *(const f32x4*)(gf + tt * 128 + 32 * kq + 4 * k4), k4v = *(const f32x4*)(gk + tt * 128 + 32 * kq + 4 * k4), q4 = *(const f32x4*)(gq + tt * 128 + 32 * kq + 4 * k4);
#pragma unroll
        for (int e = 0; e < 4; ++e) { S[4 * k4 + e] = f4[e] * S[4 * k4 + e] + k4v[e] * val; o += q4[e] * S[4 * k4 + e]; }
      }
      o += __shfl_xor(o, 16); o += __shfl_xor(o, 32);
      const int t = dir ? slen - 1 - (i0 + tt) : i0 + tt;
      if (kq == 0) od[(size_t)(row0 + t) * D + head * 128 + v] = (bf16_t)(pk2(o, 0.f) & 0xffffu);
    }
  }
}

DI void combine_phase(const Params& p) {
  const int tid = opq_tid(), wid = tid >> 6, lane = tid & 63;
  const int bid = opq_bid(); const int gw = bid * 8 + wid, NGW = gridDim.x * 8;
  const bf16_t* oF = (const bf16_t*)(p.ws + OFF_BIG + B_OFB); const bf16_t* oB = oF + (size_t)T * D;
  const bf16_t* hg = (const bf16_t*)(p.ws + OFF_BIG + B_HG); bf16_t* yb = (bf16_t*)(p.ws + OFF_BIG + B_YB);
  const float* ng = p.in[9];
  const int c0 = lane * 16;
  float g[16];
#pragma unroll
  for (int i = 0; i < 16; ++i) g[i] = ng[c0 + i];
  for (int row = gw; row < T; row += NGW) {
    const size_t b = (size_t)row * D + c0;
    float o[16]; float s = 0.f;
#pragma unroll
    for (int h = 0; h < 2; ++h) {
      const u32x4 a = *(const u32x4*)(oF + b + 8 * h), c = *(const u32x4*)(oB + b + 8 * h);
#pragma unroll
      for (int e = 0; e < 4; ++e) { o[8 * h + 2 * e] = bflo(a[e]) + bflo(c[e]); o[8 * h + 2 * e + 1] = bfhi(a[e]) + bfhi(c[e]); }
    }
#pragma unroll
    for (int i = 0; i < 16; ++i) s += o[i] * o[i];
    s += __shfl_xor(s, 1); s += __shfl_xor(s, 2); s += __shfl_xor(s, 4);
    const float rs = rsqrtf(s * (1.0f / 128.0f) + EPS);
#pragma unroll
    for (int h = 0; h < 2; ++h) {
      const u32x4 gg = *(const u32x4*)(hg + b + 8 * h); u32x4 w;
#pragma unroll
      for (int e = 0; e < 4; ++e) {
        const float g0 = bflo(gg[e]), g1 = bfhi(gg[e]);
        w[e] = pk2(o[8 * h + 2 * e] * rs * g[8 * h + 2 * e] * g0 * sigm(g0), o[8 * h + 2 * e + 1] * rs * g[8 * h + 2 * e + 1] * g1 * sigm(g1));
      }
      *(u32x4*)(yb + b + 8 * h) = w;
    }
  }
}

DI void attn_naive_phase(const Params& p, int half) {
  const int tid = opq_tid(), wid = tid >> 6, lane = tid & 63;
  const int bid = opq_bid(); const int gw = bid * 8 + wid, NGW = gridDim.x * 8;
  const int row_base = half * THALF;
  const bf16_t* base = (const bf16_t*)(p.ws + OFF_BIG + B_QKV) - (size_t)row_base * 4608;
  bf16_t* ya = (bf16_t*)(p.ws + OFF_BIG + B_YA);
  for (int unit = gw; unit < THALF * 8; unit += NGW) {
    const int row = row_base + (unit >> 3), j = unit & 7;
    int s0, slen; if (row < TP) { s0 = row & ~4095; slen = 4096; } else { s0 = TP + ((row - TP) & ~8191); slen = 8192; }
    const int t = row - s0;
    const float slope = exp2f(-(float)(j + 1));
    float sc[3][3];
#pragma unroll
    for (int g = 0; g < 3; ++g) {
      const int d = g == 0 ? 1 : (g == 1 ? 4 : 16);
      u32x4 qv[8];
      { const u32x4* qp = (const u32x4*)(base + (size_t)row * 4608 + g * 512 + j * 64);
#pragma unroll
        for (int i = 0; i < 8; ++i) qv[i] = qp[i]; }
#pragma unroll
      for (int r = 0; r < 3; ++r) {
        const int joff = lane + 64 * r - 64; const int pos = t + d * joff;
        const bool valid = (r < 2 || lane == 0) && pos >= 0 && pos < slen;
        float s = -1e30f;
        if (valid) {
          const u32x4* kp = (const u32x4*)(base + (size_t)(s0 + pos) * 4608 + 1536 + g * 512 + j * 64);
          float dot = 0.f;
#pragma unroll
          for (int i = 0; i < 8; ++i) { const u32x4 kv = kp[i];
#pragma unroll
            for (int e = 0; e < 4; ++e) dot += bflo(kv[e]) * bflo(qv[i][e]) + bfhi(kv[e]) * bfhi(qv[i][e]); }
          s = dot * 0.125f - slope * (float)(d * (joff < 0 ? -joff : joff));
        }
        sc[g][r] = s;
      }
    }
    float m = -1e30f;
#pragma unroll
    for (int g = 0; g < 3; ++g)
#pragma unroll
      for (int r = 0; r < 3; ++r) m = fmaxf(m, sc[g][r]);
    m = wave_max(m);
    float l = 0.f;
#pragma unroll
    for (int g = 0; g < 3; ++g)
#pragma unroll
      for (int r = 0; r < 3; ++r) { sc[g][r] = sc[g][r] > -1e29f ? __expf(sc[g][r] - m) : 0.f; l += sc[g][r]; }
    l = wave_sum(l);
    float o = 0.f;
#pragma unroll
    for (int g = 0; g < 3; ++g) {
      const int d = g == 0 ? 1 : (g == 1 ? 4 : 16);
      const bf16_t* vb = base + 3072 + g * 512 + j * 64 + lane;
#pragma unroll
      for (int r = 0; r < 3; ++r) {
        const int ntl = r < 2 ? 64 : 1;
        for (int tl = 0; tl < ntl; ++tl) {
          const float pb = __uint_as_float(__builtin_amdgcn_readlane(__float_as_uint(sc[g][r]), tl));
          if (pb != 0.f) { const int pos = t + d * (tl + 64 * r - 64); o += pb * bf1(vb[(size_t)(s0 + pos) * 4608]); }
        }
      }
    }
    ya[(size_t)row * 512 + j * 64 + lane] = (bf16_t)(pk2(o / l, 0.f) & 0xffffu);
  }
}


typedef float f32x16 __attribute__((ext_vector_type(16)));
typedef short s16x4 __attribute__((ext_vector_type(4)));
typedef __bf16 bf16v2_t __attribute__((ext_vector_type(2)));
typedef float f32v2_t __attribute__((ext_vector_type(2)));
DI unsigned pk2c(float a, float b) { f32v2_t v = {a, b}; bf16v2_t r = __builtin_convertvector(v, bf16v2_t); return __builtin_bit_cast(unsigned, r); }
#define MFMA32(a, b, c) __builtin_amdgcn_mfma_f32_32x32x16_bf16((a), (b), (c), 0, 0, 0)
DI int crow(int i, int h) { return (i & 3) + 8 * (i >> 2) + 4 * h; }
DI void tr_read4(unsigned a0, unsigned a1, unsigned a2, unsigned a3, s16x4& r0, s16x4& r1, s16x4& r2, s16x4& r3) {
  asm volatile("ds_read_b64_tr_b16 %0, %4\n\tds_read_b64_tr_b16 %1, %5\n\tds_read_b64_tr_b16 %2, %6\n\tds_read_b64_tr_b16 %3, %7\n\ts_waitcnt lgkmcnt(0)"
               : "=&v"(r0), "=&v"(r1), "=&v"(r2), "=&v"(r3) : "v"(a0), "v"(a1), "v"(a2), "v"(a3) : "memory");
}
constexpr int AROW = 144;
constexpr int AV_OFF = 384 * AROW;

struct AUnit { int g, j, d, r, c, L, lrow0, ki0; size_t colq; };
DI AUnit attn_decode(int unit, int half) {
  AUnit a; a.g = unit / 768; const int rem = unit % 768; a.j = rem & 7; const int cidx = rem >> 3;
  a.d = a.g == 0 ? 1 : (a.g == 1 ? 4 : 16);
  int seq_row0, S, w;
  if (half == 0) { if (cidx < 64) { seq_row0 = (cidx >> 4) * 4096; S = 4096; w = cidx & 15; } else { seq_row0 = TP; S = 8192; w = cidx - 64; } }
  else { seq_row0 = TP + (1 + (cidx >> 5)) * 8192; S = 8192; w = cidx & 31; }
  a.r = w % a.d; a.c = w / a.d; a.L = S / a.d; a.lrow0 = seq_row0 - half * THALF; a.ki0 = 256 * a.c - 64; a.colq = (size_t)a.g * 512 + a.j * 64;
  return a;
}
DI void attn_phase(const Params& p, int half, unsigned char* shm) {
  const int tid = opq_tid(), wid = tid >> 6, lane = tid & 63, bid = opq_bid();
  const int q32 = lane & 31, h = lane >> 5;
  const bf16_t* qkv = (const bf16_t*)(p.ws + OFF_BIG + B_QKV);
  bf16_t* og = (bf16_t*)(p.ws + OFF_BIG + B_OG);
  float* ml = (float*)(p.ws + OFF_BIG + B_LSE);
  const unsigned lbase = (unsigned)(size_t)(PG8_LAS unsigned char*)shm;
  u32x4 kreg[6], vreg[6];
#define AT_FETCH(UU) do { const AUnit f = attn_decode((UU), half); \
    _Pragma("unroll") for (int it = 0; it < 6; ++it) { const int idx = tid + 512 * it, slot = idx >> 3, ch = idx & 7, ki = f.ki0 + slot; \
      u32x4 kv = {0u, 0u, 0u, 0u}, vv = {0u, 0u, 0u, 0u}; \
      if (ki >= 0 && ki < f.L) { const bf16_t* rp = qkv + (size_t)(f.lrow0 + f.r + f.d * ki) * 4608 + f.colq + ch * 8; kv = *(const u32x4*)(rp + 1536); vv = *(const u32x4*)(rp + 3072); } \
      kreg[it] = kv; vreg[it] = vv; } \
    } while (0)
  if (bid < 2304) AT_FETCH(bid);
  for (int unit = bid; unit < 2304; unit += (int)gridDim.x) {
    const AUnit a = attn_decode(unit, half);
    const int g = a.g, j = a.j, d = a.d, r = a.r, c = a.c, L = a.L, lrow0 = a.lrow0, ki0 = a.ki0;
    pg8::bf16x8 qf[4];
    { const bf16_t* qp = qkv + (size_t)(lrow0 + r + d * (256 * c + 32 * wid + q32)) * 4608 + a.colq + 8 * h;
#pragma unroll
      for (int ks = 0; ks < 4; ++ks) qf[ks] = *(const pg8::bf16x8*)(qp + 16 * ks); }
    __syncthreads();
#pragma unroll
    for (int it = 0; it < 6; ++it) {
      const int idx = tid + 512 * it, slot = idx >> 3, ch = idx & 7;
      *(u32x4*)(shm + slot * AROW + ch * 16) = kreg[it]; *(u32x4*)(shm + AV_OFF + slot * AROW + ch * 16) = vreg[it];
    }
    __syncthreads();
    if (unit + (int)gridDim.x < 2304) AT_FETCH(unit + (int)gridDim.x);
    f32x16 st[5];
#pragma unroll
    for (int kt = 0; kt < 5; ++kt) {
#pragma unroll
      for (int i = 0; i < 16; ++i) st[kt][i] = 0.f;
#pragma unroll
      for (int ks = 0; ks < 4; ++ks) {
        const pg8::bf16x8 kf = *(const pg8::bf16x8*)(shm + (32 * wid + 32 * kt + q32) * AROW + (16 * ks + 8 * h) * 2);
        st[kt] = MFMA32(kf, qf[ks], st[kt]);
      }
    }
    const float slope_d = exp2f(-(float)(j + 1)) * (float)d;
    int hu = h, qu = q32; asm volatile("" : "+v"(hu), "+v"(qu));
    float m = -1e30f;
#pragma unroll
    for (int kt = 0; kt < 5; ++kt)
#pragma unroll
      for (int i = 0; i < 16; ++i) {
        const int rel = 32 * kt + crow(i, hu) - qu - 64; const int ki = ki0 + 32 * wid + 32 * kt + crow(i, hu);
        const int arel = rel < 0 ? -rel : rel;
        const bool valid = arel <= 64 && ki >= 0 && ki < L;
        const float s = valid ? st[kt][i] * 0.125f - slope_d * (float)arel : -1e30f;
        st[kt][i] = s; m = fmaxf(m, s);
      }
    m = fmaxf(m, __shfl_xor(m, 32));
    float l = 0.f;
#pragma unroll
    for (int kt = 0; kt < 5; ++kt)
#pragma unroll
      for (int i = 0; i < 16; ++i) { const float s = st[kt][i]; const float e = s > -1e29f ? __expf(s - m) : 0.f; st[kt][i] = e; l += e; }
    l += __shfl_xor(l, 32);
    f32x16 o[2];
#pragma unroll
    for (int et = 0; et < 2; ++et)
#pragma unroll
      for (int i = 0; i < 16; ++i) o[et][i] = 0.f;
    const int i16 = lane & 15, q4 = i16 >> 2, p4 = i16 & 3, blk = (lane >> 4) & 1;
    const unsigned vaddr0 = lbase + AV_OFF + (32 * wid + 4 * h + q4) * AROW + 32 * blk + 8 * p4;
#pragma unroll
    for (int kt = 0; kt < 5; ++kt)
#pragma unroll
      for (int s2 = 0; s2 < 2; ++s2) {
        u32x4 pw; pw.x = pk2c(st[kt][8 * s2 + 0], st[kt][8 * s2 + 1]); pw.y = pk2c(st[kt][8 * s2 + 2], st[kt][8 * s2 + 3]);
        pw.z = pk2c(st[kt][8 * s2 + 4], st[kt][8 * s2 + 5]); pw.w = pk2c(st[kt][8 * s2 + 6], st[kt][8 * s2 + 7]);
        const pg8::bf16x8 pa = __builtin_bit_cast(pg8::bf16x8, pw);
        const unsigned a = vaddr0 + (32 * kt + 16 * s2) * AROW;
        s16x4 lo0, hi0, lo1, hi1;
        tr_read4(a, a + 8 * AROW, a + 64, a + 8 * AROW + 64, lo0, hi0, lo1, hi1);
        const pg8::bf16x8 v0 = __builtin_shufflevector(lo0, hi0, 0, 1, 2, 3, 4, 5, 6, 7), v1 = __builtin_shufflevector(lo1, hi1, 0, 1, 2, 3, 4, 5, 6, 7);
        o[0] = MFMA32(pa, v0, o[0]); o[1] = MFMA32(pa, v1, o[1]);
      }
    const int rowq0 = half * THALF + lrow0 + r + d * (256 * c + 32 * wid);
#pragma unroll
    for (int et = 0; et < 2; ++et)
#pragma unroll
      for (int i = 0; i < 16; ++i) {
        const int row = rowq0 + d * crow(i, h);
        og[((size_t)g * T + row) * 512 + j * 64 + 32 * et + q32] = (bf16_t)(pk2c(o[et][i], 0.f) & 0xffffu);
      }
    if (h == 0) { const int row = rowq0 + d * q32; f32v2_t v = {m, l}; *(f32v2_t*)(ml + (((size_t)g * T + row) * 8 + j) * 2) = v; }
  }
#undef AT_FETCH
}


DI void tr_read2(unsigned a0, unsigned a1, s16x4& r0, s16x4& r1) {
  asm volatile("ds_read_b64_tr_b16 %0, %2\n\tds_read_b64_tr_b16 %1, %3\n\ts_waitcnt lgkmcnt(0)" : "=&v"(r0), "=&v"(r1) : "v"(a0), "v"(a1) : "memory");
}
constexpr int HP = 272;
constexpr int H_QT = 0, H_KT = 64 * HP, H_KE = 2 * 64 * HP, H_VV = 3 * 64 * HP, H_ST = H_VV + 64 * AROW, H_DEC = H_ST + 64 * HP, H_GG = H_DEC + 512;
DI void hgrn_phase(const Params& p, unsigned char* shm) {
  const int chain = opq_bid();
  if (chain >= 256) return;
  const int tid = opq_tid(), wid = tid >> 6, lane = tid & 63;
  const int vh = chain & 1, dir = (chain >> 1) & 1, head = (chain >> 2) & 7, seq = chain >> 5;
  const int slen = seq < 4 ? 4096 : 8192, row0 = seq < 4 ? seq * 4096 : TP + (seq - 4) * 8192, nchunks = slen >> 6;
  const bf16_t* pj = (const bf16_t*)(p.ws + OFF_BIG + B_PROJH);
  bf16_t* od = (bf16_t*)(p.ws + OFF_BIG + B_OFB) + (size_t)dir * T * D;
  const float* lbw = dir ? p.in[8] : p.in[7];
  const unsigned lbase = (unsigned)(size_t)(PG8_LAS unsigned char*)shm;
  const int c2 = 2 * lane;
  const float lb0 = 1.0f / (1.0f + __expf(lbw[D + head * 128 + c2] - lbw[head * 128 + c2]));
  const float lb1 = 1.0f / (1.0f + __expf(lbw[D + head * 128 + c2 + 1] - lbw[head * 128 + c2 + 1]));
  for (int i = tid; i < 64 * HP / 4; i += 512) ((unsigned*)(shm + H_ST))[i] = 0u;
  f32x16 Sacc[2];
#pragma unroll
  for (int b = 0; b < 2; ++b)
#pragma unroll
    for (int i = 0; i < 16; ++i) Sacc[b][i] = 0.f;
  unsigned rq[8], rf[8]; u32x4 rv;
#define HG_LOAD(cc) do { _Pragma("unroll") for (int ii = 0; ii < 8; ++ii) { const int il = 64 * (cc) + 8 * wid + ii; const int t = dir ? slen - 1 - il : il; \
      const bf16_t* bp = pj + (size_t)(row0 + t) * 4096 + head * 128 + c2; rq[ii] = *(const unsigned*)bp; rf[ii] = *(const unsigned*)(bp + 1024 * (1 + dir)); } \
    { const int il = 64 * (cc) + (tid >> 3); const int t = dir ? slen - 1 - il : il; rv = *(const u32x4*)(pj + (size_t)(row0 + t) * 4096 + 3072 + head * 128 + vh * 64 + (tid & 7) * 8); } } while (0)
  HG_LOAD(0);
  for (int c = 0; c < nchunks; ++c) {
    int hu = lane >> 5, qu = lane & 31; asm volatile("" : "+v"(hu), "+v"(qu));
    float q0[8], q1[8], k0[8], k1[8], P0[8], P1[8];
    float run0 = 1.f, run1 = 1.f;
#pragma unroll
    for (int ii = 0; ii < 8; ++ii) {
      const float hq0 = bflo(rq[ii]), hq1 = bfhi(rq[ii]), hf0 = bflo(rf[ii]), hf1 = bfhi(rf[ii]);
      const float s0 = sigm(hf0), s1 = sigm(hf1);
      run0 *= lb0 + (1.0f - lb0) * s0; run1 *= lb1 + (1.0f - lb1) * s1;
      P0[ii] = run0; P1[ii] = run1;
      k0[ii] = (1.0f - lb0) * (1.0f - s0); k1[ii] = (1.0f - lb1) * (1.0f - s1);
      q0[ii] = hq0; q1[ii] = hq1;
    }
    { f32v2_t gg = {run0, run1}; *(f32v2_t*)(shm + H_GG + (wid * 128 + c2) * 4) = gg; }
    *(u32x4*)(shm + H_VV + (tid >> 3) * AROW + (tid & 7) * 16) = rv;
    __syncthreads();
    float pre0 = 1.f, pre1 = 1.f, dec0 = 1.f, dec1 = 1.f;
#pragma unroll
    for (int w2 = 0; w2 < 8; ++w2) { const f32v2_t gg = *(const f32v2_t*)(shm + H_GG + (w2 * 128 + c2) * 4); dec0 *= gg[0]; dec1 *= gg[1]; if (w2 < wid) { pre0 *= gg[0]; pre1 *= gg[1]; } }
#pragma unroll
    for (int ii = 0; ii < 8; ++ii) {
      const float Pa = pre0 * P0[ii], Pb = pre1 * P1[ii];
      const float ia = __builtin_amdgcn_rcpf(Pa), ib = __builtin_amdgcn_rcpf(Pb);
      const float kta = k0[ii] * ia, ktb = k1[ii] * ib;
      const int off = (8 * wid + ii) * HP + c2 * 2;
      *(unsigned*)(shm + H_QT + off) = pk2c(q0[ii] * Pa, q1[ii] * Pb);
      *(unsigned*)(shm + H_KT + off) = pk2c(kta, ktb);
      *(unsigned*)(shm + H_KE + off) = pk2c(kta * dec0, ktb * dec1);
    }
    if (wid == 0) { f32v2_t dd = {dec0, dec1}; *(f32v2_t*)(shm + H_DEC + c2 * 4) = dd; }
    __syncthreads();
    if (c + 1 < nchunks) HG_LOAD(c + 1);
    const int i16 = lane & 15, q4 = i16 >> 2, p4 = i16 & 3, blk = (lane >> 4) & 1;
    if (wid < 4) {
      const int tb = wid >> 1, vb = wid & 1;
      f32x16 o;
#pragma unroll
      for (int i = 0; i < 16; ++i) o[i] = 0.f;
#pragma unroll
      for (int ks = 0; ks < 8; ++ks) {
        const pg8::bf16x8 a = *(const pg8::bf16x8*)(shm + H_QT + (32 * tb + qu) * HP + (16 * ks + 8 * hu) * 2);
        const pg8::bf16x8 b = *(const pg8::bf16x8*)(shm + H_ST + (32 * vb + qu) * HP + (16 * ks + 8 * hu) * 2);
        o = MFMA32(a, b, o);
      }
      for (int sb = 0; sb <= tb; ++sb) {
        f32x16 at;
#pragma unroll
        for (int i = 0; i < 16; ++i) at[i] = 0.f;
#pragma unroll
        for (int ks = 0; ks < 8; ++ks) {
          const pg8::bf16x8 a = *(const pg8::bf16x8*)(shm + H_KT + (32 * sb + qu) * HP + (16 * ks + 8 * hu) * 2);
          const pg8::bf16x8 b = *(const pg8::bf16x8*)(shm + H_QT + (32 * tb + qu) * HP + (16 * ks + 8 * hu) * 2);
          at = MFMA32(a, b, at);
        }
        if (sb == tb) {
#pragma unroll
          for (int i = 0; i < 16; ++i) at[i] = crow(i, hu) > qu ? 0.f : at[i];
        }
#pragma unroll
        for (int s2 = 0; s2 < 2; ++s2) {
          u32x4 pw; pw.x = pk2c(at[8 * s2 + 0], at[8 * s2 + 1]); pw.y = pk2c(at[8 * s2 + 2], at[8 * s2 + 3]); pw.z = pk2c(at[8 * s2 + 4], at[8 * s2 + 5]); pw.w = pk2c(at[8 * s2 + 6], at[8 * s2 + 7]);
          const pg8::bf16x8 pa = __builtin_bit_cast(pg8::bf16x8, pw);
          const unsigned a = lbase + H_VV + (32 * sb + 16 * s2 + 4 * hu + q4) * AROW + (32 * vb + 16 * blk) * 2 + 8 * p4;
          s16x4 lo, hi; tr_read2(a, a + 8 * AROW, lo, hi);
          const pg8::bf16x8 vf = __builtin_shufflevector(lo, hi, 0, 1, 2, 3, 4, 5, 6, 7);
          o = MFMA32(pa, vf, o);
        }
      }
#pragma unroll
      for (int i = 0; i < 16; ++i) {
        const int il = 64 * c + 32 * tb + crow(i, hu); const int t = dir ? slen - 1 - il : il;
        od[(size_t)(row0 + t) * D + head * 128 + vh * 64 + 32 * vb + qu] = (bf16_t)(pk2c(o[i], 0.f) & 0xffffu);
      }
    } else {
      const int kb = wid - 4;
#pragma unroll
      for (int i = 0; i < 16; ++i) { const float dv = *(const float*)(shm + H_DEC + (32 * kb + crow(i, hu)) * 4); Sacc[0][i] *= dv; Sacc[1][i] *= dv; }
#pragma unroll
      for (int s = 0; s < 4; ++s) {
        const unsigned aa = lbase + H_KE + (16 * s + 8 * hu + q4) * HP + (32 * kb + 16 * blk) * 2 + 8 * p4;
        const unsigned ab = lbase + H_VV + (16 * s + 8 * hu + q4) * AROW + (16 * blk) * 2 + 8 * p4;
        s16x4 alo, ahi, b0lo, b0hi, b1lo, b1hi;
        tr_read2(aa, aa + 4 * HP, alo, ahi); tr_read2(ab, ab + 4 * AROW, b0lo, b0hi); tr_read2(ab + 64, ab + 4 * AROW + 64, b1lo, b1hi);
        const pg8::bf16x8 af = __builtin_shufflevector(alo, ahi, 0, 1, 2, 3, 4, 5, 6, 7);
        const pg8::bf16x8 bf0 = __builtin_shufflevector(b0lo, b0hi, 0, 1, 2, 3, 4, 5, 6, 7), bf1v = __builtin_shufflevector(b1lo, b1hi, 0, 1, 2, 3, 4, 5, 6, 7);
        Sacc[0] = MFMA32(af, bf0, Sacc[0]); Sacc[1] = MFMA32(af, bf1v, Sacc[1]);
      }
    }
    __syncthreads();
    if (wid >= 4) {
      const int kb = wid - 4;
#pragma unroll
      for (int b = 0; b < 2; ++b)
#pragma unroll
        for (int g4 = 0; g4 < 4; ++g4) {
          u32x2 w; w.x = pk2c(Sacc[b][4 * g4 + 0], Sacc[b][4 * g4 + 1]); w.y = pk2c(Sacc[b][4 * g4 + 2], Sacc[b][4 * g4 + 3]);
          *(u32x2*)(shm + H_ST + (32 * b + qu) * HP + (32 * kb + 8 * g4 + 4 * hu) * 2) = w;
        }
    }
  }
#undef HG_LOAD
}

DI void merge_phase(const Params& p) {
  const int tid = opq_tid(), wid = tid >> 6, lane = tid & 63;
  const int bid = opq_bid(); const int gw = bid * 8 + wid, NGW = gridDim.x * 8;
  const bf16_t* og = (const bf16_t*)(p.ws + OFF_BIG + B_OG); const float* ml = (const float*)(p.ws + OFF_BIG + B_LSE);
  bf16_t* ya = (bf16_t*)(p.ws + OFF_BIG + B_YA);
  const int c0 = lane * 8, j = lane >> 3;
  for (int row = gw; row < T; row += NGW) {
    float mg[3], lg[3];
#pragma unroll
    for (int g = 0; g < 3; ++g) { const f32v2_t v = *(const f32v2_t*)(ml + (((size_t)g * T + row) * 8 + j) * 2); mg[g] = v[0]; lg[g] = v[1]; }
    const float M = fmaxf(mg[0], fmaxf(mg[1], mg[2]));
    float acc[8]; float den = 0.f;
#pragma unroll
    for (int e = 0; e < 8; ++e) acc[e] = 0.f;
#pragma unroll
    for (int g = 0; g < 3; ++g) {
      const float wg = __expf(mg[g] - M); den += wg * lg[g];
      const u32x4 a = *(const u32x4*)(og + ((size_t)g * T + row) * 512 + c0);
#pragma unroll
      for (int e = 0; e < 4; ++e) { acc[2 * e] += wg * bflo(a[e]); acc[2 * e + 1] += wg * bfhi(a[e]); }
    }
    const float inv = __builtin_amdgcn_rcpf(den);
    u32x4 w; w.x = pk2c(acc[0] * inv, acc[1] * inv); w.y = pk2c(acc[2] * inv, acc[3] * inv); w.z = pk2c(acc[4] * inv, acc[5] * inv); w.w = pk2c(acc[6] * inv, acc[7] * inv);
    *(u32x4*)(ya + (size_t)row * 512 + c0) = w;
  }
}

DI void final_phase(const Params& p) {
  const int tid = opq_tid(), wid = tid >> 6, lane = tid & 63;
  const int bid = opq_bid(); const int gw = bid * 8 + wid, NGW = gridDim.x * 8;
  const float* ss3 = (const float*)(p.ws + OFF_SS) + (size_t)3 * T * 16; const float* g = p.in[16];
  f32x4 g4[4];
#pragma unroll
  for (int j = 0; j < 4; ++j) g4[j] = *(const f32x4*)(g + 4 * lane + 256 * j);
  for (int row = gw; row < T; row += NGW) {
    const float rs = rsqrtf(ss16(ss3 + (size_t)row * 16) * (1.0f / 1024.0f) + EPS);
    float* xr = p.out + (size_t)row * D;
#pragma unroll
    for (int j = 0; j < 4; ++j) { f32x4 v = *(const f32x4*)(xr + 4 * lane + 256 * j); v = v * rs * g4[j]; *(f32x4*)(xr + 4 * lane + 256 * j) = v; }
  }
}

#define XB_TMO      128
#define XB_XCNT(j)  (256  + 64 * (j))
#define XB_XSUB(j)  (1280 + 64 * (j))
#define XB_XGEN(j)  (2304 + 64 * (j))
#define XB_TOP      3328
#define XB_TOPGEN   3392
#define XCD_BAR_WORDS 3456
#define XB_SPIN_CAP (1u << 18)
#define XLAS __attribute__((address_space(3)))

__device__ __forceinline__ unsigned xb_ld(unsigned* p)              { return __hip_atomic_load(p, __ATOMIC_RELAXED, __HIP_MEMORY_SCOPE_AGENT); }
__device__ __forceinline__ unsigned xb_add(unsigned* p, unsigned v) { return __hip_atomic_fetch_add(p, v, __ATOMIC_RELAXED, __HIP_MEMORY_SCOPE_AGENT); }
__device__ __forceinline__ unsigned xb_xcc_id() { return (unsigned)__builtin_amdgcn_s_getreg((3 << 11) | 20) & 0xFu; }
#define XB_SPIN(cond, bar) do { unsigned _sp = 0; while (cond) { __builtin_amdgcn_s_sleep(1); \
    if ((++_sp & 255u) == 0u) { if (xb_ld(&(bar)[XB_TMO])) break; if (_sp > XB_SPIN_CAP) { atomicAdd(&(bar)[XB_TMO], 1u); break; } } } } while (0)

struct XcdBarrier {
    unsigned* bar; unsigned x;
    volatile XLAS unsigned* st;
};

__device__ __forceinline__ XcdBarrier xcd_barrier_post(unsigned* bar, volatile XLAS unsigned* st) {
    XcdBarrier b; b.bar = bar; b.x = xb_xcc_id(); b.st = st;
    if (threadIdx.x == 0) (void)xb_add(&bar[XB_XCNT(b.x)], 1u);
    return b;
}
__device__ __forceinline__ void xcd_barrier_complete(unsigned* bar, unsigned x, unsigned& nloc, unsigned& nx) {
    const unsigned G = gridDim.x * gridDim.y * gridDim.z;
    unsigned sum, cnt, mine, sp = 0u;
    for (;;) {
        sum = 0u; cnt = 0u; mine = 0u;
#pragma unroll
        for (unsigned j = 0; j < 16; ++j) { const unsigned c = xb_ld(&bar[XB_XCNT(j)]); sum += c; cnt += (c > 0u) ? 1u : 0u; mine = (j == x) ? c : mine; }
        if (sum == G) break;
        __builtin_amdgcn_s_sleep(1);
        if ((++sp & 255u) == 0u) { if (xb_ld(&bar[XB_TMO])) break; if (sp > XB_SPIN_CAP) { atomicAdd(&bar[XB_TMO], 1u); break; } }
    }
    nloc = mine > 0u ? mine : 1u; nx = cnt > 0u ? cnt : 1u;
}

__device__ __forceinline__ void xcd_barrier(const XcdBarrier& b) {
    asm volatile("s_waitcnt vmcnt(0)" ::: "memory");
    __syncthreads();
    if (threadIdx.x == 0) {
        unsigned* bar = b.bar;
        __builtin_amdgcn_s_waitcnt(0);
        unsigned nloc = b.st[0], nx = b.st[1];
        if (nloc == 0u) { xcd_barrier_complete(bar, b.x, nloc, nx); b.st[0] = nloc; b.st[1] = nx; }
        const unsigned old = xb_add(&bar[XB_XSUB(b.x)], 1u);
        const unsigned gen = old / nloc;
        if (old + 1u == (gen + 1u) * nloc) {
            __builtin_amdgcn_fence(__ATOMIC_RELEASE, "agent");
            asm volatile("s_waitcnt vmcnt(0)" ::: "memory");
            const unsigned og = xb_add(&bar[XB_TOP], 1u);
            const unsigned tg = og / nx;
            if (og + 1u == (tg + 1u) * nx) xb_add(&bar[XB_TOPGEN], 1u);
            else XB_SPIN(xb_ld(&bar[XB_TOPGEN]) == tg, bar);
            __builtin_amdgcn_fence(__ATOMIC_ACQUIRE, "agent");
            xb_add(&bar[XB_XGEN(b.x)], 1u);
            asm volatile("s_waitcnt vmcnt(0)" ::: "memory");
        } else {
            XB_SPIN(xb_ld(&bar[XB_XGEN(b.x)]) == gen, bar);
            __builtin_amdgcn_fence(__ATOMIC_ACQUIRE, "agent");
            asm volatile("s_waitcnt vmcnt(0)" ::: "memory");
        }
    }
    __syncthreads();
}


enum { PT_GEMM = 0, PT_HGRN = 1, PT_COMBINE = 2, PT_ATTN0 = 3, PT_ATTN1 = 4, PT_FINAL = 5, PT_MERGE = 6 };
constexpr int NPH = 18;
__global__ void __launch_bounds__(512, 2) fwd_megakernel(Params p) {
  extern __shared__ __attribute__((aligned(16))) unsigned char shm[];
  cg::grid_group grid = cg::this_grid();
  unsigned* ctr = (unsigned*)(p.ws + OFF_CTR);
  if (threadIdx.x == 0) { *(volatile unsigned*)(shm + 131072 + 200) = 0u; *(volatile unsigned*)(shm + 131072 + 204) = 0u; }
  __syncthreads();
  const XcdBarrier xb = xcd_barrier_post((unsigned*)(p.ws + OFF_BAR), (volatile XLAS unsigned*)((XLAS unsigned char*)shm + 131072 + 200));
  unsigned my_x = 0, my_rank = 0;
  if (threadIdx.x == 0) { my_x = (unsigned)__builtin_amdgcn_s_getreg((3 << 11) | 20) & 0xFu; if (my_x > 7u) my_x = 7u; my_rank = __hip_atomic_fetch_add(ctr + my_x, 1u, __ATOMIC_RELAXED, __HIP_MEMORY_SCOPE_AGENT); }
  prep_phase(p, shm);
  grid.sync();
  if (threadIdx.x == 0) {
    bool ok = true;
    for (int x = 0; x < 8; ++x) ok = ok && (__hip_atomic_load(ctr + x, __ATOMIC_RELAXED, __HIP_MEMORY_SCOPE_AGENT) * 8u == gridDim.x);
    *(int*)(shm + 131072 + 192) = ok ? (int)(my_rank * 8u + my_x) : (int)blockIdx.x;
  }
  __syncthreads();
  const int vcu = __builtin_amdgcn_readfirstlane(*(const int*)(shm + 131072 + 192));
  for (int ph = 0; ph < NPH; ++ph) {
    const int type = p.ph[ph].type;
    if (type == PT_GEMM) {
      __syncthreads();
      if (threadIdx.x == 0) *(EpiP*)(shm + 131072) = p.ph[ph].e;
      __syncthreads();
      pg8::Gemm g; g.A = p.ph[ph].A; g.Bt = p.ph[ph].Bt; g.M = p.ph[ph].M; g.N = p.ph[ph].N; g.K = p.ph[ph].K;
      Epi E; E.lp = (const PG8_LAS EpiP*)((PG8_LAS unsigned char*)shm + 131072);
      int vc = vcu; asm volatile("" : "+s"(vc)); pg8::StaticOrder S; S.init(g.M, g.N, (int)gridDim.x, vc);
      int nrep = 1;
#if defined(REP_PH)
      if (ph == REP_PH) nrep = 2;
#endif
      for (int rr = 0; rr < nrep; ++rr) {
        if (rr) grid.sync();
        pg8::gemm_phase<Epi, pg8::StaticOrder>((PG8_LAS unsigned char*)shm, g, S, E);
      }
    } else if (type == PT_HGRN) { hgrn_phase(p, shm);
#if defined(REP_HGRN)
      grid.sync(); hgrn_phase(p, shm);
#endif
    }
    else if (type == PT_COMBINE) combine_phase(p);
    else if (type == PT_ATTN0) { attn_phase(p, 0, shm);
#if defined(REP_ATTN)
      grid.sync(); attn_phase(p, 0, shm);
#endif
    }
    else if (type == PT_ATTN1) { attn_phase(p, 1, shm);
#if defined(REP_ATTN)
      grid.sync(); attn_phase(p, 1, shm);
#endif
    }
    else if (type == PT_MERGE) merge_phase(p);
    else final_phase(p);
    if (ph < NPH - 1) xcd_barrier(xb);
  }
}

static void fill_phases(Params& p) {
  unsigned char* ws = p.ws; unsigned char* big = ws + OFF_BIG;
  float* ssb = (float*)(ws + OFF_SS); bf16_t* xb = (bf16_t*)(ws + OFF_XB);
  float* ss0 = ssb; float* ss1 = ssb + (size_t)T * 16; float* ss2 = ssb + (size_t)2 * T * 16; float* ss3 = ssb + (size_t)3 * T * 16;
  const bf16_t* win = (const bf16_t*)(ws + OFF_WIN);
  auto gemm = [&](int i, const bf16_t* A, const bf16_t* Bt, int M, int N, int K) -> EpiP& {
    PhaseDesc& d = p.ph[i]; d.type = PT_GEMM; d.M = M; d.N = N; d.K = K; d.A = A; d.Bt = Bt; d.e.mode = M_BF16S; d.e.ldo = D; d.e.alpha = 1.0f; return d.e; };
  auto other = [&](int i, int type) { p.ph[i].type = type; };
  { EpiP& e = gemm(0, xb, (const bf16_t*)(ws + OFF_WGU1), T, 2 * FF, D); e.mode = M_SWIGLU; e.ss = ss0; e.ob = (bf16_t*)(big + B_ACT); }
  { EpiP& e = gemm(1, (const bf16_t*)(big + B_ACT), (const bf16_t*)(ws + OFF_WD1), T, D, FF); e.mode = M_RESID; e.alpha = 0.5f; e.of = p.out; e.r0 = p.in[0]; e.r1 = p.in[1]; e.ob = xb; e.ss_out = ss1; }
  { EpiP& e = gemm(2, xb, win + (size_t)4608 * D, T, 4096, D); e.ss = ss1; e.ob = (bf16_t*)(big + B_PROJH); e.ldo = 4096; e.silu_tiles = 4; }
  other(3, PT_HGRN);
  { EpiP& e = gemm(4, xb, win + (size_t)8704 * D, T, 1024, D); e.ss = ss1; e.ob = (bf16_t*)(big + B_HG); e.ldo = 1024; }
  other(5, PT_COMBINE);
  for (int half = 0; half < 2; ++half) {
    EpiP& e = gemm(6 + 2 * half, xb + (size_t)half * THALF * D, win, THALF, 4608, D); e.ss = ss1 + (size_t)half * THALF * 16; e.ob = (bf16_t*)(big + B_QKV); e.ldo = 4608;
    other(7 + 2 * half, half ? PT_ATTN1 : PT_ATTN0);
  }
  other(10, PT_MERGE);
  { EpiP& e = gemm(11, xb, win + (size_t)9728 * D, T, 2048, D); e.ss = ss1; e.sig = 1; e.ob = (bf16_t*)(big + B_SGA); e.ldo = 1024; e.split_tiles = 4; e.split_stride = (size_t)T * D; }
  { EpiP& e = gemm(12, (const bf16_t*)(big + B_YA), (const bf16_t*)(ws + OFF_WA), T, D, 512); e.mode = M_MUL; e.sg = (const bf16_t*)(big + B_SGA); e.of = (float*)(big + B_TMP); }
  { EpiP& e = gemm(13, (const bf16_t*)(big + B_YB), (const bf16_t*)(ws + OFF_WB), T, D, D); e.mode = M_FMA; e.sg = (const bf16_t*)(big + B_SGB); e.tmp = (const float*)(big + B_TMP); e.ob = (bf16_t*)(big + B_SGB); }
  { EpiP& e = gemm(14, (const bf16_t*)(big + B_SGB), (const bf16_t*)(ws + OFF_WO), T, D, D); e.mode = M_RESID; e.alpha = 1.0f; e.of = p.out; e.r0 = p.out; e.r1 = p.out + (size_t)TP * D; e.ob = xb; e.ss_out = ss2; }
  { EpiP& e = gemm(15, xb, (const bf16_t*)(ws + OFF_WGU2), T, 2 * FF, D); e.mode = M_SWIGLU; e.ss = ss2; e.ob = (bf16_t*)(big + B_ACT); }
  { EpiP& e = gemm(16, (const bf16_t*)(big + B_ACT), (const bf16_t*)(ws + OFF_WD2), T, D, FF); e.mode = M_RESID; e.alpha = 0.5f; e.of = p.out; e.r0 = p.out; e.r1 = p.out + (size_t)TP * D; e.ob = nullptr; e.ss_out = ss3; }
  other(17, PT_FINAL);
}

extern "C" void kernel_launch(void* const* d_in, const int* in_sizes, int n_in, void* d_out, int out_size, void* d_ws, size_t ws_size, hipStream_t stream) {
  constexpr int kDynLds = 131072 + 256;
  static int grid_blocks = 0;
  if (!grid_blocks) {
    if (n_in != 17 || out_size != T * D || ws_size < WS_NEED) { fprintf(stderr, "kernel_launch: unexpected shapes (n_in %d out %d ws %zu need %zu)\n", n_in, out_size, ws_size, (size_t)WS_NEED); grid_blocks = -1; return; }
    int dev = 0, cus = 0, per_cu = 0;
    (void)hipGetDevice(&dev);
    (void)hipDeviceGetAttribute(&cus, hipDeviceAttributeMultiprocessorCount, dev);
    (void)hipFuncSetAttribute((const void*)fwd_megakernel, hipFuncAttributeMaxDynamicSharedMemorySize, kDynLds);
    (void)hipOccupancyMaxActiveBlocksPerMultiprocessor(&per_cu, (const void*)fwd_megakernel, 512, kDynLds);
    if (per_cu < 1) per_cu = 1;
    grid_blocks = cus * per_cu;
  }
  if (grid_blocks < 0) return;
  static Params p;
  memset(&p, 0, sizeof(p));
  for (int i = 0; i < 17; ++i) p.in[i] = (const float*)d_in[i];
  p.out = (float*)d_out; p.ws = (unsigned char*)d_ws;
  fill_phases(p);
  (void)hipMemsetAsync((unsigned char*)d_ws + OFF_CTR, 0, 256 + 3456 * 4, stream);
  void* args[] = {&p};
  hipError_t e = hipLaunchCooperativeKernel((const void*)fwd_megakernel, dim3(grid_blocks), dim3(512), args, kDynLds, stream);
  if (e != hipSuccess) fprintf(stderr, "cooperative launch failed: %s (grid %d)\n", hipGetErrorString(e), grid_blocks);
}
```

```cpp
#include <hip/hip_runtime.h>
#include <hip/hip_cooperative_groups.h>
#include <cstdio>
#include <cstdint>
#include <cstring>
namespace cg = cooperative_groups;
__device__ __forceinline__ int opq_tid() { int t = threadIdx.x; asm volatile("" : "+v"(t)); return t; }
__device__ __forceinline__ int opq_bid() { int b = blockIdx.x; asm volatile("" : "+s"(b)); return b; }
namespace pg8 {
#define PG8_LAS __attribute__((address_space(3)))
typedef unsigned short bf16_t;
typedef short bf16x8 __attribute__((ext_vector_type(8)));
typedef float f32x4 __attribute__((ext_vector_type(4)));
typedef unsigned u32x4 __attribute__((ext_vector_type(4)));
constexpr int BM = 256, BK = 64, HALF = 128, HTB = HALF * BK * 2  , STAGE_BYTES = 8 * HTB, NXCD = 8, WGM = 8;

__host__ __device__ __forceinline__ int lds_byte(int r, int c) { const int st = (r >> 4) * 2 + (c >> 5), rr = r & 15, cc = c & 31, ob = rr * 64 + cc * 2; return st * 1024 + (ob ^ (((ob >> 9) & 1) << 5)); }
__host__ __device__ __forceinline__ void stage_rc(int b, int& R, int& C) { const int st = b / 1024, sb = b % 1024, swz = sb ^ (((sb >> 9) & 1) << 5); R = (st >> 1) * 16 + swz / 64; C = (st & 1) * 32 + (swz % 64) / 2; }
__host__ __device__ __forceinline__ int perm32(int rho) { const int n = rho >> 4, i = rho & 15; return 8 * (i >> 2) + 4 * n + (i & 3); }

struct Unit { int pm, pn; };
struct Gemm { const bf16_t* A; const bf16_t* Bt; int M, N, K; };

struct StaticOrder {
    int nM, nN, nwg, G, c;
    __host__ __device__ __forceinline__ void init(int M, int N, int G_, int c_) { nM = M / BM; nN = N / BM; nwg = nM * nN; G = G_; c = c_; }
    __host__ __device__ __forceinline__ bool next(int i, Unit& u) const {
        const long L = (long)i * G + c; if (L >= nwg) return false;
        int wgid = (int)L; { const int q = nwg / NXCD, r = nwg % NXCD, xcd = wgid % NXCD, off = wgid / NXCD; wgid = (xcd < r ? xcd * (q + 1) : r * (q + 1) + (xcd - r) * q) + off; }
        const int nig = WGM * nN, gid = wgid / nig, fm = gid * WGM, gsz = (nM - fm) < WGM ? (nM - fm) : WGM;
        u.pm = fm + ((wgid % nig) % gsz); u.pn = (wgid % nig) / gsz; return true;
    }
    __device__ __forceinline__ void a_ready(const Unit&) const {}
    __device__ __forceinline__ void done(const Unit&) const {}
};
template <class Epi, class Sched, bool ALIGN_EPI = false, bool SP2 = false>
__device__ __forceinline__ void gemm_phase(PG8_LAS unsigned char* lds, const Gemm g, const Sched& S, const Epi& E) {
    const int tid = opq_tid(), wid = __builtin_amdgcn_readfirstlane(tid >> 6), lane = tid & 63, wr = wid >> 2, wc = wid & 3, fr = lane & 15, fq = lane >> 4;
    const int K = g.K, nt = K / BK;
    unsigned voffA[2], voffB[2];
#pragma unroll
    for (int i = 0; i < 2; ++i) { int R, C; stage_rc(tid * 16 + i * 8192, R, C); const int Rb = Epi::PERM ? ((R & ~31) + perm32(R & 31)) : R;
        voffA[i] = (unsigned)(R * K + C) * 2u; voffB[i] = (unsigned)(Rb * K + C) * 2u; }
    const size_t kstep = (size_t)(BK * 2);
    const size_t hstep = (size_t)HALF * K * 2;
    const size_t tstep = 2 * hstep;
    const unsigned ldsw = (unsigned)wid * 1024u;
    const int aoff = lds_byte(wr * 64 + fr, fq * 8), boff = lds_byte(wc * 32 + fr, fq * 8);
#define PG8_SA(b, h) (((b) * 2 + (h)) * HTB)
#define PG8_SB(b, h) ((4 + (b) * 2 + (h)) * HTB)
#define PG8_STAGE(bufoff, gbase, voff) do { _Pragma("unroll") for (int _i = 0; _i < 2; ++_i) \
        __builtin_amdgcn_global_load_lds((const unsigned*)((const char*)(gbase) + (voff)[_i]), (PG8_LAS unsigned*)(lds + (bufoff) + ldsw + _i * 8192), 16, 0, 0); } while (0)
#define PG8_LDA(dst, b, h) do { _Pragma("unroll") for (int m = 0; m < 4; ++m) _Pragma("unroll") for (int k = 0; k < 2; ++k) dst[m][k] = *(const PG8_LAS bf16x8*)(lds + PG8_SA(b, h) + aoff + m * 2048 + k * 1024); } while (0)
#define PG8_LDB(dst, b, h) do { _Pragma("unroll") for (int n = 0; n < 2; ++n) _Pragma("unroll") for (int k = 0; k < 2; ++k) dst[n][k] = *(const PG8_LAS bf16x8*)(lds + PG8_SB(b, h) + boff + n * 2048 + k * 1024); } while (0)
#define PG8_MMA(ai, bj, At, Bt) do { __builtin_amdgcn_s_setprio(1); _Pragma("unroll") for (int m = 0; m < 4; ++m) _Pragma("unroll") for (int n = 0; n < 2; ++n) _Pragma("unroll") for (int k = 0; k < 2; ++k) \
        acc[ai][bj][m][n] = __builtin_amdgcn_mfma_f32_16x16x32_bf16(Bt[n][k], At[m][k], acc[ai][bj][m][n], 0, 0, 0); __builtin_amdgcn_s_setprio(0); } while (0)
#define PG8_WAIT_V(n) asm volatile("s_waitcnt vmcnt(" #n ")" ::: "memory")
#define PG8_WAIT_L(n) asm volatile("s_waitcnt lgkmcnt(" #n ")" ::: "memory")
#define PG8_BAR __builtin_amdgcn_s_barrier()
#define PG8_SCHED __builtin_amdgcn_sched_barrier(0)
    Unit cur, nxt; int ui = 0;
    if (!S.next(0, cur)) return;
    f32x4 acc[2][2][4][2];
#pragma unroll
    for (int a = 0; a < 2; ++a)
#pragma unroll
        for (int b = 0; b < 2; ++b)
#pragma unroll
            for (int m = 0; m < 4; ++m)
#pragma unroll
                for (int n = 0; n < 2; ++n) acc[a][b][m][n] = (f32x4){0.f, 0.f, 0.f, 0.f};
    bf16x8 At[4][2], B0[2][2], B1[2][2];
    const char* cA = (const char*)g.A + (size_t)cur.pm * tstep; const char* cB = (const char*)g.Bt + (size_t)cur.pn * tstep;
    S.a_ready(cur);
    if constexpr (SP2) {
        PG8_STAGE(PG8_SB(0, 0), cB, voffB); PG8_STAGE(PG8_SB(0, 1), cB + hstep, voffB); PG8_STAGE(PG8_SA(0, 0), cA, voffA); PG8_STAGE(PG8_SA(0, 1), cA + hstep, voffA);
        if (wr == 1) PG8_BAR;
        PG8_WAIT_V(2); PG8_BAR;
        PG8_STAGE(PG8_SB(1, 0), cB + kstep, voffB); PG8_STAGE(PG8_SA(1, 0), cA + kstep, voffA); PG8_STAGE(PG8_SB(1, 1), cB + hstep + kstep, voffB);
        PG8_WAIT_V(6); PG8_BAR;
    } else {
        PG8_STAGE(PG8_SB(0, 0), cB, voffB); PG8_STAGE(PG8_SA(0, 0), cA, voffA); PG8_STAGE(PG8_SB(0, 1), cB + hstep, voffB); PG8_STAGE(PG8_SA(0, 1), cA + hstep, voffA);
        if (wr == 1) PG8_BAR;
        PG8_WAIT_V(4); PG8_BAR;
        PG8_STAGE(PG8_SB(1, 0), cB + kstep, voffB); PG8_STAGE(PG8_SA(1, 0), cA + kstep, voffA); PG8_STAGE(PG8_SB(1, 1), cB + hstep + kstep, voffB);
        PG8_WAIT_V(6); PG8_BAR;
    }
    for (;;) {
        const bool has_next = S.next(ui + 1, nxt);
        const char* nA = has_next ? (const char*)g.A + (size_t)nxt.pm * tstep : cA; const char* nB = has_next ? (const char*)g.Bt + (size_t)nxt.pn * tstep : cB;
        for (int t = 0; t < nt; t += 2) {
            const bool last = (t == nt - 2);
            const char* a1 = cA + (size_t)(t + 1) * kstep;
            const char* a2 = last ? nA : cA + (size_t)(t + 2) * kstep; const char* b2 = last ? nB : cB + (size_t)(t + 2) * kstep;
            const char* a3 = a2 + kstep; const char* b3 = b2 + kstep;
            if (last && has_next) S.a_ready(nxt);
            if constexpr (SP2) {
            PG8_LDB(B0, 0, 0); PG8_LDB(B1, 0, 1); PG8_SCHED; PG8_LDA(At, 0, 0); PG8_STAGE(PG8_SA(1, 1), a1 + hstep, voffA);
            PG8_WAIT_V(8); PG8_WAIT_L(0); PG8_BAR; PG8_MMA(0, 0, At, B0); PG8_MMA(0, 1, At, B1); PG8_BAR; PG8_SCHED;
            PG8_LDA(At, 0, 1); PG8_STAGE(PG8_SB(0, 0), b2, voffB); PG8_STAGE(PG8_SB(0, 1), b2 + hstep, voffB); PG8_STAGE(PG8_SA(0, 0), a2, voffA);
            PG8_WAIT_V(8); PG8_WAIT_L(0); PG8_BAR; PG8_MMA(1, 0, At, B0); PG8_MMA(1, 1, At, B1); PG8_BAR; PG8_SCHED;
            PG8_LDB(B0, 1, 0); PG8_LDB(B1, 1, 1); PG8_SCHED; PG8_LDA(At, 1, 0); PG8_STAGE(PG8_SA(0, 1), a2 + hstep, voffA);
            PG8_WAIT_V(8); PG8_WAIT_L(0); PG8_BAR; PG8_MMA(0, 0, At, B0); PG8_MMA(0, 1, At, B1); PG8_BAR; PG8_SCHED;
            PG8_LDA(At, 1, 1); PG8_STAGE(PG8_SB(1, 0), b3, voffB); PG8_STAGE(PG8_SB(1, 1), b3 + hstep, voffB); PG8_STAGE(PG8_SA(1, 0), a3, voffA);
            PG8_WAIT_V(8); PG8_WAIT_L(0); PG8_BAR; PG8_MMA(1, 0, At, B0); PG8_MMA(1, 1, At, B1); PG8_BAR; PG8_SCHED;
            } else {
            PG8_LDB(B0, 0, 0); PG8_SCHED; PG8_LDA(At, 0, 0); PG8_STAGE(PG8_SA(1, 1), a1 + hstep, voffA);
            PG8_WAIT_L(8); PG8_BAR; PG8_WAIT_L(0); PG8_MMA(0, 0, At, B0); PG8_BAR; PG8_SCHED;
            PG8_LDB(B1, 0, 1); PG8_STAGE(PG8_SB(0, 0), b2, voffB);
            PG8_BAR; PG8_WAIT_L(0); PG8_MMA(0, 1, At, B1); PG8_BAR;
            PG8_LDA(At, 0, 1); PG8_STAGE(PG8_SA(0, 0), a2, voffA);
            PG8_BAR; PG8_WAIT_L(0); PG8_MMA(1, 0, At, B0); PG8_BAR; PG8_SCHED;
            PG8_STAGE(PG8_SB(0, 1), b2 + hstep, voffB);
            PG8_WAIT_V(6); PG8_BAR; PG8_MMA(1, 1, At, B1); PG8_BAR;
            PG8_LDB(B0, 1, 0); PG8_SCHED; PG8_LDA(At, 1, 0); PG8_STAGE(PG8_SA(0, 1), a2 + hstep, voffA);
            PG8_WAIT_L(8); PG8_BAR; PG8_WAIT_L(0); PG8_MMA(0, 0, At, B0); PG8_BAR; PG8_SCHED;
            PG8_LDB(B1, 1, 1); PG8_STAGE(PG8_SB(1, 0), b3, voffB);
            PG8_BAR; PG8_WAIT_L(0); PG8_MMA(0, 1, At, B1); PG8_BAR;
            PG8_LDA(At, 1, 1); PG8_STAGE(PG8_SA(1, 0), a3, voffA);
            PG8_BAR; PG8_WAIT_L(0); PG8_MMA(1, 0, At, B0); PG8_BAR; PG8_SCHED;
            PG8_STAGE(PG8_SB(1, 1), b3 + hstep, voffB);
            PG8_WAIT_V(6); PG8_BAR; PG8_MMA(1, 1, At, B1); PG8_BAR;
            }
        }
        if constexpr (ALIGN_EPI) { if (wr == 0) PG8_BAR; }
        if constexpr (!Epi::AFTER_DRAIN) { E(acc, cur, wr, wc, fr, fq); S.done(cur); }
        if (!has_next) break;
#pragma unroll
        for (int a = 0; a < 2; ++a)
#pragma unroll
            for (int b = 0; b < 2; ++b)
#pragma unroll
                for (int m = 0; m < 4; ++m)
#pragma unroll
                    for (int n = 0; n < 2; ++n) acc[a][b][m][n] = (f32x4){0.f, 0.f, 0.f, 0.f};
        cur = nxt; cA = nA; cB = nB; ++ui;
        if constexpr (ALIGN_EPI) { if (wr == 1) PG8_BAR; }
    }
    PG8_WAIT_V(0);
    if constexpr (!ALIGN_EPI) { if (wr == 0) PG8_BAR; }
    PG8_BAR;
    if constexpr (Epi::AFTER_DRAIN) { E.fused(acc, cur, wr, wc, fr, fq, lds, wid, lane); S.done(cur); }
#undef PG8_SA
#undef PG8_SB
#undef PG8_STAGE
#undef PG8_LDA
#undef PG8_LDB
#undef PG8_MMA
#undef PG8_WAIT_V
#undef PG8_WAIT_L
#undef PG8_BAR
#undef PG8_SCHED
}
}

using pg8::f32x4; using pg8::bf16_t; using pg8::u32x4;
typedef unsigned u32x2 __attribute__((ext_vector_type(2)));
#define DI __device__ __forceinline__
#define LDS_BARRIER() do { asm volatile("s_waitcnt lgkmcnt(0)" ::: "memory"); __builtin_amdgcn_s_barrier(); asm volatile("" ::: "memory"); } while (0)

constexpr int T = 49152, TP = 16384, D = 1024, FF = 2816, NIN = 11776, THALF = 24576;
constexpr float EPS = 1e-6f;
constexpr int LCTL = 163840 - 256;

typedef __bf16 bf16v2_t __attribute__((ext_vector_type(2)));
typedef float f32v2_t __attribute__((ext_vector_type(2)));
DI unsigned pk2(float lo, float hi) { f32v2_t v = {lo, hi}; bf16v2_t r = __builtin_convertvector(v, bf16v2_t); return __builtin_bit_cast(unsigned, r); }
DI float bflo(unsigned u) { return __uint_as_float(u << 16); }
DI float bfhi(unsigned u) { return __uint_as_float(u & 0xffff0000u); }
DI float bf1(bf16_t b) { return __uint_as_float(((unsigned)b) << 16); }
DI float sigm(float x) { return __builtin_amdgcn_rcpf(1.0f + __expf(-x)); }
DI float wave_sum(float v) {
#pragma unroll
  for (int o = 1; o < 64; o <<= 1) v += __shfl_xor(v, o);
  return v;
}
DI float wave_max(float v) {
#pragma unroll
  for (int o = 1; o < 64; o <<= 1) v = fmaxf(v, __shfl_xor(v, o));
  return v;
}

DI float ss16(const float* p) { const f32x4 a = *(const f32x4*)p, b = *(const f32x4*)(p + 4), c = *(const f32x4*)(p + 8), d = *(const f32x4*)(p + 12);
  return ((a[0] + a[1]) + (a[2] + a[3])) + ((b[0] + b[1]) + (b[2] + b[3])) + ((c[0] + c[1]) + (c[2] + c[3])) + ((d[0] + d[1]) + (d[2] + d[3])); }
enum { M_SWIGLU = 0, M_BF16S = 1, M_RESID = 2, M_MUL = 3, M_FMA = 4 };

struct EpiP {
  int mode, sig, split_tiles, ldo;
  const float* ss; bf16_t* ob; size_t split_stride;
  float* of; const float* r0; const float* r1; float alpha; int silu_tiles; float* ss_out;
  const bf16_t* sg; const float* tmp;
  const float* lbp; int kk_lo; int pad2;
};
struct Epi {
  static constexpr bool PERM = false, AFTER_DRAIN = false;
  const PG8_LAS EpiP* lp;
  __device__ __forceinline__ void operator()(const f32x4 (&acc)[2][2][4][2], const pg8::Unit& u, int wr, int wc, int fr, int fq) const {
    asm volatile("" : "+v"(fr), "+v"(fq));
    const int mode = lp->mode, sig = lp->sig, split_tiles = lp->split_tiles, ldo = lp->ldo, silu_tiles = lp->silu_tiles;
    const float* ss = lp->ss; bf16_t* ob = lp->ob; const size_t split_stride = lp->split_stride;
    float* of = lp->of; const float* r0 = lp->r0; const float* r1 = lp->r1; const float alpha = lp->alpha; float* ss_out = lp->ss_out;
    const bf16_t* sg = lp->sg; const float* tmp = lp->tmp; const float* lbp = lp->lbp; const int kk_lo = lp->kk_lo;
    const int rowb = u.pm * 256 + wr * 64 + fr;
    float rsv[8];
    if (mode == M_SWIGLU || mode == M_BF16S) {
      f32x4 pq[8];
#pragma unroll
      for (int q = 0; q < 8; ++q) pq[q] = *(const f32x4*)(ss + (size_t)(rowb + (q >> 2) * 128 + (q & 3) * 16) * 16 + 4 * fq);
#pragma unroll
      for (int q = 0; q < 8; ++q) { float t = (pq[q][0] + pq[q][1]) + (pq[q][2] + pq[q][3]); t += __shfl_xor(t, 16); t += __shfl_xor(t, 32); rsv[q] = rsqrtf(t * (1.0f / 1024.0f) + EPS); }
    }
    if (mode == M_SWIGLU) {
#pragma unroll
      for (int ai = 0; ai < 2; ++ai)
#pragma unroll
        for (int m = 0; m < 4; ++m) {
          const int row = rowb + ai * 128 + m * 16;
          const float rs = rsv[ai * 4 + m];
          float h[8];
#pragma unroll
          for (int n = 0; n < 2; ++n)
#pragma unroll
            for (int j = 0; j < 4; ++j) { const float a = acc[ai][0][m][n][j] * rs, b = acc[ai][1][m][n][j] * rs; h[n * 4 + j] = a * sigm(a) * b; }
          u32x4 w; w.x = pk2(h[0], h[1]); w.y = pk2(h[2], h[3]); w.z = pk2(h[4], h[5]); w.w = pk2(h[6], h[7]);
          *(u32x4*)(ob + (size_t)row * FF + u.pn * 128 + wc * 32 + fq * 8) = w;
        }
    } else if (mode == M_BF16S) {
      int pn = u.pn; bf16_t* base = ob;
      if (split_tiles) { const int t = pn / split_tiles; base += (size_t)t * split_stride; pn -= t * split_tiles; }
      const bool iskk = (unsigned)(u.pn - kk_lo) < 8u;
      const int act = sig ? 1 : (u.pn < silu_tiles ? 2 : (iskk ? 3 : 0));
      if (act == 0) {
#pragma unroll
        for (int ai = 0; ai < 2; ++ai)
#pragma unroll
          for (int m = 0; m < 4; ++m) {
            const int row = rowb + ai * 128 + m * 16;
            const float rs = rsv[ai * 4 + m];
#pragma unroll
            for (int bj = 0; bj < 2; ++bj) {
              const f32x4 a0 = acc[ai][bj][m][0] * rs, a1 = acc[ai][bj][m][1] * rs;
              u32x4 w; w.x = pk2(a0[0], a0[1]); w.y = pk2(a0[2], a0[3]); w.z = pk2(a1[0], a1[1]); w.w = pk2(a1[2], a1[3]);
              *(u32x4*)(base + (size_t)row * ldo + pn * 256 + bj * 128 + wc * 32 + fq * 8) = w;
            }
          }
      } else {
#pragma unroll
        for (int ai = 0; ai < 2; ++ai)
#pragma unroll
          for (int m = 0; m < 4; ++m) {
            const int row = rowb + ai * 128 + m * 16;
            const float rs = rsv[ai * 4 + m];
#pragma unroll
            for (int bj = 0; bj < 2; ++bj) {
              float v[8];
              f32x4 lbA = {0.f, 0.f, 0.f, 0.f}, lbB = {0.f, 0.f, 0.f, 0.f};
              if (act == 3) { const float* lq = lbp + (u.pn - kk_lo) * 256 + bj * 128 + wc * 32 + fq * 8; lbA = *(const f32x4*)lq; lbB = *(const f32x4*)(lq + 4); }
#pragma unroll
              for (int n = 0; n < 2; ++n)
#pragma unroll
                for (int j = 0; j < 4; ++j) { const float x = acc[ai][bj][m][n][j] * rs; const float sg1 = sigm(x); const float lb = n ? lbB[j] : lbA[j];
                  v[n * 4 + j] = act == 1 ? sg1 : (act == 2 ? x * sg1 : (1.0f - lb) * (1.0f - sg1)); }
              u32x4 w; w.x = pk2(v[0], v[1]); w.y = pk2(v[2], v[3]); w.z = pk2(v[4], v[5]); w.w = pk2(v[6], v[7]);
              *(u32x4*)(base + (size_t)row * ldo + pn * 256 + bj * 128 + wc * 32 + fq * 8) = w;
            }
          }
      }
    } else if (mode == M_RESID) {
      const int cb = u.pn * 256 + wc * 32 + fq * 4;
#define RES_ROW(q) (rowb + ((q) >> 2) * 128 + ((q) & 3) * 16)
#define RES_PTR(q) ((RES_ROW(q) < TP) ? r0 + (size_t)RES_ROW(q) * D : r1 + (size_t)(RES_ROW(q) - TP) * D)
#define RES_TAIL(OV) do { \
          if (of) *(f32x4*)(of + (size_t)row * D + c0) = (OV); \
          if (ob) { u32x2 w; w.x = pk2((OV)[0], (OV)[1]); w.y = pk2((OV)[2], (OV)[3]); *(u32x2*)(ob + (size_t)row * D + c0) = w; } \
          s2 += ((OV)[0] * (OV)[0] + (OV)[1] * (OV)[1]) + ((OV)[2] * (OV)[2] + (OV)[3] * (OV)[3]); } while (0)
      if (r0) {
        f32x4 rc[4], rn[4];
        { const float* rp = RES_PTR(0);
#pragma unroll
          for (int e = 0; e < 4; ++e) rc[e] = *(const f32x4*)(rp + cb + (e >> 1) * 128 + (e & 1) * 16); }
#pragma unroll
        for (int q = 0; q < 8; ++q) {
          const int ai = q >> 2, m = q & 3, row = RES_ROW(q);
          if (q < 7) { const float* rp = RES_PTR(q + 1);
#pragma unroll
            for (int e = 0; e < 4; ++e) rn[e] = *(const f32x4*)(rp + cb + (e >> 1) * 128 + (e & 1) * 16); }
          float s2 = 0.f;
#pragma unroll
          for (int e = 0; e < 4; ++e) { const int bj = e >> 1, n = e & 1, c0 = cb + bj * 128 + n * 16; const f32x4 o = rc[e] + alpha * acc[ai][bj][m][n]; RES_TAIL(o); }
          s2 += __shfl_xor(s2, 16); s2 += __shfl_xor(s2, 32);
          if (fq == 0) ss_out[(size_t)row * 16 + u.pn * 4 + wc] = s2;
          asm volatile("" ::: "memory");
#pragma unroll
          for (int e = 0; e < 4; ++e) rc[e] = rn[e];
        }
      } else {
        u32x2 rc[4], rn[4];
#pragma unroll
        for (int e = 0; e < 4; ++e) rc[e] = *(const u32x2*)(sg + (size_t)RES_ROW(0) * D + cb + (e >> 1) * 128 + (e & 1) * 16);
#pragma unroll
        for (int q = 0; q < 8; ++q) {
          const int ai = q >> 2, m = q & 3, row = RES_ROW(q);
          if (q < 7) {
#pragma unroll
            for (int e = 0; e < 4; ++e) rn[e] = *(const u32x2*)(sg + (size_t)RES_ROW(q + 1) * D + cb + (e >> 1) * 128 + (e & 1) * 16); }
          float s2 = 0.f;
#pragma unroll
          for (int e = 0; e < 4; ++e) { const int bj = e >> 1, n = e & 1, c0 = cb + bj * 128 + n * 16;
            f32x4 r; r[0] = bflo(rc[e].x); r[1] = bfhi(rc[e].x); r[2] = bflo(rc[e].y); r[3] = bfhi(rc[e].y);
            const f32x4 o = r + alpha * acc[ai][bj][m][n]; RES_TAIL(o); }
          s2 += __shfl_xor(s2, 16); s2 += __shfl_xor(s2, 32);
          if (fq == 0) ss_out[(size_t)row * 16 + u.pn * 4 + wc] = s2;
          asm volatile("" ::: "memory");
#pragma unroll
          for (int e = 0; e < 4; ++e) rc[e] = rn[e];
        }
      }
#undef RES_TAIL
#undef RES_ROW
#undef RES_PTR
    } else {
      u32x2 gc[4], gn[4]; f32x4 tc[4], tn[4];
      const int cb = u.pn * 256 + wc * 32 + fq * 4;
      const bool fma = mode == M_FMA;
#pragma unroll
      for (int e = 0; e < 4; ++e) { const size_t o0 = (size_t)rowb * D + cb + (e >> 1) * 128 + (e & 1) * 16; gc[e] = *(const u32x2*)(sg + o0); if (fma) tc[e] = *(const f32x4*)(tmp + o0); }
#pragma unroll
      for (int q = 0; q < 8; ++q) {
        const int ai = q >> 2, m = q & 3, row = rowb + ai * 128 + m * 16;
        if (q < 7) { const int rown = rowb + ((q + 1) >> 2) * 128 + ((q + 1) & 3) * 16;
#pragma unroll
          for (int e = 0; e < 4; ++e) { const size_t o0 = (size_t)rown * D + cb + (e >> 1) * 128 + (e & 1) * 16; gn[e] = *(const u32x2*)(sg + o0); if (fma) tn[e] = *(const f32x4*)(tmp + o0); } }
#pragma unroll
        for (int e = 0; e < 4; ++e) {
          const int bj = e >> 1, n = e & 1; const size_t o0 = (size_t)row * D + cb + bj * 128 + n * 16;
          f32x4 gv; gv[0] = bflo(gc[e].x); gv[1] = bfhi(gc[e].x); gv[2] = bflo(gc[e].y); gv[3] = bfhi(gc[e].y);
          if (!fma) { *(f32x4*)(of + o0) = gv * acc[ai][bj][m][n]; }
          else { const f32x4 o = tc[e] + gv * acc[ai][bj][m][n]; u32x2 w; w.x = pk2(o[0], o[1]); w.y = pk2(o[2], o[3]); *(u32x2*)(ob + o0) = w; }
        }
        asm volatile("" ::: "memory");
#pragma unroll
        for (int e = 0; e < 4; ++e) { gc[e] = gn[e]; if (fma) tc[e] = tn[e]; }
      }
    }
  }
};

constexpr size_t SZ_WGU = (size_t)2 * FF * D * 2, SZ_WD = (size_t)D * FF * 2, SZ_WIN = (size_t)NIN * D * 2;
constexpr size_t OFF_WGU1 = 0, OFF_WD1 = OFF_WGU1 + SZ_WGU, OFF_WGU2 = OFF_WD1 + SZ_WD, OFF_WD2 = OFF_WGU2 + SZ_WGU, OFF_WIN = OFF_WD2 + SZ_WD;
constexpr size_t OFF_WA = OFF_WIN + SZ_WIN, OFF_WB = OFF_WA + (size_t)D * 512 * 2, OFF_WO = OFF_WB + (size_t)D * D * 2, OFF_XB = OFF_WO + (size_t)D * D * 2;
constexpr size_t OFF_SS = OFF_XB + (size_t)T * D * 2, OFF_CTR = OFF_SS + (size_t)4 * T * 16 * 4, OFF_BAR = OFF_CTR + 256, OFF_LB = OFF_BAR + (size_t)3456 * 4, OFF_BIG = OFF_LB + 8192;
constexpr size_t B_ACT = 0, B_PROJH = 0, B_OFB = (size_t)T * 4096 * 2, B_HG = 0, B_YB = (size_t)T * D * 2, B_QKV = B_YB + (size_t)T * D * 2;
constexpr size_t B_OG = B_QKV + (size_t)THALF * 4608 * 2, B_LSE = B_OG + (size_t)3 * T * 512 * 2, B_YA = 0, B_SGA = B_QKV, B_SGB = B_SGA + (size_t)T * D * 2, B_TMP = B_SGB + (size_t)T * D * 2;
constexpr size_t WS_NEED = OFF_BIG + B_TMP + (size_t)T * D * 4;

struct PhaseDesc { int type, M, N, K; const bf16_t* A; const bf16_t* Bt; EpiP e; };
struct Params {
  const float* in[17];
  float* out; unsigned char* ws;
  PhaseDesc ph[18];
};

enum { MAP_NAT = 0, MAP_P32 = 1, MAP_GU = 2 };
DI int srccol(int map, int np) {
  if (map == MAP_NAT) return np;
  if (map == MAP_P32) return (np & ~31) + pg8::perm32(np & 31);
  const int pn = np >> 8, w = np & 255, bj = w >> 7, wc = (w & 127) >> 5, n = (w & 31) >> 4, fq = (w & 15) >> 2, j = w & 3;
  return bj * FF + 128 * pn + 32 * wc + 8 * fq + 4 * n + j;
}
DI void transpose_item(const float* W, int K, int Nsrc, const float* gain, bf16_t* WT, int map, float* scr, int item, int nblk, int lane) {
  const int kb = item / nblk, nb = item % nblk, k0 = 64 * kb, n0 = 32 * nb;
  const int sc = srccol(map, n0 + (lane & 31));
#pragma unroll 8
  for (int i = 0; i < 32; ++i) { const int kk = 2 * i + (lane >> 5); scr[kk * 33 + (lane & 31)] = W[(size_t)(k0 + kk) * Nsrc + sc]; }
  asm volatile("s_waitcnt lgkmcnt(0)" ::: "memory");
  const int c = lane & 7;
  float g8[8];
#pragma unroll
  for (int e = 0; e < 8; ++e) g8[e] = gain ? gain[k0 + 8 * c + e] : 1.0f;
#pragma unroll
  for (int j = 0; j < 4; ++j) {
    const int n = (lane >> 3) + 8 * j; const float* s = scr + (8 * c) * 33 + n;
    u32x4 o; o.x = pk2(s[0 * 33] * g8[0], s[1 * 33] * g8[1]); o.y = pk2(s[2 * 33] * g8[2], s[3 * 33] * g8[3]);
    o.z = pk2(s[4 * 33] * g8[4], s[5 * 33] * g8[5]); o.w = pk2(s[6 * 33] * g8[6], s[7 * 33] * g8[7]);
    *(u32x4*)(WT + (size_t)(n0 + n) * K + k0 + 8 * c) = o;
  }
  asm volatile("s_waitcnt lgkmcnt(0)" ::: "memory");
}

DI void prep_phase(const Params& p, unsigned char* shm) {
  const int tid = opq_tid(), wid = tid >> 6, lane = tid & 63;
  const int bid = opq_bid(); const int gw = bid * 8 + wid, NGW = gridDim.x * 8;
  unsigned char* ws = p.ws;
  if (bid == 1) { float* lbv = (float*)(ws + OFF_LB);
    for (int i = tid; i < 2048; i += 512) { const float* lw = i < 1024 ? p.in[7] : p.in[8]; const int k = i & 1023; lbv[i] = 1.0f / (1.0f + __expf(lw[D + k] - lw[k])); } }
  { float* ss0 = (float*)(ws + OFF_SS); bf16_t* xb = (bf16_t*)(ws + OFF_XB);
    for (int rb = gw; rb < T; rb += 4 * NGW) {
      f32x4 v[4][4];
#pragma unroll
      for (int k = 0; k < 4; ++k) { const int row = rb + k * NGW; if (row < T) { const float* xr = row < TP ? p.in[0] + (size_t)row * D : p.in[1] + (size_t)(row - TP) * D;
#pragma unroll
          for (int j = 0; j < 4; ++j) v[k][j] = *(const f32x4*)(xr + 4 * lane + 256 * j); } }
#pragma unroll
      for (int k = 0; k < 4; ++k) { const int row = rb + k * NGW; if (row < T) { float s = 0.f;
#pragma unroll
          for (int j = 0; j < 4; ++j) s += (v[k][j][0] * v[k][j][0] + v[k][j][1] * v[k][j][1]) + (v[k][j][2] * v[k][j][2] + v[k][j][3] * v[k][j][3]);
          s = wave_sum(s);
          if (lane < 16) ss0[(size_t)row * 16 + lane] = lane == 0 ? s : 0.f;
#pragma unroll
          for (int j = 0; j < 4; ++j) { u32x2 w; w.x = pk2(v[k][j][0], v[k][j][1]); w.y = pk2(v[k][j][2], v[k][j][3]); *(u32x2*)(xb + (size_t)row * D + 4 * lane + 256 * j) = w; } } }
    } }
  float* scr = (float*)(shm + wid * 8704);
  for (int wsel = 0; wsel < 8; ++wsel) {
    const float* W; const float* gain = nullptr; bf16_t* WT; int K, Nsrc, Nd, map;
    switch (wsel) {
      case 0: W = p.in[3]; gain = p.in[2]; WT = (bf16_t*)(ws + OFF_WGU1); K = D; Nsrc = 2 * FF; Nd = 2 * FF; map = MAP_GU; break;
      case 1: W = p.in[4]; WT = (bf16_t*)(ws + OFF_WD1); K = FF; Nsrc = D; Nd = D; map = MAP_NAT; break;
      case 2: W = p.in[6]; gain = p.in[5]; WT = (bf16_t*)(ws + OFF_WIN); K = D; Nsrc = NIN; Nd = NIN; map = MAP_P32; break;
      case 3: W = p.in[10]; WT = (bf16_t*)(ws + OFF_WA); K = 512; Nsrc = D; Nd = D; map = MAP_NAT; break;
      case 4: W = p.in[11]; WT = (bf16_t*)(ws + OFF_WB); K = D; Nsrc = D; Nd = D; map = MAP_NAT; break;
      case 5: W = p.in[12]; WT = (bf16_t*)(ws + OFF_WO); K = D; Nsrc = D; Nd = D; map = MAP_NAT; break;
      case 6: W = p.in[14]; gain = p.in[13]; WT = (bf16_t*)(ws + OFF_WGU2); K = D; Nsrc = 2 * FF; Nd = 2 * FF; map = MAP_GU; break;
      default: W = p.in[15]; WT = (bf16_t*)(ws + OFF_WD2); K = FF; Nsrc = D; Nd = D; map = MAP_NAT; break;
    }
    const int nblk = Nd / 32, nitems = (K / 64) * nblk;
    for (int it = gw; it < nitems; it += NGW) transpose_item(W, K, Nsrc, gain, WT, map, scr, it, nblk, lane);
  }
}

DI void hgrn_naive_phase(const Params& p, unsigned char* shm) {
  const int chain = opq_bid();
  if (chain >= 128) return;
  const int tid = opq_tid(), wid = tid >> 6, lane = tid & 63;
  const int seq = chain >> 4, head = (chain >> 1) & 7, dir = chain & 1;
  const int slen = seq < 4 ? 4096 : 8192, row0 = seq < 4 ? seq * 4096 : TP + (seq - 4) * 8192;
  const bf16_t* pj = (const bf16_t*)(p.ws + OFF_BIG + B_PROJH);
  bf16_t* od = (bf16_t*)(p.ws + OFF_BIG + B_OFB) + (size_t)dir * T * D;
  const float* lbw = dir ? p.in[8] : p.in[7];
  float* gq = (float*)shm; float* gf = gq + 2048; float* gk = gf + 2048; float* gv = gk + 2048;
  const int vl = lane & 15, kq = lane >> 4, v = 16 * wid + vl;
  float S[32];
#pragma unroll
  for (int i = 0; i < 32; ++i) S[i] = 0.f;
  const int fk = tid & 127;
  const float lb = 1.0f / (1.0f + __expf(lbw[D + head * 128 + fk] - lbw[head * 128 + fk]));
  for (int i0 = 0; i0 < slen; i0 += 16) {
    __syncthreads();
#pragma unroll
    for (int r = 0; r < 4; ++r) {
      const int tt = (tid >> 7) + 4 * r; const int t = dir ? slen - 1 - (i0 + tt) : i0 + tt; const size_t rb = (size_t)(row0 + t) * 4096 + head * 128 + fk;
      const float hq = bf1(pj[rb]), hf = bf1(pj[rb + 1024 * (1 + dir)]), hi = bf1(pj[rb + 3072]);
      const float s = sigm(hf);
      gq[tt * 128 + fk] = hq * sigm(hq); gf[tt * 128 + fk] = lb + (1.0f - lb) * s; gk[tt * 128 + fk] = (1.0f - lb) * (1.0f - s); gv[tt * 128 + fk] = hi;
    }
    __syncthreads();
    for (int tt = 0; tt < 16; ++tt) {
      const float val = gv[tt * 128 + v]; float o = 0.f;
#pragma unroll
      for (int k4 = 0; k4 < 8; ++k4) {
        const f32x4 f4 = *(const f32x4*)(gf + tt * 128 + 32 * kq + 4 * k4), k4v = *(const f32x4*)(gk + tt * 128 + 32 * kq + 4 * k4), q4 = *(const f32x4*)(gq + tt * 128 + 32 * kq + 4 * k4);
#pragma unroll
        for (int e = 0; e < 4; ++e) { S[4 * k4 + e] = f4[e] * S[4 * k4 + e] + k4v[e] * val; o += q4[e] * S[4 * k4 + e]; }
      }
      o += __shfl_xor(o, 16); o += __shfl_xor(o, 32);
      const int t = dir ? slen - 1 - (i0 + tt) : i0 + tt;
      if (kq == 0) od[(size_t)(row0 + t) * D + head * 128 + v] = (bf16_t)(pk2(o, 0.f) & 0xffffu);
    }
  }
}

DI void combine_phase(const Params& p) {
  const int tid = opq_tid(), wid = tid >> 6, lane = tid & 63;
  const int bid = opq_bid(); const int gw = bid * 8 + wid, NGW = gridDim.x * 8;
  const bf16_t* oF = (const bf16_t*)(p.ws + OFF_BIG + B_OFB); const bf16_t* oB = oF + (size_t)T * D;
  const bf16_t* hg = (const bf16_t*)(p.ws + OFF_BIG + B_HG); bf16_t* yb = (bf16_t*)(p.ws + OFF_BIG + B_YB);
  const float* ng = p.in[9];
  const int c0 = lane * 16;
  float g[16];
#pragma unroll
  for (int i = 0; i < 16; ++i) g[i] = ng[c0 + i];
  for (int rb = gw; rb < T; rb += 3 * NGW) {
    u32x4 fa[3][2], fb[3][2], fg[3][2];
#pragma unroll
    for (int k = 0; k < 3; ++k) { const int row = rb + k * NGW; if (row < T) { const size_t b = (size_t)row * D + c0;
#pragma unroll
        for (int h = 0; h < 2; ++h) { fa[k][h] = *(const u32x4*)(oF + b + 8 * h); fb[k][h] = *(const u32x4*)(oB + b + 8 * h); fg[k][h] = *(const u32x4*)(hg + b + 8 * h); } } }
#pragma unroll
    for (int k = 0; k < 3; ++k) { const int row = rb + k * NGW; if (row < T) { const size_t b = (size_t)row * D + c0;
        float o[16]; float s = 0.f;
#pragma unroll
        for (int h = 0; h < 2; ++h)
#pragma unroll
          for (int e = 0; e < 4; ++e) { o[8 * h + 2 * e] = bflo(fa[k][h][e]) + bflo(fb[k][h][e]); o[8 * h + 2 * e + 1] = bfhi(fa[k][h][e]) + bfhi(fb[k][h][e]); }
#pragma unroll
        for (int i = 0; i < 16; ++i) s += o[i] * o[i];
        s += __shfl_xor(s, 1); s += __shfl_xor(s, 2); s += __shfl_xor(s, 4);
        const float rs = rsqrtf(s * (1.0f / 128.0f) + EPS);
#pragma unroll
        for (int h = 0; h < 2; ++h) { u32x4 w;
#pragma unroll
          for (int e = 0; e < 4; ++e) { const float g0 = bflo(fg[k][h][e]), g1 = bfhi(fg[k][h][e]);
            w[e] = pk2(o[8 * h + 2 * e] * rs * g[8 * h + 2 * e] * g0 * sigm(g0), o[8 * h + 2 * e + 1] * rs * g[8 * h + 2 * e + 1] * g1 * sigm(g1)); }
          *(u32x4*)(yb + b + 8 * h) = w; } } }
  }
}

DI void attn_naive_phase(const Params& p, int half) {
  const int tid = opq_tid(), wid = tid >> 6, lane = tid & 63;
  const int bid = opq_bid(); const int gw = bid * 8 + wid, NGW = gridDim.x * 8;
  const int row_base = half * THALF;
  const bf16_t* base = (const bf16_t*)(p.ws + OFF_BIG + B_QKV) - (size_t)row_base * 4608;
  bf16_t* ya = (bf16_t*)(p.ws + OFF_BIG + B_YA);
  for (int unit = gw; unit < THALF * 8; unit += NGW) {
    const int row = row_base + (unit >> 3), j = unit & 7;
    int s0, slen; if (row < TP) { s0 = row & ~4095; slen = 4096; } else { s0 = TP + ((row - TP) & ~8191); slen = 8192; }
    const int t = row - s0;
    const float slope = exp2f(-(float)(j + 1));
    float sc[3][3];
#pragma unroll
    for (int g = 0; g < 3; ++g) {
      const int d = g == 0 ? 1 : (g == 1 ? 4 : 16);
      u32x4 qv[8];
      { const u32x4* qp = (const u32x4*)(base + (size_t)row * 4608 + g * 512 + j * 64);
#pragma unroll
        for (int i = 0; i < 8; ++i) qv[i] = qp[i]; }
#pragma unroll
      for (int r = 0; r < 3; ++r) {
        const int joff = lane + 64 * r - 64; const int pos = t + d * joff;
        const bool valid = (r < 2 || lane == 0) && pos >= 0 && pos < slen;
        float s = -1e30f;
        if (valid) {
          const u32x4* kp = (const u32x4*)(base + (size_t)(s0 + pos) * 4608 + 1536 + g * 512 + j * 64);
          float dot = 0.f;
#pragma unroll
          for (int i = 0; i < 8; ++i) { const u32x4 kv = kp[i];
#pragma unroll
            for (int e = 0; e < 4; ++e) dot += bflo(kv[e]) * bflo(qv[i][e]) + bfhi(kv[e]) * bfhi(qv[i][e]); }
          s = dot * 0.125f - slope * (float)(d * (joff < 0 ? -joff : joff));
        }
        sc[g][r] = s;
      }
    }
    float m = -1e30f;
#pragma unroll
    for (int g = 0; g < 3; ++g)
#pragma unroll
      for (int r = 0; r < 3; ++r) m = fmaxf(m, sc[g][r]);
    m = wave_max(m);
    float l = 0.f;
#pragma unroll
    for (int g = 0; g < 3; ++g)
#pragma unroll
      for (int r = 0; r < 3; ++r) { sc[g][r] = sc[g][r] > -1e29f ? __expf(sc[g][r] - m) : 0.f; l += sc[g][r]; }
    l = wave_sum(l);
    float o = 0.f;
#pragma unroll
    for (int g = 0; g < 3; ++g) {
      const int d = g == 0 ? 1 : (g == 1 ? 4 : 16);
      const bf16_t* vb = base + 3072 + g * 512 + j * 64 + lane;
#pragma unroll
      for (int r = 0; r < 3; ++r) {
        const int ntl = r < 2 ? 64 : 1;
        for (int tl = 0; tl < ntl; ++tl) {
          const float pb = __uint_as_float(__builtin_amdgcn_readlane(__float_as_uint(sc[g][r]), tl));
          if (pb != 0.f) { const int pos = t + d * (tl + 64 * r - 64); o += pb * bf1(vb[(size_t)(s0 + pos) * 4608]); }
        }
      }
    }
    ya[(size_t)row * 512 + j * 64 + lane] = (bf16_t)(pk2(o / l, 0.f) & 0xffffu);
  }
}


typedef float f32x16 __attribute__((ext_vector_type(16)));
typedef short s16x4 __attribute__((ext_vector_type(4)));
DI unsigned pk2c(float a, float b) { f32v2_t v = {a, b}; bf16v2_t r = __builtin_convertvector(v, bf16v2_t); return __builtin_bit_cast(unsigned, r); }
#define MFMA32(a, b, c) __builtin_amdgcn_mfma_f32_32x32x16_bf16((a), (b), (c), 0, 0, 0)
DI int crow(int i, int h) { return (i & 3) + 8 * (i >> 2) + 4 * h; }
DI void tr_read4(unsigned a0, unsigned a1, unsigned a2, unsigned a3, s16x4& r0, s16x4& r1, s16x4& r2, s16x4& r3) {
  asm volatile("ds_read_b64_tr_b16 %0, %4\n\tds_read_b64_tr_b16 %1, %5\n\tds_read_b64_tr_b16 %2, %6\n\tds_read_b64_tr_b16 %3, %7\n\ts_waitcnt lgkmcnt(0)"
               : "=&v"(r0), "=&v"(r1), "=&v"(r2), "=&v"(r3) : "v"(a0), "v"(a1), "v"(a2), "v"(a3) : "memory");
}
constexpr int AROW = 144;
constexpr int AV_OFF = 384 * AROW;

struct AUnit { int g, j, d, r, c, L, lrow0, ki0; size_t colq; };
DI AUnit attn_decode(int unit, int half) {
  AUnit a; a.g = unit / 768; const int rem = unit % 768; a.j = rem & 7; const int cidx = rem >> 3;
  a.d = a.g == 0 ? 1 : (a.g == 1 ? 4 : 16);
  int seq_row0, S, w;
  if (half == 0) { if (cidx < 64) { seq_row0 = (cidx >> 4) * 4096; S = 4096; w = cidx & 15; } else { seq_row0 = TP; S = 8192; w = cidx - 64; } }
  else { seq_row0 = TP + (1 + (cidx >> 5)) * 8192; S = 8192; w = cidx & 31; }
  a.r = w % a.d; a.c = w / a.d; a.L = S / a.d; a.lrow0 = seq_row0 - half * THALF; a.ki0 = 256 * a.c - 64; a.colq = (size_t)a.g * 512 + a.j * 64;
  return a;
}
DI void attn_phase(const Params& p, int half, unsigned char* shm) {
  const int tid = opq_tid(), wid = tid >> 6, lane = tid & 63, bid = opq_bid();
  const int q32 = lane & 31, h = lane >> 5;
  const bf16_t* qkv = (const bf16_t*)(p.ws + OFF_BIG + B_QKV);
  bf16_t* og = (bf16_t*)(p.ws + OFF_BIG + B_OG);
  float* ml = (float*)(p.ws + OFF_BIG + B_LSE);
  const unsigned lbase = (unsigned)(size_t)(PG8_LAS unsigned char*)shm;
  u32x4 kreg[6], vreg[6];
#define AT_FETCH(UU) do { const AUnit f = attn_decode((UU), half); \
    _Pragma("unroll") for (int it = 0; it < 6; ++it) { const int idx = tid + 512 * it, slot = idx >> 3, ch = idx & 7, ki = f.ki0 + slot; \
      u32x4 kv = {0u, 0u, 0u, 0u}, vv = {0u, 0u, 0u, 0u}; \
      if (ki >= 0 && ki < f.L) { const bf16_t* rp = qkv + (size_t)(f.lrow0 + f.r + f.d * ki) * 4608 + f.colq + ch * 8; kv = *(const u32x4*)(rp + 1536); vv = *(const u32x4*)(rp + 3072); } \
      kreg[it] = kv; vreg[it] = vv; } \
    } while (0)
  if (bid < 2304) AT_FETCH(bid);
  for (int unit = bid; unit < 2304; unit += (int)gridDim.x) {
    const AUnit a = attn_decode(unit, half);
    const int g = a.g, j = a.j, d = a.d, r = a.r, c = a.c, L = a.L, lrow0 = a.lrow0, ki0 = a.ki0;
    pg8::bf16x8 qf[4];
    { const bf16_t* qp = qkv + (size_t)(lrow0 + r + d * (256 * c + 32 * wid + q32)) * 4608 + a.colq + 8 * h;
#pragma unroll
      for (int ks = 0; ks < 4; ++ks) qf[ks] = *(const pg8::bf16x8*)(qp + 16 * ks); }
    LDS_BARRIER();
#pragma unroll
    for (int it = 0; it < 6; ++it) {
      const int idx = tid + 512 * it, slot = idx >> 3, ch = idx & 7;
      *(u32x4*)(shm + slot * AROW + ch * 16) = kreg[it]; *(u32x4*)(shm + AV_OFF + slot * AROW + ch * 16) = vreg[it];
    }
    LDS_BARRIER();
    if (unit + (int)gridDim.x < 2304) AT_FETCH(unit + (int)gridDim.x);
    f32x16 st[5];
#pragma unroll
    for (int kt = 0; kt < 5; ++kt) {
#pragma unroll
      for (int i = 0; i < 16; ++i) st[kt][i] = 0.f;
#pragma unroll
      for (int ks = 0; ks < 4; ++ks) {
        const pg8::bf16x8 kf = *(const pg8::bf16x8*)(shm + (32 * wid + 32 * kt + q32) * AROW + (16 * ks + 8 * h) * 2);
        st[kt] = MFMA32(kf, qf[ks], st[kt]);
      }
    }
    const float slope_d = exp2f(-(float)(j + 1)) * (float)d;
    int hu = h, qu = q32; asm volatile("" : "+v"(hu), "+v"(qu));
    float m = -1e30f;
#pragma unroll
    for (int kt = 0; kt < 5; ++kt)
#pragma unroll
      for (int i = 0; i < 16; ++i) {
        const int rel = 32 * kt + crow(i, hu) - qu - 64; const int ki = ki0 + 32 * wid + 32 * kt + crow(i, hu);
        const int arel = rel < 0 ? -rel : rel;
        const bool valid = arel <= 64 && ki >= 0 && ki < L;
        const float s = valid ? st[kt][i] * 0.125f - slope_d * (float)arel : -1e30f;
        st[kt][i] = s; m = fmaxf(m, s);
      }
    m = fmaxf(m, __shfl_xor(m, 32));
    float l = 0.f;
#pragma unroll
    for (int kt = 0; kt < 5; ++kt)
#pragma unroll
      for (int i = 0; i < 16; ++i) { const float s = st[kt][i]; const float e = s > -1e29f ? __expf(s - m) : 0.f; st[kt][i] = e; l += e; }
    l += __shfl_xor(l, 32);
    f32x16 o[2];
#pragma unroll
    for (int et = 0; et < 2; ++et)
#pragma unroll
      for (int i = 0; i < 16; ++i) o[et][i] = 0.f;
    const int i16 = lane & 15, q4 = i16 >> 2, p4 = i16 & 3, blk = (lane >> 4) & 1;
    const unsigned vaddr0 = lbase + AV_OFF + (32 * wid + 4 * h + q4) * AROW + 32 * blk + 8 * p4;
#pragma unroll
    for (int kt = 0; kt < 5; ++kt)
#pragma unroll
      for (int s2 = 0; s2 < 2; ++s2) {
        u32x4 pw; pw.x = pk2c(st[kt][8 * s2 + 0], st[kt][8 * s2 + 1]); pw.y = pk2c(st[kt][8 * s2 + 2], st[kt][8 * s2 + 3]);
        pw.z = pk2c(st[kt][8 * s2 + 4], st[kt][8 * s2 + 5]); pw.w = pk2c(st[kt][8 * s2 + 6], st[kt][8 * s2 + 7]);
        const pg8::bf16x8 pa = __builtin_bit_cast(pg8::bf16x8, pw);
        const unsigned a = vaddr0 + (32 * kt + 16 * s2) * AROW;
        s16x4 lo0, hi0, lo1, hi1;
        tr_read4(a, a + 8 * AROW, a + 64, a + 8 * AROW + 64, lo0, hi0, lo1, hi1);
        const pg8::bf16x8 v0 = __builtin_shufflevector(lo0, hi0, 0, 1, 2, 3, 4, 5, 6, 7), v1 = __builtin_shufflevector(lo1, hi1, 0, 1, 2, 3, 4, 5, 6, 7);
        o[0] = MFMA32(pa, v0, o[0]); o[1] = MFMA32(pa, v1, o[1]);
      }
    const int rowq0 = half * THALF + lrow0 + r + d * (256 * c + 32 * wid);
#pragma unroll
    for (int et = 0; et < 2; ++et)
#pragma unroll
      for (int i = 0; i < 16; ++i) {
        const int row = rowq0 + d * crow(i, h);
        og[((size_t)g * T + row) * 512 + j * 64 + 32 * et + q32] = (bf16_t)(pk2c(o[et][i], 0.f) & 0xffffu);
      }
    if (h == 0) { const int row = rowq0 + d * q32; f32v2_t v = {m, l}; *(f32v2_t*)(ml + (((size_t)g * T + row) * 8 + j) * 2) = v; }
  }
#undef AT_FETCH
}


DI void tr_read2(unsigned a0, unsigned a1, s16x4& r0, s16x4& r1) {
  asm volatile("ds_read_b64_tr_b16 %0, %2\n\tds_read_b64_tr_b16 %1, %3\n\ts_waitcnt lgkmcnt(0)" : "=&v"(r0), "=&v"(r1) : "v"(a0), "v"(a1) : "memory");
}
constexpr int HP = 272;
constexpr int H_QT = 0, H_KT = 64 * HP, H_KE = 2 * 64 * HP, H_VV = 3 * 64 * HP, H_DEC = H_VV + 64 * AROW, H_BUF = H_DEC + 512, H_ST = 2 * H_BUF, H_GG = H_ST + 2 * 64 * HP;
DI void hgrn_phase(const Params& p, unsigned char* shm) {
  const int chain = opq_bid();
  if (chain >= 256) return;
  const int tid = opq_tid(), wid = tid >> 6, lane = tid & 63;
  const int vh = chain & 1, dir = (chain >> 1) & 1, head = (chain >> 2) & 7, seq = chain >> 5;
  const int slen = seq < 4 ? 4096 : 8192, row0 = seq < 4 ? seq * 4096 : TP + (seq - 4) * 8192, nchunks = slen >> 6;
  const bf16_t* pj = (const bf16_t*)(p.ws + OFF_BIG + B_PROJH);
  bf16_t* od = (bf16_t*)(p.ws + OFF_BIG + B_OFB) + (size_t)dir * T * D;
  const float* lbw = dir ? p.in[8] : p.in[7];
  const unsigned lbase = (unsigned)(size_t)(PG8_LAS unsigned char*)shm;
  const int rg = wid, c2 = 2 * lane;
  __syncthreads();
  for (int i = tid; i < 2 * 64 * HP / 4; i += 512) ((unsigned*)(shm + H_ST))[i] = 0u;
  f32x16 Sacc[2];
#pragma unroll
  for (int b = 0; b < 2; ++b)
#pragma unroll
    for (int i = 0; i < 16; ++i) Sacc[b][i] = 0.f;
  unsigned rqA[8], rfA[8], rqB[8], rfB[8]; u32x4 rvA, rvB;
#define HG_LOAD(cc, rq, rf, rv) do { _Pragma("unroll") for (int ii = 0; ii < 8; ++ii) { const int il = 64 * (cc) + 8 * rg + ii; const int t = dir ? slen - 1 - il : il; \
      const bf16_t* bp = pj + (size_t)(row0 + t) * 4096 + head * 128 + c2; rq[ii] = *(const unsigned*)bp; rf[ii] = *(const unsigned*)(bp + 1024 * (1 + dir)); } \
    { const int il = 64 * (cc) + (tid >> 3); const int t = dir ? slen - 1 - il : il; rv = *(const u32x4*)(pj + (size_t)(row0 + t) * 4096 + 3072 + head * 128 + vh * 64 + (tid & 7) * 8); } } while (0)
  HG_LOAD(0, rqA, rfA, rvA); HG_LOAD(1, rqB, rfB, rvB);
  auto step = [&](const int c, unsigned (&rq)[8], unsigned (&rf)[8], u32x4& rv) __attribute__((always_inline)) {
    int hu = lane >> 5, qu = lane & 31; asm volatile("" : "+v"(hu), "+v"(qu));
    unsigned char* buf = shm + (c & 1) * H_BUF;
    {
      float k0[8], k1[8], P0[8], P1[8];
      float run0 = 1.f, run1 = 1.f;
#pragma unroll
      for (int ii = 0; ii < 8; ++ii) {
        k0[ii] = bflo(rf[ii]); k1[ii] = bfhi(rf[ii]);
        run0 *= 1.0f - k0[ii]; run1 *= 1.0f - k1[ii];
        P0[ii] = run0; P1[ii] = run1;
      }
      { f32v2_t gg = {run0, run1}; *(f32v2_t*)(shm + H_GG + (wid * 128 + c2) * 4) = gg; }
      *(u32x4*)(buf + H_VV + (tid >> 3) * AROW + (tid & 7) * 16) = rv;
      LDS_BARRIER();
      float pre0 = 1.f, pre1 = 1.f, dec0 = 1.f, dec1 = 1.f;
#pragma unroll
      for (int w2 = 0; w2 < 8; ++w2) { const f32v2_t gg = *(const f32v2_t*)(shm + H_GG + (w2 * 128 + c2) * 4); dec0 *= gg[0]; dec1 *= gg[1]; if (w2 < wid) { pre0 *= gg[0]; pre1 *= gg[1]; } }
#pragma unroll
      for (int ii = 0; ii < 8; ++ii) {
        const float Pa = pre0 * P0[ii], Pb = pre1 * P1[ii];
        const float kta = k0[ii] * __builtin_amdgcn_rcpf(Pa), ktb = k1[ii] * __builtin_amdgcn_rcpf(Pb);
        const int off = (8 * rg + ii) * HP + c2 * 2;
        *(unsigned*)(buf + H_QT + off) = pk2c(bflo(rq[ii]) * Pa, bfhi(rq[ii]) * Pb);
        *(unsigned*)(buf + H_KT + off) = pk2c(kta, ktb);
        *(unsigned*)(buf + H_KE + off) = pk2c(kta * dec0, ktb * dec1);
      }
      if (wid == 0) { f32v2_t dd = {dec0, dec1}; *(f32v2_t*)(buf + H_DEC + c2 * 4) = dd; }
    }
    if (c + 2 < nchunks) HG_LOAD(c + 2, rq, rf, rv);
    LDS_BARRIER();
    const unsigned bbase = lbase + (c & 1) * H_BUF;
    const unsigned char* stc = shm + H_ST + (c & 1) * (64 * HP);
    unsigned char* stn = shm + H_ST + ((c + 1) & 1) * (64 * HP);
    const int i16 = lane & 15, q4 = i16 >> 2, p4 = i16 & 3, blk = (lane >> 4) & 1;
    if (wid < 4) {
      const int tb = wid >> 1, vb = wid & 1;
      pg8::bf16x8 fQ[8], fS[8], fK[8];
#pragma unroll
      for (int ks = 0; ks < 8; ++ks) {
        fQ[ks] = *(const pg8::bf16x8*)(buf + H_QT + (32 * tb + qu) * HP + (16 * ks + 8 * hu) * 2);
        fS[ks] = *(const pg8::bf16x8*)(stc + (32 * vb + qu) * HP + (16 * ks + 8 * hu) * 2);
        fK[ks] = *(const pg8::bf16x8*)(buf + H_KT + qu * HP + (16 * ks + 8 * hu) * 2);
      }
      __builtin_amdgcn_sched_barrier(0);
      f32x16 o, at;
#pragma unroll
      for (int i = 0; i < 16; ++i) { o[i] = 0.f; at[i] = 0.f; }
#pragma unroll
      for (int ks = 0; ks < 8; ++ks) { o = MFMA32(fQ[ks], fS[ks], o); at = MFMA32(fK[ks], fQ[ks], at); }
      if (tb == 1) {
#pragma unroll
        for (int ks = 0; ks < 8; ++ks) fK[ks] = *(const pg8::bf16x8*)(buf + H_KT + (32 + qu) * HP + (16 * ks + 8 * hu) * 2);
      }
      __builtin_amdgcn_sched_barrier(0);
      for (int sb = 0; sb <= tb; ++sb) {
        if (sb == 1) {
#pragma unroll
          for (int i = 0; i < 16; ++i) at[i] = 0.f;
#pragma unroll
          for (int ks = 0; ks < 8; ++ks) at = MFMA32(fK[ks], fQ[ks], at);
        }
        if (sb == tb) {
#pragma unroll
          for (int i = 0; i < 16; ++i) at[i] = crow(i, hu) > qu ? 0.f : at[i];
        }
        u32x4 pw0, pw1;
        pw0.x = pk2c(at[0], at[1]); pw0.y = pk2c(at[2], at[3]); pw0.z = pk2c(at[4], at[5]); pw0.w = pk2c(at[6], at[7]);
        pw1.x = pk2c(at[8], at[9]); pw1.y = pk2c(at[10], at[11]); pw1.z = pk2c(at[12], at[13]); pw1.w = pk2c(at[14], at[15]);
        const unsigned a = bbase + H_VV + (32 * sb + 4 * hu + q4) * AROW + (32 * vb + 16 * blk) * 2 + 8 * p4;
        s16x4 lo0, hi0, lo1, hi1; tr_read4(a, a + 8 * AROW, a + 16 * AROW, a + 24 * AROW, lo0, hi0, lo1, hi1);
        o = MFMA32(__builtin_bit_cast(pg8::bf16x8, pw0), __builtin_shufflevector(lo0, hi0, 0, 1, 2, 3, 4, 5, 6, 7), o);
        o = MFMA32(__builtin_bit_cast(pg8::bf16x8, pw1), __builtin_shufflevector(lo1, hi1, 0, 1, 2, 3, 4, 5, 6, 7), o);
      }
#pragma unroll
      for (int i = 0; i < 16; ++i) {
        const int il = 64 * c + 32 * tb + crow(i, hu); const int t = dir ? slen - 1 - il : il;
        od[(size_t)(row0 + t) * D + head * 128 + vh * 64 + 32 * vb + qu] = (bf16_t)(pk2c(o[i], 0.f) & 0xffffu);
      }
    } else {
      const int kb = wid - 4;
#pragma unroll
      for (int i = 0; i < 16; ++i) { const float dv = *(const float*)(buf + H_DEC + (32 * kb + crow(i, hu)) * 4); Sacc[0][i] *= dv; Sacc[1][i] *= dv; }
      s16x4 tA[4][2], tB[4][4];
      { const unsigned aa = bbase + H_KE + (8 * hu + q4) * HP + (32 * kb + 16 * blk) * 2 + 8 * p4;
        const unsigned ab = bbase + H_VV + (8 * hu + q4) * AROW + (16 * blk) * 2 + 8 * p4;
        static_assert(HP == 272 && AROW == 144, "offsets in the asm string below are literal");
        asm volatile("ds_read_b64_tr_b16 %0, %24 offset:0\n\tds_read_b64_tr_b16 %1, %24 offset:1088\n\tds_read_b64_tr_b16 %2, %25 offset:0\n\tds_read_b64_tr_b16 %3, %25 offset:576\n\tds_read_b64_tr_b16 %4, %25 offset:64\n\tds_read_b64_tr_b16 %5, %25 offset:640\n\tds_read_b64_tr_b16 %6, %24 offset:4352\n\tds_read_b64_tr_b16 %7, %24 offset:5440\n\tds_read_b64_tr_b16 %8, %25 offset:2304\n\tds_read_b64_tr_b16 %9, %25 offset:2880\n\tds_read_b64_tr_b16 %10, %25 offset:2368\n\tds_read_b64_tr_b16 %11, %25 offset:2944\n\tds_read_b64_tr_b16 %12, %24 offset:8704\n\tds_read_b64_tr_b16 %13, %24 offset:9792\n\tds_read_b64_tr_b16 %14, %25 offset:4608\n\tds_read_b64_tr_b16 %15, %25 offset:5184\n\tds_read_b64_tr_b16 %16, %25 offset:4672\n\tds_read_b64_tr_b16 %17, %25 offset:5248\n\tds_read_b64_tr_b16 %18, %24 offset:13056\n\tds_read_b64_tr_b16 %19, %24 offset:14144\n\tds_read_b64_tr_b16 %20, %25 offset:6912\n\tds_read_b64_tr_b16 %21, %25 offset:7488\n\tds_read_b64_tr_b16 %22, %25 offset:6976\n\tds_read_b64_tr_b16 %23, %25 offset:7552\n\ts_waitcnt lgkmcnt(0)"
                     : "=&v"(tA[0][0]), "=&v"(tA[0][1]), "=&v"(tB[0][0]), "=&v"(tB[0][1]), "=&v"(tB[0][2]), "=&v"(tB[0][3]), "=&v"(tA[1][0]), "=&v"(tA[1][1]), "=&v"(tB[1][0]), "=&v"(tB[1][1]), "=&v"(tB[1][2]), "=&v"(tB[1][3]), "=&v"(tA[2][0]), "=&v"(tA[2][1]), "=&v"(tB[2][0]), "=&v"(tB[2][1]), "=&v"(tB[2][2]), "=&v"(tB[2][3]), "=&v"(tA[3][0]), "=&v"(tA[3][1]), "=&v"(tB[3][0]), "=&v"(tB[3][1]), "=&v"(tB[3][2]), "=&v"(tB[3][3])
                     : "v"(aa), "v"(ab) : "memory"); }
#pragma unroll
      for (int s = 0; s < 4; ++s) {
        const pg8::bf16x8 af = __builtin_shufflevector(tA[s][0], tA[s][1], 0, 1, 2, 3, 4, 5, 6, 7);
        Sacc[0] = MFMA32(af, __builtin_shufflevector(tB[s][0], tB[s][1], 0, 1, 2, 3, 4, 5, 6, 7), Sacc[0]);
        Sacc[1] = MFMA32(af, __builtin_shufflevector(tB[s][2], tB[s][3], 0, 1, 2, 3, 4, 5, 6, 7), Sacc[1]);
      }
#pragma unroll
      for (int b = 0; b < 2; ++b)
#pragma unroll
        for (int g4 = 0; g4 < 4; ++g4) {
          u32x2 w; w.x = pk2c(Sacc[b][4 * g4 + 0], Sacc[b][4 * g4 + 1]); w.y = pk2c(Sacc[b][4 * g4 + 2], Sacc[b][4 * g4 + 3]);
          *(u32x2*)(stn + (32 * b + qu) * HP + (32 * kb + 8 * g4 + 4 * hu) * 2) = w;
        }
    }
  };
  for (int c = 0; c < nchunks; c += 2) { step(c, rqA, rfA, rvA); step(c + 1, rqB, rfB, rvB); }
  __syncthreads();
#undef HG_LOAD
}

DI void merge_phase(const Params& p) {
  const int tid = opq_tid(), wid = tid >> 6, lane = tid & 63;
  const int bid = opq_bid(); const int gw = bid * 8 + wid, NGW = gridDim.x * 8;
  const bf16_t* og = (const bf16_t*)(p.ws + OFF_BIG + B_OG); const float* ml = (const float*)(p.ws + OFF_BIG + B_LSE);
  bf16_t* ya = (bf16_t*)(p.ws + OFF_BIG + B_YA);
  const int c0 = lane * 8, j = lane >> 3;
  for (int rb = gw; rb < T; rb += 4 * NGW) {
    u32x4 a[4][3]; f32v2_t mlv[4][3];
#pragma unroll
    for (int k = 0; k < 4; ++k) { const int row = rb + k * NGW; if (row < T) {
#pragma unroll
        for (int g = 0; g < 3; ++g) { mlv[k][g] = *(const f32v2_t*)(ml + (((size_t)g * T + row) * 8 + j) * 2); a[k][g] = *(const u32x4*)(og + ((size_t)g * T + row) * 512 + c0); } } }
#pragma unroll
    for (int k = 0; k < 4; ++k) { const int row = rb + k * NGW; if (row < T) {
        const float M = fmaxf(mlv[k][0][0], fmaxf(mlv[k][1][0], mlv[k][2][0]));
        float acc[8]; float den = 0.f;
#pragma unroll
        for (int e = 0; e < 8; ++e) acc[e] = 0.f;
#pragma unroll
        for (int g = 0; g < 3; ++g) { const float wg = __expf(mlv[k][g][0] - M); den += wg * mlv[k][g][1];
#pragma unroll
          for (int e = 0; e < 4; ++e) { acc[2 * e] += wg * bflo(a[k][g][e]); acc[2 * e + 1] += wg * bfhi(a[k][g][e]); } }
        const float inv = __builtin_amdgcn_rcpf(den);
        u32x4 w; w.x = pk2(acc[0] * inv, acc[1] * inv); w.y = pk2(acc[2] * inv, acc[3] * inv); w.z = pk2(acc[4] * inv, acc[5] * inv); w.w = pk2(acc[6] * inv, acc[7] * inv);
        *(u32x4*)(ya + (size_t)row * 512 + c0) = w; } }
  }
}

DI void final_phase(const Params& p) {
  const int tid = opq_tid(), wid = tid >> 6, lane = tid & 63;
  const int bid = opq_bid(); const int gw = bid * 8 + wid, NGW = gridDim.x * 8;
  const float* ss3 = (const float*)(p.ws + OFF_SS) + (size_t)3 * T * 16; const float* g = p.in[16];
  const bf16_t* xb = (const bf16_t*)(p.ws + OFF_XB);
  f32x4 g4[4];
#pragma unroll
  for (int j = 0; j < 4; ++j) g4[j] = *(const f32x4*)(g + 4 * lane + 256 * j);
  for (int rb = gw; rb < T; rb += 4 * NGW) {
    u32x2 v[4][4]; float sp[4];
#pragma unroll
    for (int k = 0; k < 4; ++k) { const int row = rb + k * NGW; if (row < T) { sp[k] = ss3[(size_t)row * 16 + (lane & 15)];
#pragma unroll
        for (int j = 0; j < 4; ++j) v[k][j] = *(const u32x2*)(xb + (size_t)row * D + 4 * lane + 256 * j); } }
#pragma unroll
    for (int k = 0; k < 4; ++k) { const int row = rb + k * NGW; if (row < T) {
        float t = sp[k]; t += __shfl_xor(t, 1); t += __shfl_xor(t, 2); t += __shfl_xor(t, 4); t += __shfl_xor(t, 8);
        const float rs = rsqrtf(t * (1.0f / 1024.0f) + EPS);
#pragma unroll
        for (int j = 0; j < 4; ++j) { f32x4 x; x[0] = bflo(v[k][j].x); x[1] = bfhi(v[k][j].x); x[2] = bflo(v[k][j].y); x[3] = bfhi(v[k][j].y);
          *(f32x4*)(p.out + (size_t)row * D + 4 * lane + 256 * j) = x * rs * g4[j]; } } }
  }
}

#define XB_TMO      128
#define XB_XCNT(j)  (256  + 64 * (j))
#define XB_XSUB(j)  (1280 + 64 * (j))
#define XB_XGEN(j)  (2304 + 64 * (j))
#define XB_TOP      3328
#define XB_TOPGEN   3392
#define XCD_BAR_WORDS 3456
#define XB_SPIN_CAP (1u << 18)
#define XLAS __attribute__((address_space(3)))

__device__ __forceinline__ unsigned xb_ld(unsigned* p)              { return __hip_atomic_load(p, __ATOMIC_RELAXED, __HIP_MEMORY_SCOPE_AGENT); }
__device__ __forceinline__ unsigned xb_add(unsigned* p, unsigned v) { return __hip_atomic_fetch_add(p, v, __ATOMIC_RELAXED, __HIP_MEMORY_SCOPE_AGENT); }
__device__ __forceinline__ unsigned xb_xcc_id() { return (unsigned)__builtin_amdgcn_s_getreg((3 << 11) | 20) & 0xFu; }
#define XB_SPIN(cond, bar) do { unsigned _sp = 0; while (cond) { __builtin_amdgcn_s_sleep(1); \
    if ((++_sp & 255u) == 0u) { if (xb_ld(&(bar)[XB_TMO])) break; if (_sp > XB_SPIN_CAP) { atomicAdd(&(bar)[XB_TMO], 1u); break; } } } } while (0)

struct XcdBarrier {
    unsigned* bar; unsigned x;
    volatile XLAS unsigned* st;
};

__device__ __forceinline__ XcdBarrier xcd_barrier_post(unsigned* bar, volatile XLAS unsigned* st) {
    XcdBarrier b; b.bar = bar; b.x = xb_xcc_id(); b.st = st;
    if (threadIdx.x == 0) (void)xb_add(&bar[XB_XCNT(b.x)], 1u);
    return b;
}
__device__ __forceinline__ void xcd_barrier_complete(unsigned* bar, unsigned x, unsigned& nloc, unsigned& nx) {
    const unsigned G = gridDim.x * gridDim.y * gridDim.z;
    unsigned sum, cnt, mine, sp = 0u;
    for (;;) {
        sum = 0u; cnt = 0u; mine = 0u;
#pragma unroll
        for (unsigned j = 0; j < 16; ++j) { const unsigned c = xb_ld(&bar[XB_XCNT(j)]); sum += c; cnt += (c > 0u) ? 1u : 0u; mine = (j == x) ? c : mine; }
        if (sum == G) break;
        __builtin_amdgcn_s_sleep(1);
        if ((++sp & 255u) == 0u) { if (xb_ld(&bar[XB_TMO])) break; if (sp > XB_SPIN_CAP) { atomicAdd(&bar[XB_TMO], 1u); break; } }
    }
    nloc = mine > 0u ? mine : 1u; nx = cnt > 0u ? cnt : 1u;
}

__device__ __forceinline__ void xcd_barrier(const XcdBarrier& b) {
    asm volatile("s_waitcnt vmcnt(0)" ::: "memory");
    __syncthreads();
    if (threadIdx.x == 0) {
        unsigned* bar = b.bar;
        __builtin_amdgcn_s_waitcnt(0);
        unsigned nloc = b.st[0], nx = b.st[1];
        if (nloc == 0u) { xcd_barrier_complete(bar, b.x, nloc, nx); b.st[0] = nloc; b.st[1] = nx; }
        const unsigned old = xb_add(&bar[XB_XSUB(b.x)], 1u);
        const unsigned gen = old / nloc;
        if (old + 1u == (gen + 1u) * nloc) {
            __builtin_amdgcn_fence(__ATOMIC_RELEASE, "agent");
            asm volatile("s_waitcnt vmcnt(0)" ::: "memory");
            const unsigned og = xb_add(&bar[XB_TOP], 1u);
            const unsigned tg = og / nx;
            if (og + 1u == (tg + 1u) * nx) xb_add(&bar[XB_TOPGEN], 1u);
            else XB_SPIN(xb_ld(&bar[XB_TOPGEN]) == tg, bar);
            __builtin_amdgcn_fence(__ATOMIC_ACQUIRE, "agent");
            xb_add(&bar[XB_XGEN(b.x)], 1u);
            asm volatile("s_waitcnt vmcnt(0)" ::: "memory");
        } else {
            XB_SPIN(xb_ld(&bar[XB_XGEN(b.x)]) == gen, bar);
            __builtin_amdgcn_fence(__ATOMIC_ACQUIRE, "agent");
            asm volatile("s_waitcnt vmcnt(0)" ::: "memory");
        }
    }
    __syncthreads();
}


enum { PT_GEMM = 0, PT_HGRN = 1, PT_COMBINE = 2, PT_ATTN0 = 3, PT_ATTN1 = 4, PT_FINAL = 5, PT_MERGE = 6 };
constexpr int NPH = 18;
__global__ void __launch_bounds__(512, 2) fwd_megakernel(Params p) {
  extern __shared__ __attribute__((aligned(16))) unsigned char shm[];
  cg::grid_group grid = cg::this_grid();
  unsigned* ctr = (unsigned*)(p.ws + OFF_CTR);
  if (threadIdx.x == 0) { *(volatile unsigned*)(shm + LCTL + 200) = 0u; *(volatile unsigned*)(shm + LCTL + 204) = 0u; }
  __syncthreads();
  const XcdBarrier xb = xcd_barrier_post((unsigned*)(p.ws + OFF_BAR), (volatile XLAS unsigned*)((XLAS unsigned char*)shm + LCTL + 200));
  unsigned my_x = 0, my_rank = 0;
  if (threadIdx.x == 0) { my_x = (unsigned)__builtin_amdgcn_s_getreg((3 << 11) | 20) & 0xFu; if (my_x > 7u) my_x = 7u; my_rank = __hip_atomic_fetch_add(ctr + my_x, 1u, __ATOMIC_RELAXED, __HIP_MEMORY_SCOPE_AGENT); }
  prep_phase(p, shm);
  grid.sync();
  if (threadIdx.x == 0) {
    bool ok = true;
    for (int x = 0; x < 8; ++x) ok = ok && (__hip_atomic_load(ctr + x, __ATOMIC_RELAXED, __HIP_MEMORY_SCOPE_AGENT) * 8u == gridDim.x);
    *(int*)(shm + LCTL + 192) = ok ? (int)(my_rank * 8u + my_x) : (int)blockIdx.x;
  }
  __syncthreads();
  const int vcu = __builtin_amdgcn_readfirstlane(*(const int*)(shm + LCTL + 192));
  for (int ph = 0; ph < NPH; ++ph) {
    const int type = p.ph[ph].type;
    if (type == PT_GEMM) {
      __syncthreads();
      if (threadIdx.x == 0) *(EpiP*)(shm + LCTL) = p.ph[ph].e;
      __syncthreads();
      pg8::Gemm g; g.A = p.ph[ph].A; g.Bt = p.ph[ph].Bt; g.M = p.ph[ph].M; g.N = p.ph[ph].N; g.K = p.ph[ph].K;
      Epi E; E.lp = (const PG8_LAS EpiP*)((PG8_LAS unsigned char*)shm + LCTL);
      int vc = vcu; asm volatile("" : "+s"(vc)); pg8::StaticOrder S; S.init(g.M, g.N, (int)gridDim.x, vc);
      int nrep = 1;
#if defined(REP_PH)
      if (ph == REP_PH) nrep = 2;
#endif
#if defined(STAGGER_US)
      if (S.nwg >= 6 * (int)gridDim.x && ((vc >> 3) & 7)) { const unsigned long long t0 = wall_clock64(); const unsigned long long dl = (unsigned long long)(STAGGER_US * 100) * (unsigned)((vc >> 3) & 7); while (wall_clock64() - t0 < dl) __builtin_amdgcn_s_sleep(8); }
#endif
      for (int rr = 0; rr < nrep; ++rr) {
        if (rr) grid.sync();
        pg8::gemm_phase<Epi, pg8::StaticOrder, true, true>((PG8_LAS unsigned char*)shm, g, S, E);
      }
    } else if (type == PT_HGRN) { hgrn_phase(p, shm);
#if defined(REP_HGRN)
      grid.sync(); hgrn_phase(p, shm);
#endif
    }
    else if (type == PT_COMBINE) combine_phase(p);
    else if (type == PT_ATTN0) { attn_phase(p, 0, shm);
#if defined(REP_ATTN)
      grid.sync(); attn_phase(p, 0, shm);
#endif
    }
    else if (type == PT_ATTN1) { attn_phase(p, 1, shm);
#if defined(REP_ATTN)
      grid.sync(); attn_phase(p, 1, shm);
#endif
    }
    else if (type == PT_MERGE) merge_phase(p);
    else final_phase(p);
    if (ph < NPH - 1) xcd_barrier(xb);
  }
}

static void fill_phases(Params& p) {
  unsigned char* ws = p.ws; unsigned char* big = ws + OFF_BIG;
  float* ssb = (float*)(ws + OFF_SS); bf16_t* xb = (bf16_t*)(ws + OFF_XB);
  float* ss0 = ssb; float* ss1 = ssb + (size_t)T * 16; float* ss2 = ssb + (size_t)2 * T * 16; float* ss3 = ssb + (size_t)3 * T * 16;
  const bf16_t* win = (const bf16_t*)(ws + OFF_WIN);
  auto gemm = [&](int i, const bf16_t* A, const bf16_t* Bt, int M, int N, int K) -> EpiP& {
    PhaseDesc& d = p.ph[i]; d.type = PT_GEMM; d.M = M; d.N = N; d.K = K; d.A = A; d.Bt = Bt; d.e.mode = M_BF16S; d.e.ldo = D; d.e.alpha = 1.0f; d.e.kk_lo = -100; return d.e; };
  auto other = [&](int i, int type) { p.ph[i].type = type; };
  { EpiP& e = gemm(0, xb, (const bf16_t*)(ws + OFF_WGU1), T, 2 * FF, D); e.mode = M_SWIGLU; e.ss = ss0; e.ob = (bf16_t*)(big + B_ACT); }
  { EpiP& e = gemm(1, (const bf16_t*)(big + B_ACT), (const bf16_t*)(ws + OFF_WD1), T, D, FF); e.mode = M_RESID; e.alpha = 0.5f; e.of = nullptr; e.r0 = nullptr; e.sg = xb; e.ob = xb; e.ss_out = ss1; }
  { EpiP& e = gemm(2, xb, win + (size_t)4608 * D, T, 4096, D); e.ss = ss1; e.ob = (bf16_t*)(big + B_PROJH); e.ldo = 4096; e.silu_tiles = 4; e.kk_lo = 4; e.lbp = (const float*)(ws + OFF_LB); }
  other(3, PT_HGRN);
  { EpiP& e = gemm(4, xb, win + (size_t)8704 * D, T, 1024, D); e.ss = ss1; e.ob = (bf16_t*)(big + B_HG); e.ldo = 1024; }
  other(5, PT_COMBINE);
  for (int half = 0; half < 2; ++half) {
    EpiP& e = gemm(6 + 2 * half, xb + (size_t)half * THALF * D, win, THALF, 4608, D); e.ss = ss1 + (size_t)half * THALF * 16; e.ob = (bf16_t*)(big + B_QKV); e.ldo = 4608;
    other(7 + 2 * half, half ? PT_ATTN1 : PT_ATTN0);
  }
  other(10, PT_MERGE);
  { EpiP& e = gemm(11, xb, win + (size_t)9728 * D, T, 2048, D); e.ss = ss1; e.sig = 1; e.ob = (bf16_t*)(big + B_SGA); e.ldo = 1024; e.split_tiles = 4; e.split_stride = (size_t)T * D; }
  { EpiP& e = gemm(12, (const bf16_t*)(big + B_YA), (const bf16_t*)(ws + OFF_WA), T, D, 512); e.mode = M_MUL; e.sg = (const bf16_t*)(big + B_SGA); e.of = (float*)(big + B_TMP); }
  { EpiP& e = gemm(13, (const bf16_t*)(big + B_YB), (const bf16_t*)(ws + OFF_WB), T, D, D); e.mode = M_FMA; e.sg = (const bf16_t*)(big + B_SGB); e.tmp = (const float*)(big + B_TMP); e.ob = (bf16_t*)(big + B_SGB); }
  { EpiP& e = gemm(14, (const bf16_t*)(big + B_SGB), (const bf16_t*)(ws + OFF_WO), T, D, D); e.mode = M_RESID; e.alpha = 1.0f; e.of = nullptr; e.r0 = nullptr; e.sg = xb; e.ob = xb; e.ss_out = ss2; }
  { EpiP& e = gemm(15, xb, (const bf16_t*)(ws + OFF_WGU2), T, 2 * FF, D); e.mode = M_SWIGLU; e.ss = ss2; e.ob = (bf16_t*)(big + B_ACT); }
  { EpiP& e = gemm(16, (const bf16_t*)(big + B_ACT), (const bf16_t*)(ws + OFF_WD2), T, D, FF); e.mode = M_RESID; e.alpha = 0.5f; e.of = nullptr; e.r0 = nullptr; e.sg = xb; e.ob = xb; e.ss_out = ss3; }
  other(17, PT_FINAL);
}

extern "C" void kernel_launch(void* const* d_in, const int* in_sizes, int n_in, void* d_out, int out_size, void* d_ws, size_t ws_size, hipStream_t stream) {
  constexpr int kDynLds = 163840;
  static int grid_blocks = 0;
  if (!grid_blocks) {
    if (n_in != 17 || out_size != T * D || ws_size < WS_NEED) { fprintf(stderr, "kernel_launch: unexpected shapes (n_in %d out %d ws %zu need %zu)\n", n_in, out_size, ws_size, (size_t)WS_NEED); grid_blocks = -1; return; }
    int dev = 0, cus = 0, per_cu = 0;
    (void)hipGetDevice(&dev);
    (void)hipDeviceGetAttribute(&cus, hipDeviceAttributeMultiprocessorCount, dev);
    (void)hipFuncSetAttribute((const void*)fwd_megakernel, hipFuncAttributeMaxDynamicSharedMemorySize, kDynLds);
    (void)hipOccupancyMaxActiveBlocksPerMultiprocessor(&per_cu, (const void*)fwd_megakernel, 512, kDynLds);
    if (per_cu < 1) per_cu = 1;
    grid_blocks = cus * per_cu;
  }
  if (grid_blocks < 0) return;
  static Params p;
  memset(&p, 0, sizeof(p));
  for (int i = 0; i < 17; ++i) p.in[i] = (const float*)d_in[i];
  p.out = (float*)d_out; p.ws = (unsigned char*)d_ws;
  fill_phases(p);
  (void)hipMemsetAsync((unsigned char*)d_ws + OFF_CTR, 0, 256 + 3456 * 4, stream);
  void* args[] = {&p};
  hipError_t e = hipLaunchCooperativeKernel((const void*)fwd_megakernel, dim3(grid_blocks), dim3(512), args, kDynLds, stream);
  if (e != hipSuccess) fprintf(stderr, "cooperative launch failed: %s (grid %d)\n", hipGetErrorString(e), grid_blocks);
}
```

```cpp
#include <hip/hip_runtime.h>
#include <hip/hip_cooperative_groups.h>
#include <cstdio>
#include <cstdint>
#include <cstring>
namespace cg = cooperative_groups;
__device__ __forceinline__ int opq_tid() { int t = threadIdx.x; asm volatile("" : "+v"(t)); return t; }
__device__ __forceinline__ int opq_bid() { int b = blockIdx.x; asm volatile("" : "+s"(b)); return b; }
namespace pg8 {
#define PG8_LAS __attribute__((address_space(3)))
typedef unsigned short bf16_t;
typedef short bf16x8 __attribute__((ext_vector_type(8)));
typedef float f32x4 __attribute__((ext_vector_type(4)));
typedef unsigned u32x4 __attribute__((ext_vector_type(4)));
constexpr int BM = 256, BK = 64, HALF = 128, HTB = HALF * BK * 2  , STAGE_BYTES = 8 * HTB, NXCD = 8, WGM = 8;

__host__ __device__ __forceinline__ int lds_byte(int r, int c) { const int st = (r >> 4) * 2 + (c >> 5), rr = r & 15, cc = c & 31, ob = rr * 64 + cc * 2; return st * 1024 + (ob ^ (((ob >> 9) & 1) << 5)); }
__host__ __device__ __forceinline__ void stage_rc(int b, int& R, int& C) { const int st = b / 1024, sb = b % 1024, swz = sb ^ (((sb >> 9) & 1) << 5); R = (st >> 1) * 16 + swz / 64; C = (st & 1) * 32 + (swz % 64) / 2; }
__host__ __device__ __forceinline__ int perm32(int rho) { const int n = rho >> 4, i = rho & 15; return 8 * (i >> 2) + 4 * n + (i & 3); }

struct Unit { int pm, pn; };
struct Gemm { const bf16_t* A; const bf16_t* Bt; int M, N, K; };

struct StaticOrder {
    int nM, nN, nwg, G, c;
    __host__ __device__ __forceinline__ void init(int M, int N, int G_, int c_) { nM = M / BM; nN = N / BM; nwg = nM * nN; G = G_; c = c_; }
    __host__ __device__ __forceinline__ bool next(int i, Unit& u) const {
        const long L = (long)i * G + c; if (L >= nwg) return false;
        int wgid = (int)L; { const int q = nwg / NXCD, r = nwg % NXCD, xcd = wgid % NXCD, off = wgid / NXCD; wgid = (xcd < r ? xcd * (q + 1) : r * (q + 1) + (xcd - r) * q) + off; }
        const int nig = WGM * nN, gid = wgid / nig, fm = gid * WGM, gsz = (nM - fm) < WGM ? (nM - fm) : WGM;
        u.pm = fm + ((wgid % nig) % gsz); u.pn = (wgid % nig) / gsz; return true;
    }
    __device__ __forceinline__ void a_ready(const Unit&) const {}
    __device__ __forceinline__ void done(const Unit&) const {}
};
template <class Epi, class Sched, bool ALIGN_EPI = false, bool SP2 = false>
__device__ __forceinline__ void gemm_phase(PG8_LAS unsigned char* lds, const Gemm g, const Sched& S, const Epi& E) {
    const int tid = opq_tid(), wid = __builtin_amdgcn_readfirstlane(tid >> 6), lane = tid & 63, wr = wid >> 2, wc = wid & 3, fr = lane & 15, fq = lane >> 4;
    const int K = g.K, nt = K / BK;
    unsigned voffA[2], voffB[2];
#pragma unroll
    for (int i = 0; i < 2; ++i) { int R, C; stage_rc(tid * 16 + i * 8192, R, C); const int Rb = Epi::PERM ? ((R & ~31) + perm32(R & 31)) : R;
        voffA[i] = (unsigned)(R * K + C) * 2u; voffB[i] = (unsigned)(Rb * K + C) * 2u; }
    const size_t kstep = (size_t)(BK * 2);
    const size_t hstep = (size_t)HALF * K * 2;
    const size_t tstep = 2 * hstep;
    const unsigned ldsw = (unsigned)wid * 1024u;
    const int aoff = lds_byte(wr * 64 + fr, fq * 8), boff = lds_byte(wc * 32 + fr, fq * 8);
#define PG8_SA(b, h) (((b) * 2 + (h)) * HTB)
#define PG8_SB(b, h) ((4 + (b) * 2 + (h)) * HTB)
#define PG8_STAGE(bufoff, gbase, voff) do { _Pragma("unroll") for (int _i = 0; _i < 2; ++_i) \
        __builtin_amdgcn_global_load_lds((const unsigned*)((const char*)(gbase) + (voff)[_i]), (PG8_LAS unsigned*)(lds + (bufoff) + ldsw + _i * 8192), 16, 0, 0); } while (0)
#define PG8_LDA(dst, b, h) do { _Pragma("unroll") for (int m = 0; m < 4; ++m) _Pragma("unroll") for (int k = 0; k < 2; ++k) dst[m][k] = *(const PG8_LAS bf16x8*)(lds + PG8_SA(b, h) + aoff + m * 2048 + k * 1024); } while (0)
#define PG8_LDB(dst, b, h) do { _Pragma("unroll") for (int n = 0; n < 2; ++n) _Pragma("unroll") for (int k = 0; k < 2; ++k) dst[n][k] = *(const PG8_LAS bf16x8*)(lds + PG8_SB(b, h) + boff + n * 2048 + k * 1024); } while (0)
#define PG8_MMA(ai, bj, At, Bt) do { __builtin_amdgcn_s_setprio(1); _Pragma("unroll") for (int m = 0; m < 4; ++m) _Pragma("unroll") for (int n = 0; n < 2; ++n) _Pragma("unroll") for (int k = 0; k < 2; ++k) \
        acc[ai][bj][m][n] = __builtin_amdgcn_mfma_f32_16x16x32_bf16(Bt[n][k], At[m][k], acc[ai][bj][m][n], 0, 0, 0); __builtin_amdgcn_s_setprio(0); } while (0)
#define PG8_WAIT_V(n) asm volatile("s_waitcnt vmcnt(" #n ")" ::: "memory")
#define PG8_WAIT_L(n) asm volatile("s_waitcnt lgkmcnt(" #n ")" ::: "memory")
#define PG8_BAR __builtin_amdgcn_s_barrier()
#define PG8_SCHED __builtin_amdgcn_sched_barrier(0)
    Unit cur, nxt; int ui = 0;
    if (!S.next(0, cur)) return;
    f32x4 acc[2][2][4][2];
#pragma unroll
    for (int a = 0; a < 2; ++a)
#pragma unroll
        for (int b = 0; b < 2; ++b)
#pragma unroll
            for (int m = 0; m < 4; ++m)
#pragma unroll
                for (int n = 0; n < 2; ++n) acc[a][b][m][n] = (f32x4){0.f, 0.f, 0.f, 0.f};
    bf16x8 At[4][2], B0[2][2], B1[2][2];
    const char* cA = (const char*)g.A + (size_t)cur.pm * tstep; const char* cB = (const char*)g.Bt + (size_t)cur.pn * tstep;
    S.a_ready(cur);
    if constexpr (SP2) {
        PG8_STAGE(PG8_SB(0, 0), cB, voffB); PG8_STAGE(PG8_SB(0, 1), cB + hstep, voffB); PG8_STAGE(PG8_SA(0, 0), cA, voffA); PG8_STAGE(PG8_SA(0, 1), cA + hstep, voffA);
        if (wr == 1) PG8_BAR;
        PG8_WAIT_V(2); PG8_BAR;
        PG8_STAGE(PG8_SB(1, 0), cB + kstep, voffB); PG8_STAGE(PG8_SA(1, 0), cA + kstep, voffA); PG8_STAGE(PG8_SB(1, 1), cB + hstep + kstep, voffB);
        PG8_WAIT_V(6); PG8_BAR;
    } else {
        PG8_STAGE(PG8_SB(0, 0), cB, voffB); PG8_STAGE(PG8_SA(0, 0), cA, voffA); PG8_STAGE(PG8_SB(0, 1), cB + hstep, voffB); PG8_STAGE(PG8_SA(0, 1), cA + hstep, voffA);
        if (wr == 1) PG8_BAR;
        PG8_WAIT_V(4); PG8_BAR;
        PG8_STAGE(PG8_SB(1, 0), cB + kstep, voffB); PG8_STAGE(PG8_SA(1, 0), cA + kstep, voffA); PG8_STAGE(PG8_SB(1, 1), cB + hstep + kstep, voffB);
        PG8_WAIT_V(6); PG8_BAR;
    }
    for (;;) {
        const bool has_next = S.next(ui + 1, nxt);
        const char* nA = has_next ? (const char*)g.A + (size_t)nxt.pm * tstep : cA; const char* nB = has_next ? (const char*)g.Bt + (size_t)nxt.pn * tstep : cB;
        for (int t = 0; t < nt; t += 2) {
            const bool last = (t == nt - 2);
            const char* a1 = cA + (size_t)(t + 1) * kstep;
            const char* a2 = last ? nA : cA + (size_t)(t + 2) * kstep; const char* b2 = last ? nB : cB + (size_t)(t + 2) * kstep;
            const char* a3 = a2 + kstep; const char* b3 = b2 + kstep;
            if (last && has_next) S.a_ready(nxt);
            if constexpr (SP2) {
            PG8_LDB(B0, 0, 0); PG8_LDB(B1, 0, 1); PG8_SCHED; PG8_LDA(At, 0, 0); PG8_STAGE(PG8_SA(1, 1), a1 + hstep, voffA);
            PG8_WAIT_V(8); PG8_WAIT_L(0); PG8_BAR; PG8_MMA(0, 0, At, B0); PG8_MMA(0, 1, At, B1); PG8_BAR; PG8_SCHED;
            PG8_LDA(At, 0, 1); PG8_STAGE(PG8_SB(0, 0), b2, voffB); PG8_STAGE(PG8_SB(0, 1), b2 + hstep, voffB); PG8_STAGE(PG8_SA(0, 0), a2, voffA);
            PG8_WAIT_V(8); PG8_WAIT_L(0); PG8_BAR; PG8_MMA(1, 0, At, B0); PG8_MMA(1, 1, At, B1); PG8_BAR; PG8_SCHED;
            PG8_LDB(B0, 1, 0); PG8_LDB(B1, 1, 1); PG8_SCHED; PG8_LDA(At, 1, 0); PG8_STAGE(PG8_SA(0, 1), a2 + hstep, voffA);
            PG8_WAIT_V(8); PG8_WAIT_L(0); PG8_BAR; PG8_MMA(0, 0, At, B0); PG8_MMA(0, 1, At, B1); PG8_BAR; PG8_SCHED;
            PG8_LDA(At, 1, 1); PG8_STAGE(PG8_SB(1, 0), b3, voffB); PG8_STAGE(PG8_SB(1, 1), b3 + hstep, voffB); PG8_STAGE(PG8_SA(1, 0), a3, voffA);
            PG8_WAIT_V(8); PG8_WAIT_L(0); PG8_BAR; PG8_MMA(1, 0, At, B0); PG8_MMA(1, 1, At, B1); PG8_BAR; PG8_SCHED;
            } else {
            PG8_LDB(B0, 0, 0); PG8_SCHED; PG8_LDA(At, 0, 0); PG8_STAGE(PG8_SA(1, 1), a1 + hstep, voffA);
            PG8_WAIT_L(8); PG8_BAR; PG8_WAIT_L(0); PG8_MMA(0, 0, At, B0); PG8_BAR; PG8_SCHED;
            PG8_LDB(B1, 0, 1); PG8_STAGE(PG8_SB(0, 0), b2, voffB);
            PG8_BAR; PG8_WAIT_L(0); PG8_MMA(0, 1, At, B1); PG8_BAR;
            PG8_LDA(At, 0, 1); PG8_STAGE(PG8_SA(0, 0), a2, voffA);
            PG8_BAR; PG8_WAIT_L(0); PG8_MMA(1, 0, At, B0); PG8_BAR; PG8_SCHED;
            PG8_STAGE(PG8_SB(0, 1), b2 + hstep, voffB);
            PG8_WAIT_V(6); PG8_BAR; PG8_MMA(1, 1, At, B1); PG8_BAR;
            PG8_LDB(B0, 1, 0); PG8_SCHED; PG8_LDA(At, 1, 0); PG8_STAGE(PG8_SA(0, 1), a2 + hstep, voffA);
            PG8_WAIT_L(8); PG8_BAR; PG8_WAIT_L(0); PG8_MMA(0, 0, At, B0); PG8_BAR; PG8_SCHED;
            PG8_LDB(B1, 1, 1); PG8_STAGE(PG8_SB(1, 0), b3, voffB);
            PG8_BAR; PG8_WAIT_L(0); PG8_MMA(0, 1, At, B1); PG8_BAR;
            PG8_LDA(At, 1, 1); PG8_STAGE(PG8_SA(1, 0), a3, voffA);
            PG8_BAR; PG8_WAIT_L(0); PG8_MMA(1, 0, At, B0); PG8_BAR; PG8_SCHED;
            PG8_STAGE(PG8_SB(1, 1), b3 + hstep, voffB);
            PG8_WAIT_V(6); PG8_BAR; PG8_MMA(1, 1, At, B1); PG8_BAR;
            }
        }
        if constexpr (ALIGN_EPI) { if (wr == 0) PG8_BAR; }
        if constexpr (!Epi::AFTER_DRAIN) { E(acc, cur, wr, wc, fr, fq); S.done(cur); }
        if (!has_next) break;
#pragma unroll
        for (int a = 0; a < 2; ++a)
#pragma unroll
            for (int b = 0; b < 2; ++b)
#pragma unroll
                for (int m = 0; m < 4; ++m)
#pragma unroll
                    for (int n = 0; n < 2; ++n) acc[a][b][m][n] = (f32x4){0.f, 0.f, 0.f, 0.f};
        cur = nxt; cA = nA; cB = nB; ++ui;
        if constexpr (ALIGN_EPI) { if (wr == 1) PG8_BAR; }
    }
    PG8_WAIT_V(0);
    if constexpr (!ALIGN_EPI) { if (wr == 0) PG8_BAR; }
    PG8_BAR;
    if constexpr (Epi::AFTER_DRAIN) { E.fused(acc, cur, wr, wc, fr, fq, lds, wid, lane); S.done(cur); }
#undef PG8_SA
#undef PG8_SB
#undef PG8_STAGE
#undef PG8_LDA
#undef PG8_LDB
#undef PG8_MMA
#undef PG8_WAIT_V
#undef PG8_WAIT_L
#undef PG8_BAR
#undef PG8_SCHED
}
}

using pg8::f32x4; using pg8::bf16_t; using pg8::u32x4;
typedef unsigned u32x2 __attribute__((ext_vector_type(2)));
#define DI __device__ __forceinline__
#define LDS_BARRIER() do { asm volatile("s_waitcnt lgkmcnt(0)" ::: "memory"); __builtin_amdgcn_s_barrier(); asm volatile("" ::: "memory"); } while (0)

constexpr int T = 49152, TP = 16384, D = 1024, FF = 2816, NIN = 11776, THALF = 24576;
constexpr float EPS = 1e-6f;
constexpr int LCTL = 163840 - 256;

typedef __bf16 bf16v2_t __attribute__((ext_vector_type(2)));
typedef float f32v2_t __attribute__((ext_vector_type(2)));
DI unsigned pk2(float lo, float hi) { f32v2_t v = {lo, hi}; bf16v2_t r = __builtin_convertvector(v, bf16v2_t); return __builtin_bit_cast(unsigned, r); }
DI float bflo(unsigned u) { return __uint_as_float(u << 16); }
DI float bfhi(unsigned u) { return __uint_as_float(u & 0xffff0000u); }
DI float bf1(bf16_t b) { return __uint_as_float(((unsigned)b) << 16); }
DI float sigm(float x) { return __builtin_amdgcn_rcpf(1.0f + __expf(-x)); }
DI float wave_sum(float v) {
#pragma unroll
  for (int o = 1; o < 64; o <<= 1) v += __shfl_xor(v, o);
  return v;
}
DI float wave_max(float v) {
#pragma unroll
  for (int o = 1; o < 64; o <<= 1) v = fmaxf(v, __shfl_xor(v, o));
  return v;
}

DI float ss16(const float* p) { const f32x4 a = *(const f32x4*)p, b = *(const f32x4*)(p + 4), c = *(const f32x4*)(p + 8), d = *(const f32x4*)(p + 12);
  return ((a[0] + a[1]) + (a[2] + a[3])) + ((b[0] + b[1]) + (b[2] + b[3])) + ((c[0] + c[1]) + (c[2] + c[3])) + ((d[0] + d[1]) + (d[2] + d[3])); }
enum { M_SWIGLU = 0, M_BF16S = 1, M_RESID = 2, M_MUL = 3, M_FMA = 4 };

struct EpiP {
  int mode, sig, split_tiles, ldo;
  const float* ss; bf16_t* ob; size_t split_stride;
  float* of; const float* r0; const float* r1; float alpha; int silu_tiles; float* ss_out;
  const bf16_t* sg; const float* tmp;
  const float* lbp; int kk_lo; int pad2;
};
struct Epi {
  static constexpr bool PERM = false, AFTER_DRAIN = false;
  const PG8_LAS EpiP* lp;
  __device__ __forceinline__ void operator()(const f32x4 (&acc)[2][2][4][2], const pg8::Unit& u, int wr, int wc, int fr, int fq) const {
    asm volatile("" : "+v"(fr), "+v"(fq));
    const int mode = lp->mode, sig = lp->sig, split_tiles = lp->split_tiles, ldo = lp->ldo, silu_tiles = lp->silu_tiles;
    const float* ss = lp->ss; bf16_t* ob = lp->ob; const size_t split_stride = lp->split_stride;
    float* of = lp->of; const float* r0 = lp->r0; const float* r1 = lp->r1; const float alpha = lp->alpha; float* ss_out = lp->ss_out;
    const bf16_t* sg = lp->sg; const float* tmp = lp->tmp; const float* lbp = lp->lbp; const int kk_lo = lp->kk_lo;
    const int rowb = u.pm * 256 + wr * 64 + fr;
    float rsv[8];
    if (mode == M_SWIGLU || mode == M_BF16S) {
      f32x4 pq[8];
#pragma unroll
      for (int q = 0; q < 8; ++q) pq[q] = *(const f32x4*)(ss + (size_t)(rowb + (q >> 2) * 128 + (q & 3) * 16) * 16 + 4 * fq);
#pragma unroll
      for (int q = 0; q < 8; ++q) { float t = (pq[q][0] + pq[q][1]) + (pq[q][2] + pq[q][3]); t += __shfl_xor(t, 16); t += __shfl_xor(t, 32); rsv[q] = rsqrtf(t * (1.0f / 1024.0f) + EPS); }
    }
    if (mode == M_SWIGLU) {
#pragma unroll
      for (int ai = 0; ai < 2; ++ai)
#pragma unroll
        for (int m = 0; m < 4; ++m) {
          const int row = rowb + ai * 128 + m * 16;
          const float rs = rsv[ai * 4 + m];
          float h[8];
#pragma unroll
          for (int n = 0; n < 2; ++n)
#pragma unroll
            for (int j = 0; j < 4; ++j) { const float a = acc[ai][0][m][n][j] * rs, b = acc[ai][1][m][n][j] * rs; h[n * 4 + j] = a * sigm(a) * b; }
          u32x4 w; w.x = pk2(h[0], h[1]); w.y = pk2(h[2], h[3]); w.z = pk2(h[4], h[5]); w.w = pk2(h[6], h[7]);
          *(u32x4*)(ob + (size_t)row * FF + u.pn * 128 + wc * 32 + fq * 8) = w;
        }
    } else if (mode == M_BF16S) {
      int pn = u.pn; bf16_t* base = ob;
      if (split_tiles) { const int t = pn / split_tiles; base += (size_t)t * split_stride; pn -= t * split_tiles; }
      const bool iskk = (unsigned)(u.pn - kk_lo) < 8u;
      const int act = sig ? 1 : (u.pn < silu_tiles ? 2 : (iskk ? 3 : 0));
      if (act == 0) {
#pragma unroll
        for (int ai = 0; ai < 2; ++ai)
#pragma unroll
          for (int m = 0; m < 4; ++m) {
            const int row = rowb + ai * 128 + m * 16;
            const float rs = rsv[ai * 4 + m];
#pragma unroll
            for (int bj = 0; bj < 2; ++bj) {
              const f32x4 a0 = acc[ai][bj][m][0] * rs, a1 = acc[ai][bj][m][1] * rs;
              u32x4 w; w.x = pk2(a0[0], a0[1]); w.y = pk2(a0[2], a0[3]); w.z = pk2(a1[0], a1[1]); w.w = pk2(a1[2], a1[3]);
              *(u32x4*)(base + (size_t)row * ldo + pn * 256 + bj * 128 + wc * 32 + fq * 8) = w;
            }
          }
      } else {
#pragma unroll
        for (int ai = 0; ai < 2; ++ai)
#pragma unroll
          for (int m = 0; m < 4; ++m) {
            const int row = rowb + ai * 128 + m * 16;
            const float rs = rsv[ai * 4 + m];
#pragma unroll
            for (int bj = 0; bj < 2; ++bj) {
              float v[8];
              f32x4 lbA = {0.f, 0.f, 0.f, 0.f}, lbB = {0.f, 0.f, 0.f, 0.f};
              if (act == 3) { const float* lq = lbp + (u.pn - kk_lo) * 256 + bj * 128 + wc * 32 + fq * 8; lbA = *(const f32x4*)lq; lbB = *(const f32x4*)(lq + 4); }
#pragma unroll
              for (int n = 0; n < 2; ++n)
#pragma unroll
                for (int j = 0; j < 4; ++j) { const float x = acc[ai][bj][m][n][j] * rs; const float sg1 = sigm(x); const float lb = n ? lbB[j] : lbA[j];
                  v[n * 4 + j] = act == 1 ? sg1 : (act == 2 ? x * sg1 : (1.0f - lb) * (1.0f - sg1)); }
              u32x4 w; w.x = pk2(v[0], v[1]); w.y = pk2(v[2], v[3]); w.z = pk2(v[4], v[5]); w.w = pk2(v[6], v[7]);
              *(u32x4*)(base + (size_t)row * ldo + pn * 256 + bj * 128 + wc * 32 + fq * 8) = w;
            }
          }
      }
    } else if (mode == M_RESID) {
      const int cb = u.pn * 256 + wc * 32 + fq * 4;
#define RES_ROW(q) (rowb + ((q) >> 2) * 128 + ((q) & 3) * 16)
#define RES_PTR(q) ((RES_ROW(q) < TP) ? r0 + (size_t)RES_ROW(q) * D : r1 + (size_t)(RES_ROW(q) - TP) * D)
#define RES_TAIL(OV) do { \
          if (of) *(f32x4*)(of + (size_t)row * D + c0) = (OV); \
          if (ob) { u32x2 w; w.x = pk2((OV)[0], (OV)[1]); w.y = pk2((OV)[2], (OV)[3]); *(u32x2*)(ob + (size_t)row * D + c0) = w; } \
          s2 += ((OV)[0] * (OV)[0] + (OV)[1] * (OV)[1]) + ((OV)[2] * (OV)[2] + (OV)[3] * (OV)[3]); } while (0)
      if (r0) {
        f32x4 rc[4], rn[4];
        { const float* rp = RES_PTR(0);
#pragma unroll
          for (int e = 0; e < 4; ++e) rc[e] = *(const f32x4*)(rp + cb + (e >> 1) * 128 + (e & 1) * 16); }
#pragma unroll
        for (int q = 0; q < 8; ++q) {
          const int ai = q >> 2, m = q & 3, row = RES_ROW(q);
          if (q < 7) { const float* rp = RES_PTR(q + 1);
#pragma unroll
            for (int e = 0; e < 4; ++e) rn[e] = *(const f32x4*)(rp + cb + (e >> 1) * 128 + (e & 1) * 16); }
          float s2 = 0.f;
#pragma unroll
          for (int e = 0; e < 4; ++e) { const int bj = e >> 1, n = e & 1, c0 = cb + bj * 128 + n * 16; const f32x4 o = rc[e] + alpha * acc[ai][bj][m][n]; RES_TAIL(o); }
          s2 += __shfl_xor(s2, 16); s2 += __shfl_xor(s2, 32);
          if (fq == 0) ss_out[(size_t)row * 16 + u.pn * 4 + wc] = s2;
          asm volatile("" ::: "memory");
#pragma unroll
          for (int e = 0; e < 4; ++e) rc[e] = rn[e];
        }
      } else {
        u32x2 rc[4], rn[4];
#pragma unroll
        for (int e = 0; e < 4; ++e) rc[e] = *(const u32x2*)(sg + (size_t)RES_ROW(0) * D + cb + (e >> 1) * 128 + (e & 1) * 16);
#pragma unroll
        for (int q = 0; q < 8; ++q) {
          const int ai = q >> 2, m = q & 3, row = RES_ROW(q);
          if (q < 7) {
#pragma unroll
            for (int e = 0; e < 4; ++e) rn[e] = *(const u32x2*)(sg + (size_t)RES_ROW(q + 1) * D + cb + (e >> 1) * 128 + (e & 1) * 16); }
          float s2 = 0.f;
#pragma unroll
          for (int e = 0; e < 4; ++e) { const int bj = e >> 1, n = e & 1, c0 = cb + bj * 128 + n * 16;
            f32x4 r; r[0] = bflo(rc[e].x); r[1] = bfhi(rc[e].x); r[2] = bflo(rc[e].y); r[3] = bfhi(rc[e].y);
            const f32x4 o = r + alpha * acc[ai][bj][m][n]; RES_TAIL(o); }
          s2 += __shfl_xor(s2, 16); s2 += __shfl_xor(s2, 32);
          if (fq == 0) ss_out[(size_t)row * 16 + u.pn * 4 + wc] = s2;
          asm volatile("" ::: "memory");
#pragma unroll
          for (int e = 0; e < 4; ++e) rc[e] = rn[e];
        }
      }
#undef RES_TAIL
#undef RES_ROW
#undef RES_PTR
    } else {
      u32x2 gc[4], gn[4]; f32x4 tc[4], tn[4];
      const int cb = u.pn * 256 + wc * 32 + fq * 4;
      const bool fma = mode == M_FMA;
#pragma unroll
      for (int e = 0; e < 4; ++e) { const size_t o0 = (size_t)rowb * D + cb + (e >> 1) * 128 + (e & 1) * 16; gc[e] = *(const u32x2*)(sg + o0); if (fma) tc[e] = *(const f32x4*)(tmp + o0); }
#pragma unroll
      for (int q = 0; q < 8; ++q) {
        const int ai = q >> 2, m = q & 3, row = rowb + ai * 128 + m * 16;
        if (q < 7) { const int rown = rowb + ((q + 1) >> 2) * 128 + ((q + 1) & 3) * 16;
#pragma unroll
          for (int e = 0; e < 4; ++e) { const size_t o0 = (size_t)rown * D + cb + (e >> 1) * 128 + (e & 1) * 16; gn[e] = *(const u32x2*)(sg + o0); if (fma) tn[e] = *(const f32x4*)(tmp + o0); } }
#pragma unroll
        for (int e = 0; e < 4; ++e) {
          const int bj = e >> 1, n = e & 1; const size_t o0 = (size_t)row * D + cb + bj * 128 + n * 16;
          f32x4 gv; gv[0] = bflo(gc[e].x); gv[1] = bfhi(gc[e].x); gv[2] = bflo(gc[e].y); gv[3] = bfhi(gc[e].y);
          if (!fma) { *(f32x4*)(of + o0) = gv * acc[ai][bj][m][n]; }
          else { const f32x4 o = tc[e] + gv * acc[ai][bj][m][n]; u32x2 w; w.x = pk2(o[0], o[1]); w.y = pk2(o[2], o[3]); *(u32x2*)(ob + o0) = w; }
        }
        asm volatile("" ::: "memory");
#pragma unroll
        for (int e = 0; e < 4; ++e) { gc[e] = gn[e]; if (fma) tc[e] = tn[e]; }
      }
    }
  }
};

constexpr size_t SZ_WGU = (size_t)2 * FF * D * 2, SZ_WD = (size_t)D * FF * 2, SZ_WIN = (size_t)NIN * D * 2;
constexpr size_t OFF_WGU1 = 0, OFF_WD1 = OFF_WGU1 + SZ_WGU, OFF_WGU2 = OFF_WD1 + SZ_WD, OFF_WD2 = OFF_WGU2 + SZ_WGU, OFF_WIN = OFF_WD2 + SZ_WD;
constexpr size_t OFF_WA = OFF_WIN + SZ_WIN, OFF_WB = OFF_WA + (size_t)D * 512 * 2, OFF_WO = OFF_WB + (size_t)D * D * 2, OFF_XB = OFF_WO + (size_t)D * D * 2;
constexpr size_t OFF_SS = OFF_XB + (size_t)T * D * 2, OFF_CTR = OFF_SS + (size_t)4 * T * 16 * 4, OFF_BAR = OFF_CTR + 256, OFF_LB = OFF_BAR + (size_t)3456 * 4, OFF_BIG = OFF_LB + 8192;
constexpr size_t B_ACT = 0, B_PROJH = 0, B_OFB = (size_t)T * 4096 * 2, B_HG = 0, B_YB = (size_t)T * D * 2, B_QKV = B_YB + (size_t)T * D * 2;
constexpr size_t B_OG = B_QKV + (size_t)THALF * 4608 * 2, B_LSE = B_OG + (size_t)3 * T * 512 * 2, B_YA = 0, B_SGA = B_QKV, B_SGB = B_SGA + (size_t)T * D * 2, B_TMP = B_SGB + (size_t)T * D * 2;
constexpr size_t WS_NEED = OFF_BIG + B_TMP + (size_t)T * D * 4;

struct PhaseDesc { int type, M, N, K; const bf16_t* A; const bf16_t* Bt; EpiP e; };
struct Params {
  const float* in[17];
  float* out; unsigned char* ws;
  PhaseDesc ph[18];
};

enum { MAP_NAT = 0, MAP_P32 = 1, MAP_GU = 2 };
DI int srccol(int map, int np) {
  if (map == MAP_NAT) return np;
  if (map == MAP_P32) return (np & ~31) + pg8::perm32(np & 31);
  const int pn = np >> 8, w = np & 255, bj = w >> 7, wc = (w & 127) >> 5, n = (w & 31) >> 4, fq = (w & 15) >> 2, j = w & 3;
  return bj * FF + 128 * pn + 32 * wc + 8 * fq + 4 * n + j;
}
DI void transpose_item(const float* W, int K, int Nsrc, const float* gain, bf16_t* WT, int map, float* scr, int item, int nblk, int lane) {
  const int kb = item / nblk, nb = item % nblk, k0 = 64 * kb, n0 = 32 * nb;
  const int sc = srccol(map, n0 + (lane & 31));
#pragma unroll 8
  for (int i = 0; i < 32; ++i) { const int kk = 2 * i + (lane >> 5); scr[kk * 33 + (lane & 31)] = W[(size_t)(k0 + kk) * Nsrc + sc]; }
  asm volatile("s_waitcnt lgkmcnt(0)" ::: "memory");
  const int c = lane & 7;
  float g8[8];
#pragma unroll
  for (int e = 0; e < 8; ++e) g8[e] = gain ? gain[k0 + 8 * c + e] : 1.0f;
#pragma unroll
  for (int j = 0; j < 4; ++j) {
    const int n = (lane >> 3) + 8 * j; const float* s = scr + (8 * c) * 33 + n;
    u32x4 o; o.x = pk2(s[0 * 33] * g8[0], s[1 * 33] * g8[1]); o.y = pk2(s[2 * 33] * g8[2], s[3 * 33] * g8[3]);
    o.z = pk2(s[4 * 33] * g8[4], s[5 * 33] * g8[5]); o.w = pk2(s[6 * 33] * g8[6], s[7 * 33] * g8[7]);
    *(u32x4*)(WT + (size_t)(n0 + n) * K + k0 + 8 * c) = o;
  }
  asm volatile("s_waitcnt lgkmcnt(0)" ::: "memory");
}

DI void prep_phase(const Params& p, unsigned char* shm) {
  const int tid = opq_tid(), wid = tid >> 6, lane = tid & 63;
  const int bid = opq_bid(); const int gw = bid * 8 + wid, NGW = gridDim.x * 8;
  unsigned char* ws = p.ws;
  if (bid == 1) { float* lbv = (float*)(ws + OFF_LB);
    for (int i = tid; i < 2048; i += 512) { const float* lw = i < 1024 ? p.in[7] : p.in[8]; const int k = i & 1023; lbv[i] = 1.0f / (1.0f + __expf(lw[D + k] - lw[k])); } }
  { float* ss0 = (float*)(ws + OFF_SS); bf16_t* xb = (bf16_t*)(ws + OFF_XB);
    for (int rb = gw; rb < T; rb += 4 * NGW) {
      f32x4 v[4][4];
#pragma unroll
      for (int k = 0; k < 4; ++k) { const int row = rb + k * NGW; if (row < T) { const float* xr = row < TP ? p.in[0] + (size_t)row * D : p.in[1] + (size_t)(row - TP) * D;
#pragma unroll
          for (int j = 0; j < 4; ++j) v[k][j] = *(const f32x4*)(xr + 4 * lane + 256 * j); } }
#pragma unroll
      for (int k = 0; k < 4; ++k) { const int row = rb + k * NGW; if (row < T) { float s = 0.f;
#pragma unroll
          for (int j = 0; j < 4; ++j) s += (v[k][j][0] * v[k][j][0] + v[k][j][1] * v[k][j][1]) + (v[k][j][2] * v[k][j][2] + v[k][j][3] * v[k][j][3]);
          s = wave_sum(s);
          if (lane < 16) ss0[(size_t)row * 16 + lane] = lane == 0 ? s : 0.f;
#pragma unroll
          for (int j = 0; j < 4; ++j) { u32x2 w; w.x = pk2(v[k][j][0], v[k][j][1]); w.y = pk2(v[k][j][2], v[k][j][3]); *(u32x2*)(xb + (size_t)row * D + 4 * lane + 256 * j) = w; } } }
    } }
  float* scr = (float*)(shm + wid * 8704);
  for (int wsel = 0; wsel < 8; ++wsel) {
    const float* W; const float* gain = nullptr; bf16_t* WT; int K, Nsrc, Nd, map;
    switch (wsel) {
      case 0: W = p.in[3]; gain = p.in[2]; WT = (bf16_t*)(ws + OFF_WGU1); K = D; Nsrc = 2 * FF; Nd = 2 * FF; map = MAP_GU; break;
      case 1: W = p.in[4]; WT = (bf16_t*)(ws + OFF_WD1); K = FF; Nsrc = D; Nd = D; map = MAP_NAT; break;
      case 2: W = p.in[6]; gain = p.in[5]; WT = (bf16_t*)(ws + OFF_WIN); K = D; Nsrc = NIN; Nd = NIN; map = MAP_P32; break;
      case 3: W = p.in[10]; WT = (bf16_t*)(ws + OFF_WA); K = 512; Nsrc = D; Nd = D; map = MAP_NAT; break;
      case 4: W = p.in[11]; WT = (bf16_t*)(ws + OFF_WB); K = D; Nsrc = D; Nd = D; map = MAP_NAT; break;
      case 5: W = p.in[12]; WT = (bf16_t*)(ws + OFF_WO); K = D; Nsrc = D; Nd = D; map = MAP_NAT; break;
      case 6: W = p.in[14]; gain = p.in[13]; WT = (bf16_t*)(ws + OFF_WGU2); K = D; Nsrc = 2 * FF; Nd = 2 * FF; map = MAP_GU; break;
      default: W = p.in[15]; WT = (bf16_t*)(ws + OFF_WD2); K = FF; Nsrc = D; Nd = D; map = MAP_NAT; break;
    }
    const int nblk = Nd / 32, nitems = (K / 64) * nblk;
    for (int it = gw; it < nitems; it += NGW) transpose_item(W, K, Nsrc, gain, WT, map, scr, it, nblk, lane);
  }
}

DI void hgrn_naive_phase(const Params& p, unsigned char* shm) {
  const int chain = opq_bid();
  if (chain >= 128) return;
  const int tid = opq_tid(), wid = tid >> 6, lane = tid & 63;
  const int seq = chain >> 4, head = (chain >> 1) & 7, dir = chain & 1;
  const int slen = seq < 4 ? 4096 : 8192, row0 = seq < 4 ? seq * 4096 : TP + (seq - 4) * 8192;
  const bf16_t* pj = (const bf16_t*)(p.ws + OFF_BIG + B_PROJH);
  bf16_t* od = (bf16_t*)(p.ws + OFF_BIG + B_OFB) + (size_t)dir * T * D;
  const float* lbw = dir ? p.in[8] : p.in[7];
  float* gq = (float*)shm; float* gf = gq + 2048; float* gk = gf + 2048; float* gv = gk + 2048;
  const int vl = lane & 15, kq = lane >> 4, v = 16 * wid + vl;
  float S[32];
#pragma unroll
  for (int i = 0; i < 32; ++i) S[i] = 0.f;
  const int fk = tid & 127;
  const float lb = 1.0f / (1.0f + __expf(lbw[D + head * 128 + fk] - lbw[head * 128 + fk]));
  for (int i0 = 0; i0 < slen; i0 += 16) {
    __syncthreads();
#pragma unroll
    for (int r = 0; r < 4; ++r) {
      const int tt = (tid >> 7) + 4 * r; const int t = dir ? slen - 1 - (i0 + tt) : i0 + tt; const size_t rb = (size_t)(row0 + t) * 4096 + head * 128 + fk;
      const float hq = bf1(pj[rb]), hf = bf1(pj[rb + 1024 * (1 + dir)]), hi = bf1(pj[rb + 3072]);
      const float s = sigm(hf);
      gq[tt * 128 + fk] = hq * sigm(hq); gf[tt * 128 + fk] = lb + (1.0f - lb) * s; gk[tt * 128 + fk] = (1.0f - lb) * (1.0f - s); gv[tt * 128 + fk] = hi;
    }
    __syncthreads();
    for (int tt = 0; tt < 16; ++tt) {
      const float val = gv[tt * 128 + v]; float o = 0.f;
#pragma unroll
      for (int k4 = 0; k4 < 8; ++k4) {
        const f32x4 f4 = *(const f32x4*)(gf + tt * 128 + 32 * kq + 4 * k4), k4v = *(const f32x4*)(gk + tt * 128 + 32 * kq + 4 * k4), q4 = *(const f32x4*)(gq + tt * 128 + 32 * kq + 4 * k4);
#pragma unroll
        for (int e = 0; e < 4; ++e) { S[4 * k4 + e] = f4[e] * S[4 * k4 + e] + k4v[e] * val; o += q4[e] * S[4 * k4 + e]; }
      }
      o += __shfl_xor(o, 16); o += __shfl_xor(o, 32);
      const int t = dir ? slen - 1 - (i0 + tt) : i0 + tt;
      if (kq == 0) od[(size_t)(row0 + t) * D + head * 128 + v] = (bf16_t)(pk2(o, 0.f) & 0xffffu);
    }
  }
}

DI void combine_phase(const Params& p) {
  const int tid = opq_tid(), wid = tid >> 6, lane = tid & 63;
  const int bid = opq_bid(); const int gw = bid * 8 + wid, NGW = gridDim.x * 8;
  const bf16_t* oF = (const bf16_t*)(p.ws + OFF_BIG + B_OFB); const bf16_t* oB = oF + (size_t)T * D;
  const bf16_t* hg = (const bf16_t*)(p.ws + OFF_BIG + B_HG); bf16_t* yb = (bf16_t*)(p.ws + OFF_BIG + B_YB);
  const float* ng = p.in[9];
  const int c0 = lane * 16;
  float g[16];
#pragma unroll
  for (int i = 0; i < 16; ++i) g[i] = ng[c0 + i];
  for (int rb = gw; rb < T; rb += 3 * NGW) {
    u32x4 fa[3][2], fb[3][2], fg[3][2];
#pragma unroll
    for (int k = 0; k < 3; ++k) { const int row = rb + k * NGW; if (row < T) { const size_t b = (size_t)row * D + c0;
#pragma unroll
        for (int h = 0; h < 2; ++h) { fa[k][h] = __builtin_nontemporal_load((const u32x4*)(oF + b + 8 * h)); fb[k][h] = __builtin_nontemporal_load((const u32x4*)(oB + b + 8 * h)); fg[k][h] = __builtin_nontemporal_load((const u32x4*)(hg + b + 8 * h)); } } }
#pragma unroll
    for (int k = 0; k < 3; ++k) { const int row = rb + k * NGW; if (row < T) { const size_t b = (size_t)row * D + c0;
        float o[16]; float s = 0.f;
#pragma unroll
        for (int h = 0; h < 2; ++h)
#pragma unroll
          for (int e = 0; e < 4; ++e) { o[8 * h + 2 * e] = bflo(fa[k][h][e]) + bflo(fb[k][h][e]); o[8 * h + 2 * e + 1] = bfhi(fa[k][h][e]) + bfhi(fb[k][h][e]); }
#pragma unroll
        for (int i = 0; i < 16; ++i) s += o[i] * o[i];
        s += __shfl_xor(s, 1); s += __shfl_xor(s, 2); s += __shfl_xor(s, 4);
        const float rs = rsqrtf(s * (1.0f / 128.0f) + EPS);
#pragma unroll
        for (int h = 0; h < 2; ++h) { u32x4 w;
#pragma unroll
          for (int e = 0; e < 4; ++e) { const float g0 = bflo(fg[k][h][e]), g1 = bfhi(fg[k][h][e]);
            w[e] = pk2(o[8 * h + 2 * e] * rs * g[8 * h + 2 * e] * g0 * sigm(g0), o[8 * h + 2 * e + 1] * rs * g[8 * h + 2 * e + 1] * g1 * sigm(g1)); }
          *(u32x4*)(yb + b + 8 * h) = w; } } }
  }
}

DI void attn_naive_phase(const Params& p, int half) {
  const int tid = opq_tid(), wid = tid >> 6, lane = tid & 63;
  const int bid = opq_bid(); const int gw = bid * 8 + wid, NGW = gridDim.x * 8;
  const int row_base = half * THALF;
  const bf16_t* base = (const bf16_t*)(p.ws + OFF_BIG + B_QKV) - (size_t)row_base * 4608;
  bf16_t* ya = (bf16_t*)(p.ws + OFF_BIG + B_YA);
  for (int unit = gw; unit < THALF * 8; unit += NGW) {
    const int row = row_base + (unit >> 3), j = unit & 7;
    int s0, slen; if (row < TP) { s0 = row & ~4095; slen = 4096; } else { s0 = TP + ((row - TP) & ~8191); slen = 8192; }
    const int t = row - s0;
    const float slope = exp2f(-(float)(j + 1));
    float sc[3][3];
#pragma unroll
    for (int g = 0; g < 3; ++g) {
      const int d = g == 0 ? 1 : (g == 1 ? 4 : 16);
      u32x4 qv[8];
      { const u32x4* qp = (const u32x4*)(base + (size_t)row * 4608 + g * 512 + j * 64);
#pragma unroll
        for (int i = 0; i < 8; ++i) qv[i] = qp[i]; }
#pragma unroll
      for (int r = 0; r < 3; ++r) {
        const int joff = lane + 64 * r - 64; const int pos = t + d * joff;
        const bool valid = (r < 2 || lane == 0) && pos >= 0 && pos < slen;
        float s = -1e30f;
        if (valid) {
          const u32x4* kp = (const u32x4*)(base + (size_t)(s0 + pos) * 4608 + 1536 + g * 512 + j * 64);
          float dot = 0.f;
#pragma unroll
          for (int i = 0; i < 8; ++i) { const u32x4 kv = kp[i];
#pragma unroll
            for (int e = 0; e < 4; ++e) dot += bflo(kv[e]) * bflo(qv[i][e]) + bfhi(kv[e]) * bfhi(qv[i][e]); }
          s = dot * 0.125f - slope * (float)(d * (joff < 0 ? -joff : joff));
        }
        sc[g][r] = s;
      }
    }
    float m = -1e30f;
#pragma unroll
    for (int g = 0; g < 3; ++g)
#pragma unroll
      for (int r = 0; r < 3; ++r) m = fmaxf(m, sc[g][r]);
    m = wave_max(m);
    float l = 0.f;
#pragma unroll
    for (int g = 0; g < 3; ++g)
#pragma unroll
      for (int r = 0; r < 3; ++r) { sc[g][r] = sc[g][r] > -1e29f ? __expf(sc[g][r] - m) : 0.f; l += sc[g][r]; }
    l = wave_sum(l);
    float o = 0.f;
#pragma unroll
    for (int g = 0; g < 3; ++g) {
      const int d = g == 0 ? 1 : (g == 1 ? 4 : 16);
      const bf16_t* vb = base + 3072 + g * 512 + j * 64 + lane;
#pragma unroll
      for (int r = 0; r < 3; ++r) {
        const int ntl = r < 2 ? 64 : 1;
        for (int tl = 0; tl < ntl; ++tl) {
          const float pb = __uint_as_float(__builtin_amdgcn_readlane(__float_as_uint(sc[g][r]), tl));
          if (pb != 0.f) { const int pos = t + d * (tl + 64 * r - 64); o += pb * bf1(vb[(size_t)(s0 + pos) * 4608]); }
        }
      }
    }
    ya[(size_t)row * 512 + j * 64 + lane] = (bf16_t)(pk2(o / l, 0.f) & 0xffffu);
  }
}


typedef float f32x16 __attribute__((ext_vector_type(16)));
typedef short s16x4 __attribute__((ext_vector_type(4)));
DI unsigned pk2c(float a, float b) { f32v2_t v = {a, b}; bf16v2_t r = __builtin_convertvector(v, bf16v2_t); return __builtin_bit_cast(unsigned, r); }
#define MFMA32(a, b, c) __builtin_amdgcn_mfma_f32_32x32x16_bf16((a), (b), (c), 0, 0, 0)
DI int crow(int i, int h) { return (i & 3) + 8 * (i >> 2) + 4 * h; }
DI void tr_read4(unsigned a0, unsigned a1, unsigned a2, unsigned a3, s16x4& r0, s16x4& r1, s16x4& r2, s16x4& r3) {
  asm volatile("ds_read_b64_tr_b16 %0, %4\n\tds_read_b64_tr_b16 %1, %5\n\tds_read_b64_tr_b16 %2, %6\n\tds_read_b64_tr_b16 %3, %7\n\ts_waitcnt lgkmcnt(0)"
               : "=&v"(r0), "=&v"(r1), "=&v"(r2), "=&v"(r3) : "v"(a0), "v"(a1), "v"(a2), "v"(a3) : "memory");
}
constexpr int AROW = 144;
constexpr int AV_OFF = 384 * AROW;

struct AUnit { int g, j, d, r, c, L, lrow0, ki0; size_t colq; };
DI AUnit attn_decode(int unit, int half) {
  AUnit a; a.g = unit / 768; const int rem = unit % 768; a.j = rem & 7; const int cidx = rem >> 3;
  a.d = a.g == 0 ? 1 : (a.g == 1 ? 4 : 16);
  int seq_row0, S, w;
  if (half == 0) { if (cidx < 64) { seq_row0 = (cidx >> 4) * 4096; S = 4096; w = cidx & 15; } else { seq_row0 = TP; S = 8192; w = cidx - 64; } }
  else { seq_row0 = TP + (1 + (cidx >> 5)) * 8192; S = 8192; w = cidx & 31; }
  a.r = w % a.d; a.c = w / a.d; a.L = S / a.d; a.lrow0 = seq_row0 - half * THALF; a.ki0 = 256 * a.c - 64; a.colq = (size_t)a.g * 512 + a.j * 64;
  return a;
}
DI void attn_phase(const Params& p, int half, unsigned char* shm) {
  const int tid = opq_tid(), wid = tid >> 6, lane = tid & 63, bid = opq_bid();
  const int q32 = lane & 31, h = lane >> 5;
  const bf16_t* qkv = (const bf16_t*)(p.ws + OFF_BIG + B_QKV);
  bf16_t* og = (bf16_t*)(p.ws + OFF_BIG + B_OG);
  float* ml = (float*)(p.ws + OFF_BIG + B_LSE);
  const unsigned lbase = (unsigned)(size_t)(PG8_LAS unsigned char*)shm;
  u32x4 kreg[6], vreg[6];
#define AT_FETCH(UU) do { const AUnit f = attn_decode((UU), half); \
    _Pragma("unroll") for (int it = 0; it < 6; ++it) { const int idx = tid + 512 * it, slot = idx >> 3, ch = idx & 7, ki = f.ki0 + slot; \
      u32x4 kv = {0u, 0u, 0u, 0u}, vv = {0u, 0u, 0u, 0u}; \
      if (ki >= 0 && ki < f.L) { const bf16_t* rp = qkv + (size_t)(f.lrow0 + f.r + f.d * ki) * 4608 + f.colq + ch * 8; kv = *(const u32x4*)(rp + 1536); vv = *(const u32x4*)(rp + 3072); } \
      kreg[it] = kv; vreg[it] = vv; } \
    } while (0)
  if (bid < 2304) AT_FETCH(bid);
  for (int unit = bid; unit < 2304; unit += (int)gridDim.x) {
    const AUnit a = attn_decode(unit, half);
    const int g = a.g, j = a.j, d = a.d, r = a.r, c = a.c, L = a.L, lrow0 = a.lrow0, ki0 = a.ki0;
    pg8::bf16x8 qf[4];
    { const bf16_t* qp = qkv + (size_t)(lrow0 + r + d * (256 * c + 32 * wid + q32)) * 4608 + a.colq + 8 * h;
#pragma unroll
      for (int ks = 0; ks < 4; ++ks) qf[ks] = *(const pg8::bf16x8*)(qp + 16 * ks); }
    LDS_BARRIER();
#pragma unroll
    for (int it = 0; it < 6; ++it) {
      const int idx = tid + 512 * it, slot = idx >> 3, ch = idx & 7;
      *(u32x4*)(shm + slot * AROW + ch * 16) = kreg[it]; *(u32x4*)(shm + AV_OFF + slot * AROW + ch * 16) = vreg[it];
    }
    LDS_BARRIER();
    if (unit + (int)gridDim.x < 2304) AT_FETCH(unit + (int)gridDim.x);
    f32x16 st[5];
#pragma unroll
    for (int kt = 0; kt < 5; ++kt) {
#pragma unroll
      for (int i = 0; i < 16; ++i) st[kt][i] = 0.f;
#pragma unroll
      for (int ks = 0; ks < 4; ++ks) {
        const pg8::bf16x8 kf = *(const pg8::bf16x8*)(shm + (32 * wid + 32 * kt + q32) * AROW + (16 * ks + 8 * h) * 2);
        st[kt] = MFMA32(kf, qf[ks], st[kt]);
      }
    }
    const float slope_d = exp2f(-(float)(j + 1)) * (float)d;
    int hu = h, qu = q32; asm volatile("" : "+v"(hu), "+v"(qu));
    float m = -1e30f;
#pragma unroll
    for (int kt = 0; kt < 5; ++kt)
#pragma unroll
      for (int i = 0; i < 16; ++i) {
        const int rel = 32 * kt + crow(i, hu) - qu - 64; const int ki = ki0 + 32 * wid + 32 * kt + crow(i, hu);
        const int arel = rel < 0 ? -rel : rel;
        const bool valid = arel <= 64 && ki >= 0 && ki < L;
        const float s = valid ? st[kt][i] * 0.125f - slope_d * (float)arel : -1e30f;
        st[kt][i] = s; m = fmaxf(m, s);
      }
    m = fmaxf(m, __shfl_xor(m, 32));
    float l = 0.f;
#pragma unroll
    for (int kt = 0; kt < 5; ++kt)
#pragma unroll
      for (int i = 0; i < 16; ++i) { const float s = st[kt][i]; const float e = s > -1e29f ? __expf(s - m) : 0.f; st[kt][i] = e; l += e; }
    l += __shfl_xor(l, 32);
    f32x16 o[2];
#pragma unroll
    for (int et = 0; et < 2; ++et)
#pragma unroll
      for (int i = 0; i < 16; ++i) o[et][i] = 0.f;
    const int i16 = lane & 15, q4 = i16 >> 2, p4 = i16 & 3, blk = (lane >> 4) & 1;
    const unsigned vaddr0 = lbase + AV_OFF + (32 * wid + 4 * h + q4) * AROW + 32 * blk + 8 * p4;
#pragma unroll
    for (int kt = 0; kt < 5; ++kt)
#pragma unroll
      for (int s2 = 0; s2 < 2; ++s2) {
        u32x4 pw; pw.x = pk2c(st[kt][8 * s2 + 0], st[kt][8 * s2 + 1]); pw.y = pk2c(st[kt][8 * s2 + 2], st[kt][8 * s2 + 3]);
        pw.z = pk2c(st[kt][8 * s2 + 4], st[kt][8 * s2 + 5]); pw.w = pk2c(st[kt][8 * s2 + 6], st[kt][8 * s2 + 7]);
        const pg8::bf16x8 pa = __builtin_bit_cast(pg8::bf16x8, pw);
        const unsigned a = vaddr0 + (32 * kt + 16 * s2) * AROW;
        s16x4 lo0, hi0, lo1, hi1;
        tr_read4(a, a + 8 * AROW, a + 64, a + 8 * AROW + 64, lo0, hi0, lo1, hi1);
        const pg8::bf16x8 v0 = __builtin_shufflevector(lo0, hi0, 0, 1, 2, 3, 4, 5, 6, 7), v1 = __builtin_shufflevector(lo1, hi1, 0, 1, 2, 3, 4, 5, 6, 7);
        o[0] = MFMA32(pa, v0, o[0]); o[1] = MFMA32(pa, v1, o[1]);
      }
    const int rowq0 = half * THALF + lrow0 + r + d * (256 * c + 32 * wid);
#pragma unroll
    for (int et = 0; et < 2; ++et)
#pragma unroll
      for (int i = 0; i < 16; ++i) {
        const int row = rowq0 + d * crow(i, h);
        og[((size_t)g * T + row) * 512 + j * 64 + 32 * et + q32] = (bf16_t)(pk2c(o[et][i], 0.f) & 0xffffu);
      }
    if (h == 0) { const int row = rowq0 + d * q32; f32v2_t v = {m, l}; *(f32v2_t*)(ml + (((size_t)g * T + row) * 8 + j) * 2) = v; }
  }
#undef AT_FETCH
}


DI void tr_read2(unsigned a0, unsigned a1, s16x4& r0, s16x4& r1) {
  asm volatile("ds_read_b64_tr_b16 %0, %2\n\tds_read_b64_tr_b16 %1, %3\n\ts_waitcnt lgkmcnt(0)" : "=&v"(r0), "=&v"(r1) : "v"(a0), "v"(a1) : "memory");
}
constexpr int HP = 272;
constexpr int H_QT = 0, H_KT = 64 * HP, H_KE = 2 * 64 * HP, H_VV = 3 * 64 * HP, H_DEC = H_VV + 64 * AROW, H_BUF = H_DEC + 512, H_ST = 2 * H_BUF, H_GG = H_ST + 2 * 64 * HP;
DI void hgrn_phase(const Params& p, unsigned char* shm) {
  const int chain = opq_bid();
  if (chain >= 256) return;
  const int tid = opq_tid(), wid = tid >> 6, lane = tid & 63;
  const int vh = chain & 1, dir = (chain >> 1) & 1, head = (chain >> 2) & 7, seq = chain >> 5;
  const int slen = seq < 4 ? 4096 : 8192, row0 = seq < 4 ? seq * 4096 : TP + (seq - 4) * 8192, nchunks = slen >> 6;
  const bf16_t* pj = (const bf16_t*)(p.ws + OFF_BIG + B_PROJH);
  bf16_t* od = (bf16_t*)(p.ws + OFF_BIG + B_OFB) + (size_t)dir * T * D;
  const float* lbw = dir ? p.in[8] : p.in[7];
  const unsigned lbase = (unsigned)(size_t)(PG8_LAS unsigned char*)shm;
  const int rg = wid, c2 = 2 * lane;
  __syncthreads();
  for (int i = tid; i < 2 * 64 * HP / 4; i += 512) ((unsigned*)(shm + H_ST))[i] = 0u;
  f32x16 Sacc[2];
#pragma unroll
  for (int b = 0; b < 2; ++b)
#pragma unroll
    for (int i = 0; i < 16; ++i) Sacc[b][i] = 0.f;
  unsigned rqA[8], rfA[8], rqB[8], rfB[8]; u32x4 rvA, rvB;
#define HG_LOAD(cc, rq, rf, rv) do { _Pragma("unroll") for (int ii = 0; ii < 8; ++ii) { const int il = 64 * (cc) + 8 * rg + ii; const int t = dir ? slen - 1 - il : il; \
      const bf16_t* bp = pj + (size_t)(row0 + t) * 4096 + head * 128 + c2; rq[ii] = *(const unsigned*)bp; rf[ii] = *(const unsigned*)(bp + 1024 * (1 + dir)); } \
    { const int il = 64 * (cc) + (tid >> 3); const int t = dir ? slen - 1 - il : il; rv = *(const u32x4*)(pj + (size_t)(row0 + t) * 4096 + 3072 + head * 128 + vh * 64 + (tid & 7) * 8); } } while (0)
  HG_LOAD(0, rqA, rfA, rvA); HG_LOAD(1, rqB, rfB, rvB);
  auto step = [&](const int c, unsigned (&rq)[8], unsigned (&rf)[8], u32x4& rv) __attribute__((always_inline)) {
    int hu = lane >> 5, qu = lane & 31; asm volatile("" : "+v"(hu), "+v"(qu));
    unsigned char* buf = shm + (c & 1) * H_BUF;
    {
      float k0[8], k1[8], P0[8], P1[8];
      float run0 = 1.f, run1 = 1.f;
#pragma unroll
      for (int ii = 0; ii < 8; ++ii) {
        k0[ii] = bflo(rf[ii]); k1[ii] = bfhi(rf[ii]);
        run0 *= 1.0f - k0[ii]; run1 *= 1.0f - k1[ii];
        P0[ii] = run0; P1[ii] = run1;
      }
      { f32v2_t gg = {run0, run1}; *(f32v2_t*)(shm + H_GG + (wid * 128 + c2) * 4) = gg; }
      *(u32x4*)(buf + H_VV + (tid >> 3) * AROW + (tid & 7) * 16) = rv;
      LDS_BARRIER();
      float pre0 = 1.f, pre1 = 1.f, dec0 = 1.f, dec1 = 1.f;
#pragma unroll
      for (int w2 = 0; w2 < 8; ++w2) { const f32v2_t gg = *(const f32v2_t*)(shm + H_GG + (w2 * 128 + c2) * 4); dec0 *= gg[0]; dec1 *= gg[1]; if (w2 < wid) { pre0 *= gg[0]; pre1 *= gg[1]; } }
#pragma unroll
      for (int ii = 0; ii < 8; ++ii) {
        const float Pa = pre0 * P0[ii], Pb = pre1 * P1[ii];
        const float kta = k0[ii] * __builtin_amdgcn_rcpf(Pa), ktb = k1[ii] * __builtin_amdgcn_rcpf(Pb);
        const int off = (8 * rg + ii) * HP + c2 * 2;
        *(unsigned*)(buf + H_QT + off) = pk2c(bflo(rq[ii]) * Pa, bfhi(rq[ii]) * Pb);
        *(unsigned*)(buf + H_KT + off) = pk2c(kta, ktb);
        *(unsigned*)(buf + H_KE + off) = pk2c(kta * dec0, ktb * dec1);
      }
      if (wid == 0) { f32v2_t dd = {dec0, dec1}; *(f32v2_t*)(buf + H_DEC + c2 * 4) = dd; }
    }
    if (c + 2 < nchunks) HG_LOAD(c + 2, rq, rf, rv);
    LDS_BARRIER();
    const unsigned bbase = lbase + (c & 1) * H_BUF;
    const unsigned char* stc = shm + H_ST + (c & 1) * (64 * HP);
    unsigned char* stn = shm + H_ST + ((c + 1) & 1) * (64 * HP);
    const int i16 = lane & 15, q4 = i16 >> 2, p4 = i16 & 3, blk = (lane >> 4) & 1;
    if (wid < 4) {
      const int tb = wid >> 1, vb = wid & 1;
      pg8::bf16x8 fQ[8], fS[8], fK[8];
#pragma unroll
      for (int ks = 0; ks < 8; ++ks) {
        fQ[ks] = *(const pg8::bf16x8*)(buf + H_QT + (32 * tb + qu) * HP + (16 * ks + 8 * hu) * 2);
        fS[ks] = *(const pg8::bf16x8*)(stc + (32 * vb + qu) * HP + (16 * ks + 8 * hu) * 2);
        fK[ks] = *(const pg8::bf16x8*)(buf + H_KT + qu * HP + (16 * ks + 8 * hu) * 2);
      }
      __builtin_amdgcn_sched_barrier(0);
      f32x16 o, at;
#pragma unroll
      for (int i = 0; i < 16; ++i) { o[i] = 0.f; at[i] = 0.f; }
#pragma unroll
      for (int ks = 0; ks < 8; ++ks) { o = MFMA32(fQ[ks], fS[ks], o); at = MFMA32(fK[ks], fQ[ks], at); }
      if (tb == 1) {
#pragma unroll
        for (int ks = 0; ks < 8; ++ks) fK[ks] = *(const pg8::bf16x8*)(buf + H_KT + (32 + qu) * HP + (16 * ks + 8 * hu) * 2);
      }
      __builtin_amdgcn_sched_barrier(0);
      for (int sb = 0; sb <= tb; ++sb) {
        if (sb == 1) {
#pragma unroll
          for (int i = 0; i < 16; ++i) at[i] = 0.f;
#pragma unroll
          for (int ks = 0; ks < 8; ++ks) at = MFMA32(fK[ks], fQ[ks], at);
        }
        if (sb == tb) {
#pragma unroll
          for (int i = 0; i < 16; ++i) at[i] = crow(i, hu) > qu ? 0.f : at[i];
        }
        u32x4 pw0, pw1;
        pw0.x = pk2c(at[0], at[1]); pw0.y = pk2c(at[2], at[3]); pw0.z = pk2c(at[4], at[5]); pw0.w = pk2c(at[6], at[7]);
        pw1.x = pk2c(at[8], at[9]); pw1.y = pk2c(at[10], at[11]); pw1.z = pk2c(at[12], at[13]); pw1.w = pk2c(at[14], at[15]);
        const unsigned a = bbase + H_VV + (32 * sb + 4 * hu + q4) * AROW + (32 * vb + 16 * blk) * 2 + 8 * p4;
        s16x4 lo0, hi0, lo1, hi1; tr_read4(a, a + 8 * AROW, a + 16 * AROW, a + 24 * AROW, lo0, hi0, lo1, hi1);
        o = MFMA32(__builtin_bit_cast(pg8::bf16x8, pw0), __builtin_shufflevector(lo0, hi0, 0, 1, 2, 3, 4, 5, 6, 7), o);
        o = MFMA32(__builtin_bit_cast(pg8::bf16x8, pw1), __builtin_shufflevector(lo1, hi1, 0, 1, 2, 3, 4, 5, 6, 7), o);
      }
#pragma unroll
      for (int i = 0; i < 16; ++i) {
        const int il = 64 * c + 32 * tb + crow(i, hu); const int t = dir ? slen - 1 - il : il;
        od[(size_t)(row0 + t) * D + head * 128 + vh * 64 + 32 * vb + qu] = (bf16_t)(pk2c(o[i], 0.f) & 0xffffu);
      }
    } else {
      const int kb = wid - 4;
#pragma unroll
      for (int i = 0; i < 16; ++i) { const float dv = *(const float*)(buf + H_DEC + (32 * kb + crow(i, hu)) * 4); Sacc[0][i] *= dv; Sacc[1][i] *= dv; }
      s16x4 tA[4][2], tB[4][4];
      { const unsigned aa = bbase + H_KE + (8 * hu + q4) * HP + (32 * kb + 16 * blk) * 2 + 8 * p4;
        const unsigned ab = bbase + H_VV + (8 * hu + q4) * AROW + (16 * blk) * 2 + 8 * p4;
        static_assert(HP == 272 && AROW == 144, "offsets in the asm string below are literal");
        asm volatile("ds_read_b64_tr_b16 %0, %24 offset:0\n\tds_read_b64_tr_b16 %1, %24 offset:1088\n\tds_read_b64_tr_b16 %2, %25 offset:0\n\tds_read_b64_tr_b16 %3, %25 offset:576\n\tds_read_b64_tr_b16 %4, %25 offset:64\n\tds_read_b64_tr_b16 %5, %25 offset:640\n\tds_read_b64_tr_b16 %6, %24 offset:4352\n\tds_read_b64_tr_b16 %7, %24 offset:5440\n\tds_read_b64_tr_b16 %8, %25 offset:2304\n\tds_read_b64_tr_b16 %9, %25 offset:2880\n\tds_read_b64_tr_b16 %10, %25 offset:2368\n\tds_read_b64_tr_b16 %11, %25 offset:2944\n\tds_read_b64_tr_b16 %12, %24 offset:8704\n\tds_read_b64_tr_b16 %13, %24 offset:9792\n\tds_read_b64_tr_b16 %14, %25 offset:4608\n\tds_read_b64_tr_b16 %15, %25 offset:5184\n\tds_read_b64_tr_b16 %16, %25 offset:4672\n\tds_read_b64_tr_b16 %17, %25 offset:5248\n\tds_read_b64_tr_b16 %18, %24 offset:13056\n\tds_read_b64_tr_b16 %19, %24 offset:14144\n\tds_read_b64_tr_b16 %20, %25 offset:6912\n\tds_read_b64_tr_b16 %21, %25 offset:7488\n\tds_read_b64_tr_b16 %22, %25 offset:6976\n\tds_read_b64_tr_b16 %23, %25 offset:7552\n\ts_waitcnt lgkmcnt(0)"
                     : "=&v"(tA[0][0]), "=&v"(tA[0][1]), "=&v"(tB[0][0]), "=&v"(tB[0][1]), "=&v"(tB[0][2]), "=&v"(tB[0][3]), "=&v"(tA[1][0]), "=&v"(tA[1][1]), "=&v"(tB[1][0]), "=&v"(tB[1][1]), "=&v"(tB[1][2]), "=&v"(tB[1][3]), "=&v"(tA[2][0]), "=&v"(tA[2][1]), "=&v"(tB[2][0]), "=&v"(tB[2][1]), "=&v"(tB[2][2]), "=&v"(tB[2][3]), "=&v"(tA[3][0]), "=&v"(tA[3][1]), "=&v"(tB[3][0]), "=&v"(tB[3][1]), "=&v"(tB[3][2]), "=&v"(tB[3][3])
                     : "v"(aa), "v"(ab) : "memory"); }
#pragma unroll
      for (int s = 0; s < 4; ++s) {
        const pg8::bf16x8 af = __builtin_shufflevector(tA[s][0], tA[s][1], 0, 1, 2, 3, 4, 5, 6, 7);
        Sacc[0] = MFMA32(af, __builtin_shufflevector(tB[s][0], tB[s][1], 0, 1, 2, 3, 4, 5, 6, 7), Sacc[0]);
        Sacc[1] = MFMA32(af, __builtin_shufflevector(tB[s][2], tB[s][3], 0, 1, 2, 3, 4, 5, 6, 7), Sacc[1]);
      }
#pragma unroll
      for (int b = 0; b < 2; ++b)
#pragma unroll
        for (int g4 = 0; g4 < 4; ++g4) {
          u32x2 w; w.x = pk2c(Sacc[b][4 * g4 + 0], Sacc[b][4 * g4 + 1]); w.y = pk2c(Sacc[b][4 * g4 + 2], Sacc[b][4 * g4 + 3]);
          *(u32x2*)(stn + (32 * b + qu) * HP + (32 * kb + 8 * g4 + 4 * hu) * 2) = w;
        }
    }
  };
  for (int c = 0; c < nchunks; c += 2) { step(c, rqA, rfA, rvA); step(c + 1, rqB, rfB, rvB); }
  __syncthreads();
#undef HG_LOAD
}

DI void merge_phase(const Params& p) {
  const int tid = opq_tid(), wid = tid >> 6, lane = tid & 63;
  const int bid = opq_bid(); const int gw = bid * 8 + wid, NGW = gridDim.x * 8;
  const bf16_t* og = (const bf16_t*)(p.ws + OFF_BIG + B_OG); const float* ml = (const float*)(p.ws + OFF_BIG + B_LSE);
  bf16_t* ya = (bf16_t*)(p.ws + OFF_BIG + B_YA);
  const int c0 = lane * 8, j = lane >> 3;
  for (int rb = gw; rb < T; rb += 4 * NGW) {
    u32x4 a[4][3]; f32v2_t mlv[4][3];
#pragma unroll
    for (int k = 0; k < 4; ++k) { const int row = rb + k * NGW; if (row < T) {
#pragma unroll
        for (int g = 0; g < 3; ++g) { mlv[k][g] = *(const f32v2_t*)(ml + (((size_t)g * T + row) * 8 + j) * 2); a[k][g] = __builtin_nontemporal_load((const u32x4*)(og + ((size_t)g * T + row) * 512 + c0)); } } }
#pragma unroll
    for (int k = 0; k < 4; ++k) { const int row = rb + k * NGW; if (row < T) {
        const float M = fmaxf(mlv[k][0][0], fmaxf(mlv[k][1][0], mlv[k][2][0]));
        float acc[8]; float den = 0.f;
#pragma unroll
        for (int e = 0; e < 8; ++e) acc[e] = 0.f;
#pragma unroll
        for (int g = 0; g < 3; ++g) { const float wg = __expf(mlv[k][g][0] - M); den += wg * mlv[k][g][1];
#pragma unroll
          for (int e = 0; e < 4; ++e) { acc[2 * e] += wg * bflo(a[k][g][e]); acc[2 * e + 1] += wg * bfhi(a[k][g][e]); } }
        const float inv = __builtin_amdgcn_rcpf(den);
        u32x4 w; w.x = pk2(acc[0] * inv, acc[1] * inv); w.y = pk2(acc[2] * inv, acc[3] * inv); w.z = pk2(acc[4] * inv, acc[5] * inv); w.w = pk2(acc[6] * inv, acc[7] * inv);
        *(u32x4*)(ya + (size_t)row * 512 + c0) = w; } }
  }
}

DI void final_phase(const Params& p) {
  const int tid = opq_tid(), wid = tid >> 6, lane = tid & 63;
  const int bid = opq_bid(); const int gw = bid * 8 + wid, NGW = gridDim.x * 8;
  const float* ss3 = (const float*)(p.ws + OFF_SS) + (size_t)3 * T * 16; const float* g = p.in[16];
  const bf16_t* xb = (const bf16_t*)(p.ws + OFF_XB);
  f32x4 g4[4];
#pragma unroll
  for (int j = 0; j < 4; ++j) g4[j] = *(const f32x4*)(g + 4 * lane + 256 * j);
  for (int rb = gw; rb < T; rb += 4 * NGW) {
    u32x2 v[4][4]; float sp[4];
#pragma unroll
    for (int k = 0; k < 4; ++k) { const int row = rb + k * NGW; if (row < T) { sp[k] = ss3[(size_t)row * 16 + (lane & 15)];
#pragma unroll
        for (int j = 0; j < 4; ++j) v[k][j] = __builtin_nontemporal_load((const u32x2*)(xb + (size_t)row * D + 4 * lane + 256 * j)); } }
#pragma unroll
    for (int k = 0; k < 4; ++k) { const int row = rb + k * NGW; if (row < T) {
        float t = sp[k]; t += __shfl_xor(t, 1); t += __shfl_xor(t, 2); t += __shfl_xor(t, 4); t += __shfl_xor(t, 8);
        const float rs = rsqrtf(t * (1.0f / 1024.0f) + EPS);
#pragma unroll
        for (int j = 0; j < 4; ++j) { f32x4 x; x[0] = bflo(v[k][j].x); x[1] = bfhi(v[k][j].x); x[2] = bflo(v[k][j].y); x[3] = bfhi(v[k][j].y);
          __builtin_nontemporal_store(x * rs * g4[j], (f32x4*)(p.out + (size_t)row * D + 4 * lane + 256 * j)); } } }
  }
}

#define XB_TMO      128
#define XB_XCNT(j)  (256  + 64 * (j))
#define XB_XSUB(j)  (1280 + 64 * (j))
#define XB_XGEN(j)  (2304 + 64 * (j))
#define XB_TOP      3328
#define XB_TOPGEN   3392
#define XCD_BAR_WORDS 3456
#define XB_SPIN_CAP (1u << 18)
#define XLAS __attribute__((address_space(3)))

__device__ __forceinline__ unsigned xb_ld(unsigned* p)              { return __hip_atomic_load(p, __ATOMIC_RELAXED, __HIP_MEMORY_SCOPE_AGENT); }
__device__ __forceinline__ unsigned xb_add(unsigned* p, unsigned v) { return __hip_atomic_fetch_add(p, v, __ATOMIC_RELAXED, __HIP_MEMORY_SCOPE_AGENT); }
__device__ __forceinline__ unsigned xb_xcc_id() { return (unsigned)__builtin_amdgcn_s_getreg((3 << 11) | 20) & 0xFu; }
#define XB_SPIN(cond, bar) do { unsigned _sp = 0; while (cond) { __builtin_amdgcn_s_sleep(1); \
    if ((++_sp & 255u) == 0u) { if (xb_ld(&(bar)[XB_TMO])) break; if (_sp > XB_SPIN_CAP) { atomicAdd(&(bar)[XB_TMO], 1u); break; } } } } while (0)

struct XcdBarrier {
    unsigned* bar; unsigned x;
    volatile XLAS unsigned* st;
};

__device__ __forceinline__ XcdBarrier xcd_barrier_post(unsigned* bar, volatile XLAS unsigned* st) {
    XcdBarrier b; b.bar = bar; b.x = xb_xcc_id(); b.st = st;
    if (threadIdx.x == 0) (void)xb_add(&bar[XB_XCNT(b.x)], 1u);
    return b;
}
__device__ __forceinline__ void xcd_barrier_complete(unsigned* bar, unsigned x, unsigned& nloc, unsigned& nx) {
    const unsigned G = gridDim.x * gridDim.y * gridDim.z;
    unsigned sum, cnt, mine, sp = 0u;
    for (;;) {
        sum = 0u; cnt = 0u; mine = 0u;
#pragma unroll
        for (unsigned j = 0; j < 16; ++j) { const unsigned c = xb_ld(&bar[XB_XCNT(j)]); sum += c; cnt += (c > 0u) ? 1u : 0u; mine = (j == x) ? c : mine; }
        if (sum == G) break;
        __builtin_amdgcn_s_sleep(1);
        if ((++sp & 255u) == 0u) { if (xb_ld(&bar[XB_TMO])) break; if (sp > XB_SPIN_CAP) { atomicAdd(&bar[XB_TMO], 1u); break; } }
    }
    nloc = mine > 0u ? mine : 1u; nx = cnt > 0u ? cnt : 1u;
}

__device__ __forceinline__ void xcd_barrier(const XcdBarrier& b) {
    asm volatile("s_waitcnt vmcnt(0)" ::: "memory");
    __syncthreads();
    if (threadIdx.x == 0) {
        unsigned* bar = b.bar;
        __builtin_amdgcn_s_waitcnt(0);
        unsigned nloc = b.st[0], nx = b.st[1];
        if (nloc == 0u) { xcd_barrier_complete(bar, b.x, nloc, nx); b.st[0] = nloc; b.st[1] = nx; }
        const unsigned old = xb_add(&bar[XB_XSUB(b.x)], 1u);
        const unsigned gen = old / nloc;
        if (old + 1u == (gen + 1u) * nloc) {
            __builtin_amdgcn_fence(__ATOMIC_RELEASE, "agent");
            asm volatile("s_waitcnt vmcnt(0)" ::: "memory");
            const unsigned og = xb_add(&bar[XB_TOP], 1u);
            const unsigned tg = og / nx;
            if (og + 1u == (tg + 1u) * nx) xb_add(&bar[XB_TOPGEN], 1u);
            else XB_SPIN(xb_ld(&bar[XB_TOPGEN]) == tg, bar);
            __builtin_amdgcn_fence(__ATOMIC_ACQUIRE, "agent");
            xb_add(&bar[XB_XGEN(b.x)], 1u);
            asm volatile("s_waitcnt vmcnt(0)" ::: "memory");
        } else {
            XB_SPIN(xb_ld(&bar[XB_XGEN(b.x)]) == gen, bar);
            __builtin_amdgcn_fence(__ATOMIC_ACQUIRE, "agent");
            asm volatile("s_waitcnt vmcnt(0)" ::: "memory");
        }
    }
    __syncthreads();
}


enum { PT_GEMM = 0, PT_HGRN = 1, PT_COMBINE = 2, PT_ATTN0 = 3, PT_ATTN1 = 4, PT_FINAL = 5, PT_MERGE = 6 };
constexpr int NPH = 18;
__global__ void __launch_bounds__(512, 2) fwd_megakernel(Params p) {
  extern __shared__ __attribute__((aligned(16))) unsigned char shm[];
  cg::grid_group grid = cg::this_grid();
  unsigned* ctr = (unsigned*)(p.ws + OFF_CTR);
  if (threadIdx.x == 0) { *(volatile unsigned*)(shm + LCTL + 200) = 0u; *(volatile unsigned*)(shm + LCTL + 204) = 0u; }
  __syncthreads();
  const XcdBarrier xb = xcd_barrier_post((unsigned*)(p.ws + OFF_BAR), (volatile XLAS unsigned*)((XLAS unsigned char*)shm + LCTL + 200));
  unsigned my_x = 0, my_rank = 0;
  if (threadIdx.x == 0) { my_x = (unsigned)__builtin_amdgcn_s_getreg((3 << 11) | 20) & 0xFu; if (my_x > 7u) my_x = 7u; my_rank = __hip_atomic_fetch_add(ctr + my_x, 1u, __ATOMIC_RELAXED, __HIP_MEMORY_SCOPE_AGENT); }
  prep_phase(p, shm);
  grid.sync();
  if (threadIdx.x == 0) {
    bool ok = true;
    for (int x = 0; x < 8; ++x) ok = ok && (__hip_atomic_load(ctr + x, __ATOMIC_RELAXED, __HIP_MEMORY_SCOPE_AGENT) * 8u == gridDim.x);
    *(int*)(shm + LCTL + 192) = ok ? (int)(my_rank * 8u + my_x) : (int)blockIdx.x;
  }
  __syncthreads();
  const int vcu = __builtin_amdgcn_readfirstlane(*(const int*)(shm + LCTL + 192));
  for (int ph = 0; ph < NPH; ++ph) {
    const int type = p.ph[ph].type;
    if (type == PT_GEMM) {
      __syncthreads();
      if (threadIdx.x == 0) *(EpiP*)(shm + LCTL) = p.ph[ph].e;
      __syncthreads();
      pg8::Gemm g; g.A = p.ph[ph].A; g.Bt = p.ph[ph].Bt; g.M = p.ph[ph].M; g.N = p.ph[ph].N; g.K = p.ph[ph].K;
      Epi E; E.lp = (const PG8_LAS EpiP*)((PG8_LAS unsigned char*)shm + LCTL);
      int vc = vcu; asm volatile("" : "+s"(vc)); pg8::StaticOrder S; S.init(g.M, g.N, (int)gridDim.x, vc);
      int nrep = 1;
#if defined(REP_PH)
      if (ph == REP_PH) nrep = 2;
#endif
#if defined(STAGGER_US)
      if (S.nwg >= 6 * (int)gridDim.x && ((vc >> 3) & 7)) { const unsigned long long t0 = wall_clock64(); const unsigned long long dl = (unsigned long long)(STAGGER_US * 100) * (unsigned)((vc >> 3) & 7); while (wall_clock64() - t0 < dl) __builtin_amdgcn_s_sleep(8); }
#endif
      for (int rr = 0; rr < nrep; ++rr) {
        if (rr) grid.sync();
        pg8::gemm_phase<Epi, pg8::StaticOrder, true, true>((PG8_LAS unsigned char*)shm, g, S, E);
      }
    } else if (type == PT_HGRN) { hgrn_phase(p, shm);
#if defined(REP_HGRN)
      grid.sync(); hgrn_phase(p, shm);
#endif
    }
    else if (type == PT_COMBINE) combine_phase(p);
    else if (type == PT_ATTN0) { attn_phase(p, 0, shm);
#if defined(REP_ATTN)
      grid.sync(); attn_phase(p, 0, shm);
#endif
    }
    else if (type == PT_ATTN1) { attn_phase(p, 1, shm);
#if defined(REP_ATTN)
      grid.sync(); attn_phase(p, 1, shm);
#endif
    }
    else if (type == PT_MERGE) merge_phase(p);
    else final_phase(p);
    if (ph < NPH - 1) xcd_barrier(xb);
  }
}

static void fill_phases(Params& p) {
  unsigned char* ws = p.ws; unsigned char* big = ws + OFF_BIG;
  float* ssb = (float*)(ws + OFF_SS); bf16_t* xb = (bf16_t*)(ws + OFF_XB);
  float* ss0 = ssb; float* ss1 = ssb + (size_t)T * 16; float* ss2 = ssb + (size_t)2 * T * 16; float* ss3 = ssb + (size_t)3 * T * 16;
  const bf16_t* win = (const bf16_t*)(ws + OFF_WIN);
  auto gemm = [&](int i, const bf16_t* A, const bf16_t* Bt, int M, int N, int K) -> EpiP& {
    PhaseDesc& d = p.ph[i]; d.type = PT_GEMM; d.M = M; d.N = N; d.K = K; d.A = A; d.Bt = Bt; d.e.mode = M_BF16S; d.e.ldo = D; d.e.alpha = 1.0f; d.e.kk_lo = -100; return d.e; };
  auto other = [&](int i, int type) { p.ph[i].type = type; };
  { EpiP& e = gemm(0, xb, (const bf16_t*)(ws + OFF_WGU1), T, 2 * FF, D); e.mode = M_SWIGLU; e.ss = ss0; e.ob = (bf16_t*)(big + B_ACT); }
  { EpiP& e = gemm(1, (const bf16_t*)(big + B_ACT), (const bf16_t*)(ws + OFF_WD1), T, D, FF); e.mode = M_RESID; e.alpha = 0.5f; e.of = nullptr; e.r0 = p.in[0]; e.r1 = p.in[1]; e.ob = xb; e.ss_out = ss1; }
  { EpiP& e = gemm(2, xb, win + (size_t)4608 * D, T, 4096, D); e.ss = ss1; e.ob = (bf16_t*)(big + B_PROJH); e.ldo = 4096; e.silu_tiles = 4; e.kk_lo = 4; e.lbp = (const float*)(ws + OFF_LB); }
  other(3, PT_HGRN);
  { EpiP& e = gemm(4, xb, win + (size_t)8704 * D, T, 1024, D); e.ss = ss1; e.ob = (bf16_t*)(big + B_HG); e.ldo = 1024; }
  other(5, PT_COMBINE);
  for (int half = 0; half < 2; ++half) {
    EpiP& e = gemm(6 + 2 * half, xb + (size_t)half * THALF * D, win, THALF, 4608, D); e.ss = ss1 + (size_t)half * THALF * 16; e.ob = (bf16_t*)(big + B_QKV); e.ldo = 4608;
    other(7 + 2 * half, half ? PT_ATTN1 : PT_ATTN0);
  }
  other(10, PT_MERGE);
  { EpiP& e = gemm(11, xb, win + (size_t)9728 * D, T, 2048, D); e.ss = ss1; e.sig = 1; e.ob = (bf16_t*)(big + B_SGA); e.ldo = 1024; e.split_tiles = 4; e.split_stride = (size_t)T * D; }
  { EpiP& e = gemm(12, (const bf16_t*)(big + B_YA), (const bf16_t*)(ws + OFF_WA), T, D, 512); e.mode = M_MUL; e.sg = (const bf16_t*)(big + B_SGA); e.of = (float*)(big + B_TMP); }
  { EpiP& e = gemm(13, (const bf16_t*)(big + B_YB), (const bf16_t*)(ws + OFF_WB), T, D, D); e.mode = M_FMA; e.sg = (const bf16_t*)(big + B_SGB); e.tmp = (const float*)(big + B_TMP); e.ob = (bf16_t*)(big + B_SGB); }
  { EpiP& e = gemm(14, (const bf16_t*)(big + B_SGB), (const bf16_t*)(ws + OFF_WO), T, D, D); e.mode = M_RESID; e.alpha = 1.0f; e.of = nullptr; e.r0 = nullptr; e.sg = xb; e.ob = xb; e.ss_out = ss2; }
  { EpiP& e = gemm(15, xb, (const bf16_t*)(ws + OFF_WGU2), T, 2 * FF, D); e.mode = M_SWIGLU; e.ss = ss2; e.ob = (bf16_t*)(big + B_ACT); }
  { EpiP& e = gemm(16, (const bf16_t*)(big + B_ACT), (const bf16_t*)(ws + OFF_WD2), T, D, FF); e.mode = M_RESID; e.alpha = 0.5f; e.of = nullptr; e.r0 = nullptr; e.sg = xb; e.ob = xb; e.ss_out = ss3; }
  other(17, PT_FINAL);
}

extern "C" void kernel_launch(void* const* d_in, const int* in_sizes, int n_in, void* d_out, int out_size, void* d_ws, size_t ws_size, hipStream_t stream) {
  constexpr int kDynLds = 163840;
  static int grid_blocks = 0;
  if (!grid_blocks) {
    if (n_in != 17 || out_size != T * D || ws_size < WS_NEED) { fprintf(stderr, "kernel_launch: unexpected shapes (n_in %d out %d ws %zu need %zu)\n", n_in, out_size, ws_size, (size_t)WS_NEED); grid_blocks = -1; return; }
    int dev = 0, cus = 0, per_cu = 0;
    (void)hipGetDevice(&dev);
    (void)hipDeviceGetAttribute(&cus, hipDeviceAttributeMultiprocessorCount, dev);
    (void)hipFuncSetAttribute((const void*)fwd_megakernel, hipFuncAttributeMaxDynamicSharedMemorySize, kDynLds);
    (void)hipOccupancyMaxActiveBlocksPerMultiprocessor(&per_cu, (const void*)fwd_megakernel, 512, kDynLds);
    if (per_cu < 1) per_cu = 1;
    grid_blocks = cus * per_cu;
  }
  if (grid_blocks < 0) return;
  static Params p;
  memset(&p, 0, sizeof(p));
  for (int i = 0; i < 17; ++i) p.in[i] = (const float*)d_in[i];
  p.out = (float*)d_out; p.ws = (unsigned char*)d_ws;
  fill_phases(p);
  (void)hipMemsetAsync((unsigned char*)d_ws + OFF_CTR, 0, 256 + 3456 * 4, stream);
  void* args[] = {&p};
  hipError_t e = hipLaunchCooperativeKernel((const void*)fwd_megakernel, dim3(grid_blocks), dim3(512), args, kDynLds, stream);
  if (e != hipSuccess) fprintf(stderr, "cooperative launch failed: %s (grid %d)\n", hipGetErrorString(e), grid_blocks);
}
```
